# Optimizing an MI355X kernel written in HIP

```python
import jax, jax.numpy as jnp
from jax import lax
import numpy as np

D_MODEL = 2048
BATCH = 4
SEQ = 4096
DEPTH = 2

CHUNK = 64
EPS = 1e-6
MIX_HALF = D_MODEL // 2

CONV_WIDTH = 3
CONV_DIM = MIX_HALF
ATT_HEADS = 8
ATT_HEAD_DIM = MIX_HALF // ATT_HEADS
ATT_PAST_CHUNKS = 8
ATT_BAND = (ATT_PAST_CHUNKS + 1) * CHUNK
REL_CLIP = 256
REL_TABLE = (CHUNK - 1) + REL_CLIP + 1

HGRN_HEADS = 8
HGRN_EXPAND = 128
HGRN_DK_TOTAL = HGRN_HEADS * HGRN_EXPAND
HGRN_DV_TOTAL = MIX_HALF
HGRN_DV = HGRN_DV_TOTAL // HGRN_HEADS
GLA_HEADS = 4
GLA_DV_TOTAL = MIX_HALF
GLA_DK_TOTAL = GLA_DV_TOTAL // 2
GLA_DK = GLA_DK_TOTAL // GLA_HEADS
GLA_DV = GLA_DV_TOTAL // GLA_HEADS
GLA_GATE_RANK = 16
GLA_GATE_NORMALIZER = 16.0

EVEN_SIZES = (CONV_DIM, CONV_DIM, CONV_DIM, MIX_HALF, MIX_HALF, MIX_HALF)
ODD_SIZES = (HGRN_DK_TOTAL, HGRN_DK_TOTAL, HGRN_DV_TOTAL, HGRN_DV_TOTAL,
             GLA_DK_TOTAL, GLA_DK_TOTAL, GLA_DV_TOTAL, GLA_DV_TOTAL, GLA_GATE_RANK)
EVEN_IN = 3 * CONV_DIM + 3 * MIX_HALF
ODD_IN = 2 * HGRN_DK_TOTAL + 2 * HGRN_DV_TOTAL + 2 * GLA_DK_TOTAL + 2 * GLA_DV_TOTAL + GLA_GATE_RANK
D_FF = 4 * D_MODEL
N_EVEN = (DEPTH + 1) // 2
N_ODD = DEPTH // 2

kernel_name = "hybrid_conv_chunkattn_hgrn2_gla_block"


def rmsnorm(x, g):
    x32 = x.astype(jnp.float32)
    y = x32 * lax.rsqrt(jnp.mean(x32 * x32, axis=-1, keepdims=True) + EPS)
    return (y * g.astype(jnp.float32)).astype(x.dtype)


def split_cols(t, sizes):
    idx = [int(v) for v in np.cumsum(sizes)[:-1]]
    return jnp.split(t, idx, axis=-1)


def short_conv_mixer(b_gate, c_gate, h, conv_w):
    u = c_gate * h
    s = u.shape[1]
    up = jnp.pad(u, ((0, 0), (CONV_WIDTH - 1, 0), (0, 0)))
    y = conv_w[0] * up[:, 0:s]
    for j in range(1, CONV_WIDTH):
        y = y + conv_w[j] * up[:, j:j + s]
    return b_gate * y


def chunked_band_attention(q, k, v, rel_bias):
    b, s, h, dh = q.shape
    nc = s // CHUNK
    pad = ((0, 0), (ATT_PAST_CHUNKS * CHUNK, 0), (0, 0), (0, 0))
    kp = jnp.pad(k, pad).reshape(b, nc + ATT_PAST_CHUNKS, CHUNK, h, dh)
    vp = jnp.pad(v, pad).reshape(b, nc + ATT_PAST_CHUNKS, CHUNK, h, dh)
    k_band = jnp.concatenate([kp[:, j:j + nc] for j in range(ATT_PAST_CHUNKS + 1)], axis=2)
    v_band = jnp.concatenate([vp[:, j:j + nc] for j in range(ATT_PAST_CHUNKS + 1)], axis=2)
    qc = q.reshape(b, nc, CHUNK, h, dh)
    scores = jnp.einsum('bnqhd,bnkhd->bhnqk', qc, k_band).astype(jnp.float32) * (dh ** -0.5)
    qi = np.arange(CHUNK)[:, None]
    ki = np.arange(ATT_BAND)[None, :]
    rel = ATT_PAST_CHUNKS * CHUNK + qi - ki
    idx = np.clip(rel, -(CHUNK - 1), REL_CLIP) + (CHUNK - 1)
    bias = rel_bias[:, idx].astype(jnp.float32)
    valid = (np.arange(nc)[:, None] + ki // CHUNK) >= ATT_PAST_CHUNKS
    scores = scores + bias[None, :, None]
    scores = jnp.where(valid[None, None, :, None, :], scores, -1e30)
    p = jax.nn.softmax(scores, axis=-1).astype(v.dtype)
    o = jnp.einsum('bhnqk,bnkhd->bnqhd', p, v_band)
    return o.reshape(b, s, h * dh)


def chunk_gated_recurrence(q, k, v, log_a):
    out_dtype = v.dtype
    b, s, h, dk = q.shape
    dv = v.shape[-1]
    nc = s // CHUNK

    def to_chunks(t):
        return t.astype(jnp.float32).reshape(b, nc, CHUNK, h, t.shape[-1]).transpose(1, 0, 3, 2, 4)

    qc, kc, vc = to_chunks(q), to_chunks(k), to_chunks(v)
    bc = jnp.cumsum(to_chunks(log_a), axis=3)
    causal = np.tril(np.ones((CHUNK, CHUNK), dtype=bool))[:, :, None]

    def step(state, inp):
        q_, k_, v_, b_ = inp
        diff = b_[:, :, :, None, :] - b_[:, :, None, :, :]
        decay = jnp.exp(jnp.where(causal, diff, -jnp.inf))
        scores = jnp.einsum('bhtd,bhsd,bhtsd->bhts', q_, k_, decay)
        o = jnp.einsum('bhts,bhse->bhte', scores, v_) + jnp.einsum('bhtd,bhde->bhte', q_ * jnp.exp(b_), state)
        b_last = b_[:, :, -1:, :]
        state = jnp.exp(b_last[:, :, 0, :])[..., None] * state + jnp.einsum('bhsd,bhse->bhde', k_ * jnp.exp(b_last - b_), v_)
        return state, o

    s0 = jnp.zeros((b, h, dk, dv), jnp.float32)
    _, o = lax.scan(step, s0, (qc, kc, vc, bc))
    return o.transpose(1, 0, 3, 2, 4).reshape(b, s, h, dv).astype(out_dtype)


def hgrn2_mixer(q_raw, f_raw, i_raw, g_raw, lb, norm_g):
    b, s, _ = q_raw.shape
    q = jax.nn.silu(q_raw).reshape(b, s, HGRN_HEADS, HGRN_EXPAND)
    f = lb + (1.0 - lb) * jax.nn.sigmoid(f_raw.astype(jnp.float32))
    log_f = jnp.log(f).reshape(b, s, HGRN_HEADS, HGRN_EXPAND)
    k = (1.0 - f).reshape(b, s, HGRN_HEADS, HGRN_EXPAND)
    i = i_raw.reshape(b, s, HGRN_HEADS, HGRN_DV)
    o = chunk_gated_recurrence(q, k, i, log_f)
    o = rmsnorm(o, norm_g.reshape(HGRN_HEADS, HGRN_DV)).reshape(b, s, HGRN_DV_TOTAL)
    return o * jax.nn.silu(g_raw)


def gla_mixer(q_raw, k_raw, v_raw, r_raw, a_lr, wa2, ba, norm_g):
    b, s, _ = q_raw.shape
    q = q_raw.reshape(b, s, GLA_HEADS, GLA_DK) * (GLA_DK ** -0.5)
    k = k_raw.reshape(b, s, GLA_HEADS, GLA_DK)
    v = v_raw.reshape(b, s, GLA_HEADS, GLA_DV)
    log_a = jax.nn.log_sigmoid((a_lr @ wa2 + ba).astype(jnp.float32)) / GLA_GATE_NORMALIZER
    o = chunk_gated_recurrence(q, k, v, log_a.reshape(b, s, GLA_HEADS, GLA_DK))
    o = rmsnorm(o, norm_g.reshape(GLA_HEADS, GLA_DV)).reshape(b, s, GLA_DV_TOTAL)
    return o * jax.nn.silu(r_raw)


def setup_inputs(seed: int = 0) -> dict:
    key = jax.random.key(seed)
    ks = jax.random.split(key, 16)
    f32 = jnp.float32
    nrm = lambda k, shape, sc: jax.random.normal(k, shape, f32) * sc
    return {
        "x": nrm(ks[0], (BATCH, SEQ, D_MODEL), 1.0),
        "norm_g": 1.0 + nrm(ks[1], (DEPTH, 4, D_MODEL), 0.02),
        "even_w_in": nrm(ks[2], (N_EVEN, D_MODEL, EVEN_IN), D_MODEL ** -0.5),
        "even_conv_w": nrm(ks[3], (N_EVEN, CONV_WIDTH, CONV_DIM), CONV_WIDTH ** -0.5),
        "even_rel_bias": nrm(ks[4], (N_EVEN, ATT_HEADS, REL_TABLE), 0.1),
        "even_w_out": nrm(ks[5], (N_EVEN, D_MODEL, D_MODEL), D_MODEL ** -0.5),
        "odd_w_in": nrm(ks[6], (N_ODD, D_MODEL, ODD_IN), D_MODEL ** -0.5),
        "hgrn_lb": nrm(ks[7], (DEPTH, HGRN_DK_TOTAL), 0.5),
        "hgrn_norm_g": 1.0 + nrm(ks[8], (N_ODD, HGRN_DV_TOTAL), 0.02),
        "gla_wa2": nrm(ks[9], (N_ODD, GLA_GATE_RANK, GLA_DK_TOTAL), GLA_GATE_RANK ** -0.5),
        "gla_ba": nrm(ks[10], (N_ODD, GLA_DK_TOTAL), 0.01),
        "gla_norm_g": 1.0 + nrm(ks[11], (N_ODD, GLA_DV_TOTAL), 0.02),
        "odd_w_out": nrm(ks[12], (N_ODD, D_MODEL, D_MODEL), D_MODEL ** -0.5),
        "mlp_w1": nrm(ks[13], (DEPTH, D_MODEL, D_FF), D_MODEL ** -0.5),
        "mlp_w2": nrm(ks[14], (DEPTH, D_FF, D_MODEL), D_FF ** -0.5),
    }


def reference(x, norm_g, even_w_in, even_conv_w, even_rel_bias, even_w_out,
              odd_w_in, hgrn_lb, hgrn_norm_g, gla_wa2, gla_ba, gla_norm_g, odd_w_out,
              mlp_w1, mlp_w2):
    b, s, _ = x.shape
    lb_soft = jax.nn.softmax(hgrn_lb.astype(jnp.float32), axis=0)
    lb_all = jnp.cumsum(lb_soft, axis=0) - lb_soft[0]
    h = x
    for l in range(DEPTH):
        g = norm_g[l]
        u = rmsnorm(h, g[0])
        if l % 2 == 0:
            e = l // 2
            proj = u @ even_w_in[e]
            b_gate, c_gate, hc, q, k, v = split_cols(proj, EVEN_SIZES)
            ya = short_conv_mixer(b_gate, c_gate, hc, even_conv_w[e])
            shp = (b, s, ATT_HEADS, ATT_HEAD_DIM)
            yb = chunked_band_attention(q.reshape(shp), k.reshape(shp), v.reshape(shp), even_rel_bias[e])
            y = jnp.concatenate([ya, yb], axis=-1) @ even_w_out[e]
        else:
            o_i = l // 2
            proj = u @ odd_w_in[o_i]
            hq, hf, hi, hg, gq, gk, gv, gr, ga = split_cols(proj, ODD_SIZES)
            yc = hgrn2_mixer(hq, hf, hi, hg, lb_all[l], hgrn_norm_g[o_i])
            yd = gla_mixer(gq, gk, gv, gr, ga, gla_wa2[o_i], gla_ba[o_i], gla_norm_g[o_i])
            y = jnp.concatenate([yc, yd], axis=-1) @ odd_w_out[o_i]
        h = h + rmsnorm(y, g[1])
        u = rmsnorm(h, g[2])
        z = jnp.square(jax.nn.relu(u @ mlp_w1[l])) @ mlp_w2[l]
        h = h + rmsnorm(z, g[3])
    return h
```

```cpp
#include <hip/hip_runtime.h>
#include <hip/hip_cooperative_groups.h>
#include <cstdio>
namespace cg = cooperative_groups;

#ifndef ONE_LAUNCH
#define ONE_LAUNCH 1
#endif

typedef unsigned short bf16_t;
typedef short bf16x8 __attribute__((ext_vector_type(8)));
typedef float f32x4 __attribute__((ext_vector_type(4)));
typedef unsigned u32x4 __attribute__((ext_vector_type(4)));
typedef unsigned u32x2 __attribute__((ext_vector_type(2)));
#define LAS __attribute__((address_space(3)))

constexpr int DM = 2048, NTOK = 16384, SEQ = 4096, DFF = 8192;
constexpr int LDE = 5120;
constexpr int LDO = 5376;
constexpr float EPS = 1e-6f;

constexpr size_t WS_WOUT = 0;
constexpr size_t WS_W1 = 8388608;
constexpr size_t WS_W2 = WS_W1 + 33554432;
constexpr size_t WS_U = WS_W2 + 33554432;
constexpr size_t WS_BIG = WS_U + 67108864;
constexpr size_t WS_WIN = WS_BIG + 268435456;
constexpr size_t WS_YZ = WS_WIN + 30408704;
constexpr size_t WS_VT_E = WS_BIG + (size_t)NTOK * LDE * 2;
constexpr size_t WS_VT_O = WS_BIG + (size_t)NTOK * LDO * 2;
constexpr size_t WS_ST = WS_VT_O + 67108864;
constexpr size_t WS_DEC = WS_ST + 134217728;
constexpr size_t WS_BAR = WS_DEC + 3072 * 128 * 4;
constexpr size_t WS_RS = WS_BAR + 16384;
constexpr size_t WS_END = WS_RS + 65536;

constexpr int LDS_BYTES = 131072 + 4096;

__device__ __forceinline__ float bf2f(bf16_t v) { return __uint_as_float(((unsigned)v) << 16); }
typedef float f32x2 __attribute__((ext_vector_type(2)));
typedef __bf16 bf16x2v __attribute__((ext_vector_type(2)));
__device__ __forceinline__ unsigned pk2(float lo, float hi) { f32x2 v = {lo, hi}; bf16x2v b = __builtin_convertvector(v, bf16x2v); return __builtin_bit_cast(unsigned, b); }
__device__ __forceinline__ bf16_t f2bf(float f) { return __builtin_bit_cast(bf16_t, (__bf16)f); }
__device__ __forceinline__ float wave_sum(float v) {
#pragma unroll
    for (int o = 1; o < 64; o <<= 1) v += __shfl_xor(v, o);
    return v;
}
__device__ __forceinline__ float frcp(float x) { return __builtin_amdgcn_rcpf(x); }
__device__ __forceinline__ float sigmoidf_(float x) { return frcp(1.f + __expf(-x)); }
#define LDS_WAIT() asm volatile("s_waitcnt lgkmcnt(0)" ::: "memory")
__device__ __forceinline__ float dpp_f(float v, int ctrl_sel) {
    const int x = __float_as_int(v); int y;
    if (ctrl_sel == 0) y = __builtin_amdgcn_update_dpp(x, x, 0xB1, 0xF, 0xF, false);
    else if (ctrl_sel == 1) y = __builtin_amdgcn_update_dpp(x, x, 0x4E, 0xF, 0xF, false);
    else if (ctrl_sel == 2) y = __builtin_amdgcn_update_dpp(x, x, 0x141, 0xF, 0xF, false);
    else y = __builtin_amdgcn_update_dpp(x, x, 0x140, 0xF, 0xF, false);
    return __int_as_float(y);
}
__device__ __forceinline__ float row16_max(float v) { v = fmaxf(v, dpp_f(v, 0)); v = fmaxf(v, dpp_f(v, 1)); v = fmaxf(v, dpp_f(v, 2)); v = fmaxf(v, dpp_f(v, 3)); return v; }
__device__ __forceinline__ float row16_sum(float v) { v += dpp_f(v, 0); v += dpp_f(v, 1); v += dpp_f(v, 2); v += dpp_f(v, 3); return v; }

namespace pg8 {
constexpr int BM = 256, BK = 64, HALF = 128, HTB = HALF * BK * 2, STAGE_BYTES = 8 * HTB, NXCD = 8, WGM = 8;
__host__ __device__ __forceinline__ int lds_byte(int r, int c) { const int st = (r >> 4) * 2 + (c >> 5), rr = r & 15, cc = c & 31, ob = rr * 64 + cc * 2; return st * 1024 + (ob ^ (((ob >> 9) & 1) << 5)); }
__host__ __device__ __forceinline__ void stage_rc(int b, int& R, int& C) { const int st = b / 1024, sb = b % 1024, swz = sb ^ (((sb >> 9) & 1) << 5); R = (st >> 1) * 16 + swz / 64; C = (st & 1) * 32 + (swz % 64) / 2; }
__host__ __device__ __forceinline__ int perm32(int rho) { const int n = rho >> 4, i = rho & 15; return 8 * (i >> 2) + 4 * n + (i & 3); }
struct Unit { int pm, pn; };
struct Gemm { const bf16_t* A; const bf16_t* Bt; int M, N, K; };
struct StaticOrder {
    int nM, nN, nwg, G, c;
    __device__ void init(int M, int N, int G_, int c_) { nM = M / BM; nN = N / BM; nwg = nM * nN; G = G_; c = c_; }
    __device__ bool next(int i, Unit& u) const {
        const long L = (long)i * G + c; if (L >= nwg) return false;
        int wgid = (int)L; { const int q = nwg / NXCD, r = nwg % NXCD, xcd = wgid % NXCD, off = wgid / NXCD; wgid = (xcd < r ? xcd * (q + 1) : r * (q + 1) + (xcd - r) * q) + off; }
        const int nig = WGM * nN, gid = wgid / nig, fm = gid * WGM, gsz = (nM - fm) < WGM ? (nM - fm) : WGM;
        u.pm = fm + ((wgid % nig) % gsz); u.pn = (wgid % nig) / gsz; return true;
    }
};
template <int ACT, int RS> struct EpiB {
    static constexpr bool PERM = true;
    bf16_t* O; int ldc; const float* rs;
    __device__ __forceinline__ void load_rs(const Unit& u, int wr, int fr, float (&rsv)[8]) const {
        if (RS == 1) {
#pragma unroll
            for (int q = 0; q < 8; ++q) rsv[q] = rs[u.pm * BM + wr * 64 + fr + (q >> 2) * HALF + (q & 3) * 16]; }
    }
    __device__ __forceinline__ void operator()(const f32x4 (&acc)[2][2][4][2], const Unit& u, int wr, int wc, int fr, int fq, const float (&rsv)[8]) const {
        const int row0 = u.pm * BM + wr * 64 + fr, col0 = u.pn * BM + wc * 32 + 8 * fq;
        f32x4 cs[2][2];
        if (RS == 2) {
#pragma unroll
            for (int bj = 0; bj < 2; ++bj) { cs[bj][0] = *(const f32x4*)(rs + col0 + bj * HALF); cs[bj][1] = *(const f32x4*)(rs + col0 + bj * HALF + 4); } }
#pragma unroll
        for (int ai = 0; ai < 2; ++ai)
#pragma unroll
            for (int m = 0; m < 4; ++m) { const int row = row0 + ai * HALF + m * 16; bf16_t* rowp = O + (size_t)row * ldc + col0;
                float rsc = 1.f; if (RS == 1) rsc = rsv[ai * 4 + m];
#pragma unroll
                for (int bj = 0; bj < 2; ++bj) { f32x4 v0 = acc[ai][bj][m][0], v1 = acc[ai][bj][m][1];
                    if (RS == 1) { v0 *= rsc; v1 *= rsc; }
                    if (RS == 2) { v0 *= cs[bj][0]; v1 *= cs[bj][1]; }
                    if (ACT == 1) {
#pragma unroll
                        for (int j = 0; j < 4; ++j) { float a = fmaxf(v0[j], 0.f), b = fmaxf(v1[j], 0.f); v0[j] = a * a; v1[j] = b * b; } }
                    u32x4 w; w.x = pk2(v0[0], v0[1]); w.y = pk2(v0[2], v0[3]); w.z = pk2(v1[0], v1[1]); w.w = pk2(v1[2], v1[3]);
                    *(u32x4*)(rowp + bj * HALF) = w; } }
    }
};

template <class Epi, class Sched>
__device__ __forceinline__ void gemm_phase(LAS unsigned char* lds, const Gemm g, const Sched& S, const Epi& E) {
    const int tid = threadIdx.x, wid = __builtin_amdgcn_readfirstlane(tid >> 6), lane = tid & 63, wr = wid >> 2, wc = wid & 3, fr = lane & 15, fq = lane >> 4;
    const int K = g.K, nt = K / BK;
    unsigned voffA[2], voffB[2];
#pragma unroll
    for (int i = 0; i < 2; ++i) { int R, C; stage_rc(tid * 16 + i * 8192, R, C); const int Rb = Epi::PERM ? ((R & ~31) + perm32(R & 31)) : R;
        voffA[i] = (unsigned)(R * K + C) * 2u; voffB[i] = (unsigned)(Rb * K + C) * 2u; }
    const size_t kstep = (size_t)(BK * 2);
    const size_t hstep = (size_t)HALF * K * 2;
    const size_t tstep = 2 * hstep;
    const unsigned ldsw = (unsigned)wid * 1024u;
    const int aoff = lds_byte(wr * 64 + fr, fq * 8), boff = lds_byte(wc * 32 + fr, fq * 8);
#define PG8_SA(b, h) (((b) * 2 + (h)) * HTB)
#define PG8_SB(b, h) ((4 + (b) * 2 + (h)) * HTB)
#define PG8_STAGE(bufoff, gbase, voff) do { _Pragma("unroll") for (int _i = 0; _i < 2; ++_i) \
        __builtin_amdgcn_global_load_lds((const unsigned*)((const char*)(gbase) + (voff)[_i]), (LAS unsigned*)(lds + (bufoff) + ldsw + _i * 8192), 16, 0, 0); } while (0)
#define PG8_LDA(dst, b, h) do { _Pragma("unroll") for (int m = 0; m < 4; ++m) _Pragma("unroll") for (int k = 0; k < 2; ++k) dst[m][k] = *(const LAS bf16x8*)(lds + PG8_SA(b, h) + aoff + m * 2048 + k * 1024); } while (0)
#define PG8_LDB(dst, b, h) do { _Pragma("unroll") for (int n = 0; n < 2; ++n) _Pragma("unroll") for (int k = 0; k < 2; ++k) dst[n][k] = *(const LAS bf16x8*)(lds + PG8_SB(b, h) + boff + n * 2048 + k * 1024); } while (0)
#define PG8_MMA(ai, bj, At, Bt) do { __builtin_amdgcn_s_setprio(1); _Pragma("unroll") for (int m = 0; m < 4; ++m) _Pragma("unroll") for (int n = 0; n < 2; ++n) _Pragma("unroll") for (int k = 0; k < 2; ++k) \
        acc[ai][bj][m][n] = __builtin_amdgcn_mfma_f32_16x16x32_bf16(Bt[n][k], At[m][k], acc[ai][bj][m][n], 0, 0, 0); __builtin_amdgcn_s_setprio(0); } while (0)
#define PG8_WAIT_V(n) asm volatile("s_waitcnt vmcnt(" #n ")" ::: "memory")
#define PG8_WAIT_L(n) asm volatile("s_waitcnt lgkmcnt(" #n ")" ::: "memory")
#define PG8_BAR __builtin_amdgcn_s_barrier()
#define PG8_SCHED __builtin_amdgcn_sched_barrier(0)
    Unit cur, nxt; int ui = 0;
    if (!S.next(0, cur)) return;
    f32x4 acc[2][2][4][2];
#pragma unroll
    for (int a = 0; a < 2; ++a)
#pragma unroll
        for (int b = 0; b < 2; ++b)
#pragma unroll
            for (int m = 0; m < 4; ++m)
#pragma unroll
                for (int n = 0; n < 2; ++n) acc[a][b][m][n] = (f32x4){0.f, 0.f, 0.f, 0.f};
    bf16x8 At[4][2], B0[2][2], B1[2][2];
    const char* cA = (const char*)g.A + (size_t)cur.pm * tstep; const char* cB = (const char*)g.Bt + (size_t)cur.pn * tstep;
    float rsv[8] = {1.f, 1.f, 1.f, 1.f, 1.f, 1.f, 1.f, 1.f};
    E.load_rs(cur, wr, fr, rsv);
    PG8_STAGE(PG8_SB(0, 0), cB, voffB); PG8_STAGE(PG8_SB(0, 1), cB + hstep, voffB); PG8_STAGE(PG8_SA(0, 0), cA, voffA); PG8_STAGE(PG8_SA(0, 1), cA + hstep, voffA);
    if (wr == 1) PG8_BAR;
    PG8_WAIT_V(2); PG8_BAR;
    PG8_STAGE(PG8_SB(1, 0), cB + kstep, voffB); PG8_STAGE(PG8_SA(1, 0), cA + kstep, voffA); PG8_STAGE(PG8_SB(1, 1), cB + hstep + kstep, voffB);
    PG8_WAIT_V(6); PG8_BAR;
    for (;;) {
        const bool has_next = S.next(ui + 1, nxt);
        const char* nA = has_next ? (const char*)g.A + (size_t)nxt.pm * tstep : cA; const char* nB = has_next ? (const char*)g.Bt + (size_t)nxt.pn * tstep : cB;
        for (int t = 0; t < nt; t += 2) {
            const bool last = (t == nt - 2);
            const char* a1 = cA + (size_t)(t + 1) * kstep;
            const char* a2 = last ? nA : cA + (size_t)(t + 2) * kstep; const char* b2 = last ? nB : cB + (size_t)(t + 2) * kstep;
            const char* a3 = a2 + kstep; const char* b3 = b2 + kstep;
            PG8_LDB(B0, 0, 0); PG8_LDB(B1, 0, 1); PG8_SCHED; PG8_LDA(At, 0, 0); PG8_STAGE(PG8_SA(1, 1), a1 + hstep, voffA);
            PG8_WAIT_V(8); PG8_WAIT_L(0); PG8_BAR; PG8_MMA(0, 0, At, B0); PG8_MMA(0, 1, At, B1); PG8_BAR; PG8_SCHED;
            PG8_LDA(At, 0, 1); PG8_STAGE(PG8_SB(0, 0), b2, voffB); PG8_STAGE(PG8_SB(0, 1), b2 + hstep, voffB); PG8_STAGE(PG8_SA(0, 0), a2, voffA);
            PG8_WAIT_V(8); PG8_WAIT_L(0); PG8_BAR; PG8_MMA(1, 0, At, B0); PG8_MMA(1, 1, At, B1); PG8_BAR; PG8_SCHED;
            PG8_LDB(B0, 1, 0); PG8_LDB(B1, 1, 1); PG8_SCHED; PG8_LDA(At, 1, 0); PG8_STAGE(PG8_SA(0, 1), a2 + hstep, voffA);
            PG8_WAIT_V(8); PG8_WAIT_L(0); PG8_BAR; PG8_MMA(0, 0, At, B0); PG8_MMA(0, 1, At, B1); PG8_BAR; PG8_SCHED;
            PG8_LDA(At, 1, 1); PG8_STAGE(PG8_SB(1, 0), b3, voffB); PG8_STAGE(PG8_SB(1, 1), b3 + hstep, voffB); PG8_STAGE(PG8_SA(1, 0), a3, voffA);
            PG8_WAIT_V(8); PG8_WAIT_L(0); PG8_BAR; PG8_MMA(1, 0, At, B0); PG8_MMA(1, 1, At, B1); PG8_BAR; PG8_SCHED;
        }
        if (wr == 0) PG8_BAR;
        E(acc, cur, wr, wc, fr, fq, rsv);
        if (!has_next) break;
        E.load_rs(nxt, wr, fr, rsv);
#pragma unroll
        for (int a = 0; a < 2; ++a)
#pragma unroll
            for (int b = 0; b < 2; ++b)
#pragma unroll
                for (int m = 0; m < 4; ++m)
#pragma unroll
                    for (int n = 0; n < 2; ++n) acc[a][b][m][n] = (f32x4){0.f, 0.f, 0.f, 0.f};
        cur = nxt; cA = nA; cB = nB; ++ui;
        if (wr == 1) PG8_BAR;
    }
    PG8_WAIT_V(0);
    PG8_BAR;
#undef PG8_SA
#undef PG8_SB
#undef PG8_STAGE
#undef PG8_LDA
#undef PG8_LDB
#undef PG8_MMA
#undef PG8_WAIT_V
#undef PG8_WAIT_L
#undef PG8_BAR
#undef PG8_SCHED
}
}

struct Params {
    const float* x; const float* norm_g; const float* even_w_in; const float* conv_w; const float* rel_bias; const float* even_w_out;
    const float* odd_w_in; const float* hgrn_lb; const float* hgrn_ng; const float* wa2; const float* ba; const float* gla_ng; const float* odd_w_out;
    const float* w1; const float* w2; float* out; unsigned char* ws; int ph_lo, ph_hi;
};

__device__ __forceinline__ void cvt_seg(const float* __restrict__ W, int K, int NS, int c0, int nc, bf16_t* __restrict__ WT, int r0, const float* __restrict__ gf, float* scr, int gw, int NGW, int lane) {
    const int nblk = (nc + 31) >> 5, nitems = (K >> 6) * nblk;
    const int krow = lane >> 3, c4 = (lane & 7) * 4;
    for (int it = gw; it < nitems; it += NGW) {
        const int kb = it / nblk, nb = it - kb * nblk, k0 = kb * 64, n0 = nb * 32;
        const bool ok = (n0 + c4) < nc;
        const float* src = W + (size_t)(k0 + krow) * NS + c0 + n0 + c4;
        f32x4 v[8];
#pragma unroll
        for (int i = 0; i < 8; ++i) v[i] = ok ? *(const f32x4*)(src + (size_t)(8 * i) * NS) : (f32x4){0.f, 0.f, 0.f, 0.f};
        if (gf) {
#pragma unroll
            for (int i = 0; i < 8; ++i) v[i] *= gf[k0 + 8 * i + krow]; }
#pragma unroll
        for (int i = 0; i < 8; ++i) { float* d = scr + (8 * i + krow) * 33 + c4; d[0] = v[i][0]; d[1] = v[i][1]; d[2] = v[i][2]; d[3] = v[i][3]; }
        LDS_WAIT();
        const int c = lane & 7;
#pragma unroll
        for (int j = 0; j < 4; ++j) { const int n = (lane >> 3) + 8 * j; const float* s = scr + (8 * c) * 33 + n;
            u32x4 o; o.x = pk2(s[0], s[33]); o.y = pk2(s[66], s[99]); o.z = pk2(s[132], s[165]); o.w = pk2(s[198], s[231]);
            if (n0 + n < nc) *(u32x4*)(WT + (size_t)(r0 + n0 + n) * K + k0 + 8 * c) = o; }
        LDS_WAIT();
    }
}

template <int MODE>
__device__ __forceinline__ void rowwise(const float* __restrict__ xin, const bf16_t* __restrict__ ysrc, const float* __restrict__ g1,
                                        bf16_t* hb, float* __restrict__ rsout, float* __restrict__ out, int gw, int NGW, int lane) {
    for (int row0 = gw; row0 < NTOK; row0 += 2 * NGW) {
        f32x4 h[2][4][2]; u32x4 yw[2][4], hw[2][4];
#pragma unroll
        for (int rr = 0; rr < 2; ++rr) { const size_t rb = (size_t)(row0 + rr * NGW) * DM;
#pragma unroll
            for (int j = 0; j < 4; ++j) { const int col = 512 * j + 8 * lane;
                if (MODE == 0) { h[rr][j][0] = *(const f32x4*)(xin + rb + col); h[rr][j][1] = *(const f32x4*)(xin + rb + col + 4); }
                else { hw[rr][j] = *(const u32x4*)(hb + rb + col); yw[rr][j] = *(const u32x4*)(ysrc + rb + col); } } }
#pragma unroll
        for (int rr = 0; rr < 2; ++rr) {
            const int row = row0 + rr * NGW; const size_t rb = (size_t)row * DM;
            if (MODE != 0) {
                float y[4][8]; float ss = 0.f;
#pragma unroll
                for (int j = 0; j < 4; ++j) {
#pragma unroll
                    for (int e = 0; e < 4; ++e) { y[j][2 * e] = __uint_as_float(yw[rr][j][e] << 16); y[j][2 * e + 1] = __uint_as_float(yw[rr][j][e] & 0xffff0000u);
                        h[rr][j][e >> 1][(2 * e) & 3] = __uint_as_float(hw[rr][j][e] << 16); h[rr][j][e >> 1][(2 * e + 1) & 3] = __uint_as_float(hw[rr][j][e] & 0xffff0000u); }
#pragma unroll
                    for (int e = 0; e < 8; ++e) ss += y[j][e] * y[j][e]; }
                const float rs = rsqrtf(wave_sum(ss) * (1.f / DM) + EPS);
#pragma unroll
                for (int j = 0; j < 4; ++j) { const int col = 512 * j + 8 * lane; const f32x4 ga = *(const f32x4*)(g1 + col), gb = *(const f32x4*)(g1 + col + 4);
#pragma unroll
                    for (int e = 0; e < 4; ++e) { h[rr][j][0][e] += y[j][e] * rs * ga[e]; h[rr][j][1][e] += y[j][4 + e] * rs * gb[e]; }
                    if (MODE == 2) { *(f32x4*)(out + rb + col) = h[rr][j][0]; *(f32x4*)(out + rb + col + 4) = h[rr][j][1]; } }
            }
            if (MODE != 2) {
                float ss = 0.f;
#pragma unroll
                for (int j = 0; j < 4; ++j)
#pragma unroll
                    for (int e = 0; e < 4; ++e) ss += h[rr][j][0][e] * h[rr][j][0][e] + h[rr][j][1][e] * h[rr][j][1][e];
                const float rs = rsqrtf(wave_sum(ss) * (1.f / DM) + EPS);
                if (lane == 0) rsout[row] = rs;
#pragma unroll
                for (int j = 0; j < 4; ++j) { const int col = 512 * j + 8 * lane;
                    u32x4 o; o.x = pk2(h[rr][j][0][0], h[rr][j][0][1]); o.y = pk2(h[rr][j][0][2], h[rr][j][0][3]);
                    o.z = pk2(h[rr][j][1][0], h[rr][j][1][1]); o.w = pk2(h[rr][j][1][2], h[rr][j][1][3]);
                    *(u32x4*)(hb + rb + col) = o; }
            }
        }
    }
}

__device__ __forceinline__ void conv_phase(const bf16_t* __restrict__ P, const float* __restrict__ cw, bf16_t* __restrict__ ycat) {
    const int nthr = gridDim.x * 512;
#pragma unroll 2
    for (int it = blockIdx.x * 512 + threadIdx.x; it < NTOK * 128; it += nthr) {
        const int t = it >> 7, c0 = (it & 127) * 8, tp = t & (SEQ - 1);
        const bf16_t* row = P + (size_t)t * LDE + c0;
        const u32x4 bg = *(const u32x4*)(row), c2 = *(const u32x4*)(row + 1024), h2 = *(const u32x4*)(row + 2048);
        u32x4 c1 = (u32x4){0, 0, 0, 0}, h1 = c1, cz = c1, hz = c1;
        if (tp >= 1) { c1 = *(const u32x4*)(row - LDE + 1024); h1 = *(const u32x4*)(row - LDE + 2048); }
        if (tp >= 2) { cz = *(const u32x4*)(row - 2 * LDE + 1024); hz = *(const u32x4*)(row - 2 * LDE + 2048); }
        float o[8];
#pragma unroll
        for (int e = 0; e < 8; ++e) {
            const int sh = (e & 1) ? 0 : 16; const int w = e >> 1;
            auto get = [&](const u32x4& v) { return __uint_as_float((v[w] << sh) & 0xffff0000u); };
            const float u2 = get(c2) * get(h2), u1 = get(c1) * get(h1), u0 = get(cz) * get(hz);
            const float y = cw[c0 + e] * u0 + cw[1024 + c0 + e] * u1 + cw[2048 + c0 + e] * u2;
            o[e] = get(bg) * y;
        }
        u32x4 w; w.x = pk2(o[0], o[1]); w.y = pk2(o[2], o[3]); w.z = pk2(o[4], o[5]); w.w = pk2(o[6], o[7]);
        *(u32x4*)(ycat + (size_t)t * DM + c0) = w;
    }
}

__device__ __forceinline__ void attn_phase(unsigned char* smem, const bf16_t* __restrict__ P, const bf16_t* __restrict__ VT, const float* __restrict__ relb, bf16_t* __restrict__ ycat) {
    const int tid = threadIdx.x, lane = tid & 63, wave = tid >> 6, half = wave >> 2, w4 = wave & 3, ltid = tid & 255, r = lane & 15, q8 = lane >> 4;
    unsigned char* base = smem + half * 47616;
    bf16_t* kS = (bf16_t*)base;
    bf16_t* vS = (bf16_t*)(base + 17408);
    bf16_t* pS = (bf16_t*)(base + 35840);
    float* bS = (float*)(base + 45056);
    const float scale = 0.08838834764831845f * 1.4426950408889634f;
    for (int pair = blockIdx.x; pair < 1024; pair += gridDim.x) {
        const int hp = pair & 3, n = (pair >> 2) & 63, b = pair >> 8, head = hp * 2 + half;
        const int tok0 = b * SEQ + n * 64;
        __syncthreads();
        for (int i = ltid; i < 640; i += 256) bS[i] = relb[head * 320 + (i < 319 ? i : 319)] * 1.4426950408889634f;
        bf16x8 qf[4];
        { const bf16_t* qp = P + (size_t)(tok0 + 16 * w4 + r) * LDE + 3072 + head * 128 + 8 * q8;
#pragma unroll
          for (int kk = 0; kk < 4; ++kk) qf[kk] = *(const bf16x8*)(qp + 32 * kk); }
        float m[4], l[4]; f32x4 o[8];
#pragma unroll
        for (int j = 0; j < 4; ++j) { m[j] = -1e30f; l[j] = 0.f; }
#pragma unroll
        for (int i = 0; i < 8; ++i) o[i] = (f32x4){0.f, 0.f, 0.f, 0.f};
        const int js0 = (n < 8 ? 8 - n : 0);
        u32x4 kA[4], vA[4], kB[4], vB[4];
#define ATT_LOAD(KR, VR, JS) do { const int _kt = tok0 + ((JS) - 8) * 64; _Pragma("unroll") for (int i = 0; i < 4; ++i) { const int ch = ltid + 256 * i; \
            KR[i] = *(const u32x4*)(P + (size_t)(_kt + (ch >> 4)) * LDE + 4096 + head * 128 + (ch & 15) * 8); \
            VR[i] = *(const u32x4*)(VT + (size_t)(head * 128 + (ch >> 3)) * NTOK + _kt + (ch & 7) * 8); } } while (0)
        ATT_LOAD(kA, vA, js0);
        if (js0 < 8) ATT_LOAD(kB, vB, js0 + 1);
        auto tile = [&](u32x4 (&KR)[4], u32x4 (&VR)[4], const int js) {
            __syncthreads();
#pragma unroll
            for (int i = 0; i < 4; ++i) { const int ch = ltid + 256 * i;
                *(u32x4*)(kS + (ch >> 4) * 136 + (ch & 15) * 8) = KR[i];
                *(u32x4*)(vS + (ch >> 3) * 72 + (ch & 7) * 8) = VR[i]; }
            __syncthreads();
            if (js + 2 <= 8) ATT_LOAD(KR, VR, js + 2);
            f32x4 s[4];
#pragma unroll
            for (int nt = 0; nt < 4; ++nt) { s[nt] = (f32x4){0.f, 0.f, 0.f, 0.f};
#pragma unroll
                for (int kk = 0; kk < 4; ++kk) { const bf16x8 kf = *(const bf16x8*)(kS + (16 * nt + r) * 136 + 32 * kk + 8 * q8);
                    s[nt] = __builtin_amdgcn_mfma_f32_16x16x32_bf16(qf[kk], kf, s[nt], 0, 0, 0); } }
            float alpha[4];
            const float* bT = bS + (16 * w4 + 4 * q8 - r + 63 + (8 - js) * 64);
#pragma unroll
            for (int j = 0; j < 4; ++j) {
                float mx = -1e30f;
#pragma unroll
                for (int nt = 0; nt < 4; ++nt) { const float v = s[nt][j] * scale + bT[j - 16 * nt]; s[nt][j] = v; mx = fmaxf(mx, v); }
                mx = row16_max(mx);
                const float mn = fmaxf(m[j], mx); alpha[j] = __builtin_amdgcn_exp2f(m[j] - mn); m[j] = mn;
                float ps = 0.f;
#pragma unroll
                for (int nt = 0; nt < 4; ++nt) { const float pp = __builtin_amdgcn_exp2f(s[nt][j] - mn); ps += pp; pS[(16 * w4 + 4 * q8 + j) * 72 + 16 * nt + r] = f2bf(pp); }
                l[j] = l[j] * alpha[j] + ps;
            }
#pragma unroll
            for (int i = 0; i < 8; ++i)
#pragma unroll
                for (int j = 0; j < 4; ++j) o[i][j] *= alpha[j];
            LDS_WAIT();
#pragma unroll
            for (int kk = 0; kk < 2; ++kk) { const bf16x8 pf = *(const bf16x8*)(pS + (16 * w4 + r) * 72 + 32 * kk + 8 * q8);
#pragma unroll
                for (int i = 0; i < 8; ++i) { const bf16x8 vf = *(const bf16x8*)(vS + (16 * i + r) * 72 + 32 * kk + 8 * q8);
                    o[i] = __builtin_amdgcn_mfma_f32_16x16x32_bf16(pf, vf, o[i], 0, 0, 0); } }
        };
        for (int js = js0; js <= 8; js += 2) { tile(kA, vA, js); if (js + 1 <= 8) tile(kB, vB, js + 1); }
#pragma unroll
        for (int j = 0; j < 4; ++j) { float lt = l[j];
#pragma unroll
            for (int ofs = 1; ofs < 16; ofs <<= 1) lt += __shfl_xor(lt, ofs);
            const float inv = frcp(lt);
            bf16_t* op = ycat + (size_t)(tok0 + 16 * w4 + 4 * q8 + j) * DM + 1024 + head * 128 + r;
#pragma unroll
            for (int i = 0; i < 8; ++i) op[16 * i] = f2bf(o[i][j] * inv); }
    }
}

template <int KIND, bool WANT_Q>
__device__ __forceinline__ void decay_qk(const Params& p, const bf16_t* __restrict__ P, int tok0, int hd, int d, int tq, float (&bl)[16], float (&kv)[16], float (&qv)[16]) {
    const int col = hd * 128 + d;
    const bf16_t* rp = P + (size_t)(tok0 + 16 * tq) * LDO;
    if (KIND == 0) {
        const float lb = frcp(1.f + __expf(p.hgrn_lb[col] - p.hgrn_lb[1024 + col]));
        float run = 0.f;
#pragma unroll
        for (int jj = 0; jj < 16; ++jj) {
            const float fr = bf2f(rp[(size_t)jj * LDO + 1024 + col]);
            const float f = lb + (1.f - lb) * sigmoidf_(fr);
            run += __logf(f); bl[jj] = run; kv[jj] = 1.f - f;
            if (WANT_Q) { const float qr = bf2f(rp[(size_t)jj * LDO + col]); qv[jj] = qr * sigmoidf_(qr); }
        }
    } else {
        float w[16];
#pragma unroll
        for (int rr = 0; rr < 16; ++rr) w[rr] = p.wa2[rr * 512 + col];
        const float bias = p.ba[col];
        float run = 0.f;
#pragma unroll
        for (int jj = 0; jj < 16; ++jj) {
            const u32x4 g0 = *(const u32x4*)(rp + (size_t)jj * LDO + 5120), g1 = *(const u32x4*)(rp + (size_t)jj * LDO + 5128);
            float xx = bias;
#pragma unroll
            for (int e = 0; e < 4; ++e) {
                xx += __uint_as_float(g0[e] << 16) * w[2 * e] + __uint_as_float(g0[e] & 0xffff0000u) * w[2 * e + 1];
                xx += __uint_as_float(g1[e] << 16) * w[8 + 2 * e] + __uint_as_float(g1[e] & 0xffff0000u) * w[8 + 2 * e + 1];
            }
            const float ls = fminf(xx, 0.f) - __logf(1.f + __expf(-fabsf(xx)));
            run += ls * (1.f / 16.f); bl[jj] = run;
            kv[jj] = bf2f(rp[(size_t)jj * LDO + 3584 + col]);
            if (WANT_Q) qv[jj] = bf2f(rp[(size_t)jj * LDO + 3072 + col]) * 0.08838834764831845f;
        }
    }
}

template <int KIND>
__device__ __forceinline__ void passA_item(const Params& p, unsigned char* smem_base, const bf16_t* __restrict__ P, const bf16_t* __restrict__ VT, bf16_t* __restrict__ ST, float* __restrict__ DEC, int idx, int par) {
    unsigned char* smem = smem_base + par * 57344;
    constexpr int DV = KIND ? 256 : 128;
    const int tid = threadIdx.x, lane = tid & 63, wave = tid >> 6, r = lane & 15, q8 = lane >> 4, d = tid & 127, tq = tid >> 7;
    const int c = idx & 63, bh = idx >> 6, hd = KIND ? (bh & 3) : (bh & 7), b = KIND ? (bh >> 2) : (bh >> 3);
    const int tok0 = b * SEQ + c * 64;
    bf16_t* kT = (bf16_t*)smem;
    bf16_t* vS = (bf16_t*)(smem + 18432);
    float* tot = (float*)(smem + 18432 + 36864);
    float bl[16], kv[16], qv[16];
    u32x4 vr[DV / 64];
    { const bf16_t* vsrc = VT + (size_t)((KIND ? 1024 + hd * 256 : hd * 128)) * NTOK + tok0;
#pragma unroll
      for (int i = 0; i < DV / 64; ++i) { const int ch = tid + 512 * i, row = ch >> 3, c8 = ch & 7; vr[i] = *(const u32x4*)(vsrc + (size_t)row * NTOK + c8 * 8); } }
    decay_qk<KIND, false>(p, P, tok0, hd, d, tq, bl, kv, qv);
    tot[tq * 128 + d] = bl[15];
#pragma unroll
    for (int i = 0; i < DV / 64; ++i) { const int ch = tid + 512 * i, row = ch >> 3, c8 = ch & 7; *(u32x4*)(vS + row * 72 + c8 * 8) = vr[i]; }
    __syncthreads();
    const float t0 = tot[d], t1 = tot[128 + d], t2 = tot[256 + d], t3 = tot[384 + d];
    const float r4 = t0 + t1 + t2 + t3;
    const float rpre = (tq > 0 ? t0 : 0.f) + (tq > 1 ? t1 : 0.f) + (tq > 2 ? t2 : 0.f);
    {
        float kt[16];
#pragma unroll
        for (int jj = 0; jj < 16; ++jj) kt[jj] = kv[jj] * __expf(r4 - rpre - bl[jj]);
        u32x4 w0, w1;
        w0.x = pk2(kt[0], kt[1]); w0.y = pk2(kt[2], kt[3]); w0.z = pk2(kt[4], kt[5]); w0.w = pk2(kt[6], kt[7]);
        w1.x = pk2(kt[8], kt[9]); w1.y = pk2(kt[10], kt[11]); w1.z = pk2(kt[12], kt[13]); w1.w = pk2(kt[14], kt[15]);
        *(u32x4*)(kT + d * 72 + 16 * tq) = w0; *(u32x4*)(kT + d * 72 + 16 * tq + 8) = w1;
    }
    const int gitem = (KIND ? 2048 : 0) + idx;
    if (tq == 0) DEC[(size_t)gitem * 128 + d] = __expf(r4);
    __syncthreads();
    const int d0 = 16 * wave;
    bf16x8 af[2];
#pragma unroll
    for (int kk = 0; kk < 2; ++kk) af[kk] = *(const bf16x8*)(kT + (d0 + r) * 72 + 32 * kk + 8 * q8);
    bf16_t* stb = ST + (KIND ? (size_t)33554432 : 0) + (size_t)idx * (DV * 128);
#pragma unroll
    for (int nt = 0; nt < DV / 16; ++nt) {
        f32x4 acc = (f32x4){0.f, 0.f, 0.f, 0.f};
#pragma unroll
        for (int kk = 0; kk < 2; ++kk) { const bf16x8 bfr = *(const bf16x8*)(vS + (16 * nt + r) * 72 + 32 * kk + 8 * q8);
            acc = __builtin_amdgcn_mfma_f32_16x16x32_bf16(af[kk], bfr, acc, 0, 0, 0); }
        u32x2 w; w.x = pk2(acc[0], acc[1]); w.y = pk2(acc[2], acc[3]);
        *(u32x2*)(stb + (size_t)(16 * nt + r) * 128 + d0 + 4 * q8) = w;
    }
}

__device__ __forceinline__ void scan_phase(bf16_t* __restrict__ ST, const float* __restrict__ DEC) {
    const int nthr = gridDim.x * 512;
    for (int gid = blockIdx.x * 512 + threadIdx.x; gid < 131072; gid += nthr) {
        const int kind = gid >> 16, v = gid & 65535;
        const int vper = kind ? 4096 : 2048, bh = v / vper, vi = v - bh * vper, d0 = (vi * 8) & 127;
        const size_t csz = kind ? 32768 : 16384;
        bf16_t* sp = ST + (kind ? (size_t)33554432 : 0) + (size_t)bh * 64 * csz + (size_t)vi * 8;
        const float* dp = DEC + (size_t)((kind ? 2048 : 0) + bh * 64) * 128 + d0;
        float S[8];
#pragma unroll
        for (int e = 0; e < 8; ++e) S[e] = 0.f;
#pragma unroll 8
        for (int c = 0; c < 64; ++c) {
            const u32x4 u = *(const u32x4*)(sp + (size_t)c * csz);
            const f32x4 da = *(const f32x4*)(dp + c * 128), db = *(const f32x4*)(dp + c * 128 + 4);
            u32x4 w; w.x = pk2(S[0], S[1]); w.y = pk2(S[2], S[3]); w.z = pk2(S[4], S[5]); w.w = pk2(S[6], S[7]);
            *(u32x4*)(sp + (size_t)c * csz) = w;
#pragma unroll
            for (int e = 0; e < 4; ++e) {
                S[2 * e] = S[2 * e] * (e < 2 ? da[2 * e] : db[2 * e - 4]) + __uint_as_float(u[e] << 16);
                S[2 * e + 1] = S[2 * e + 1] * (e < 2 ? da[2 * e + 1] : db[2 * e - 3]) + __uint_as_float(u[e] & 0xffff0000u);
            }
        }
    }
}

template <int KIND>
__device__ __forceinline__ void passC_item(const Params& p, unsigned char* smem, const bf16_t* __restrict__ P, const bf16_t* __restrict__ VT, const bf16_t* __restrict__ ST, bf16_t* __restrict__ ycat, int idx) {
    constexpr int DV = KIND ? 256 : 128;
    const int tid = threadIdx.x, lane = tid & 63, wave = tid >> 6, r = lane & 15, q8 = lane >> 4, d = tid & 127, tq = tid >> 7;
    const int c = idx & 63, bh = idx >> 6, hd = KIND ? (bh & 3) : (bh & 7), b = KIND ? (bh >> 2) : (bh >> 3);
    const int tok0 = b * SEQ + c * 64;
    bf16_t* qs = (bf16_t*)smem;
    bf16_t* qh = (bf16_t*)(smem + 17408);
    bf16_t* ks = (bf16_t*)(smem + 34816);
    bf16_t* vS = (bf16_t*)(smem + 78336);
    bf16_t* pS = (bf16_t*)(smem + 115200);
    float* tot = (float*)(smem + 124416);
    float* ssq = (float*)(smem + 126464);
    float bl[16], kv[16], qv[16];
    u32x4 vr[DV / 64];
    { const bf16_t* vsrc = VT + (size_t)((KIND ? 1024 + hd * 256 : hd * 128)) * NTOK + tok0;
#pragma unroll
      for (int i = 0; i < DV / 64; ++i) { const int ch = tid + 512 * i, row = ch >> 3, c8 = ch & 7; vr[i] = *(const u32x4*)(vsrc + (size_t)row * NTOK + c8 * 8); } }
    decay_qk<KIND, true>(p, P, tok0, hd, d, tq, bl, kv, qv);
    tot[tq * 128 + d] = bl[15];
#pragma unroll
    for (int i = 0; i < DV / 64; ++i) { const int ch = tid + 512 * i, row = ch >> 3, c8 = ch & 7; *(u32x4*)(vS + row * 72 + c8 * 8) = vr[i]; }
    for (int i = tid; i < 64 * 72 / 8; i += 512) *(u32x4*)(pS + i * 8) = (u32x4){0, 0, 0, 0};
    __syncthreads();
    constexpr int NT = DV / 32;
    constexpr int NPRE = 4;
    const int oi = wave & 3, oeh = wave >> 2;
    const bf16_t* stb = ST + (KIND ? (size_t)33554432 : 0) + (size_t)idx * (DV * 128);
    const int gcol = KIND ? 4096 + hd * 256 : 2048 + hd * 128;
    bf16x8 bst[NPRE][4];
#pragma unroll
    for (int nt = 0; nt < NPRE; ++nt)
#pragma unroll
        for (int kk = 0; kk < 4; ++kk) bst[nt][kk] = *(const bf16x8*)(stb + (size_t)(oeh * (DV / 2) + 16 * nt + r) * 128 + 32 * kk + 8 * q8);
    bf16_t graw[4][NT];
#pragma unroll
    for (int j = 0; j < 4; ++j)
#pragma unroll
        for (int nt = 0; nt < NT; ++nt) graw[j][nt] = P[(size_t)(tok0 + 16 * oi + 4 * q8 + j) * LDO + gcol + oeh * (DV / 2) + 16 * nt + r];
    {
        const float t0 = tot[d], t1 = tot[128 + d], t2 = tot[256 + d];
        const float rpre = (tq > 0 ? t0 : 0.f) + (tq > 1 ? t1 : 0.f) + (tq > 2 ? t2 : 0.f);
        const float Ttq = bl[15], rn = rpre + Ttq;
        const float einv = __expf(fminf(-Ttq, 80.f));
        const float f1 = (tq == 1) ? einv : __expf(fminf(t0 - rn, 0.f));
        const float f2 = (tq == 2) ? einv : __expf(fminf(t0 + t1 - rn, 0.f));
        const float f3 = (tq == 3) ? einv : __expf(fminf(t0 + t1 + t2 - rn, 0.f));
        const float erp = __expf(rpre);
#pragma unroll
        for (int jj = 0; jj < 16; ++jj) {
            const int t = 16 * tq + jj;
            const float ql = qv[jj] * __expf(bl[jj]);
            qs[t * 136 + d] = f2bf(ql);
            qh[t * 136 + d] = f2bf(ql * erp);
            const float kb = kv[jj] * __expf(Ttq - bl[jj]);
            if (tq == 0) ks[(0 + t) * 136 + d] = f2bf(kb * einv);
            if (tq <= 1) ks[(16 + t) * 136 + d] = f2bf(kb * f1);
            if (tq <= 2) ks[(48 + t) * 136 + d] = f2bf(kb * f2);
            ks[(96 + t) * 136 + d] = f2bf(kb * f3);
        }
    }
    __syncthreads();
    {
        const int i = wave >> 1, off = 8 * i * (i + 1);
        bf16x8 af[4];
#pragma unroll
        for (int kk = 0; kk < 4; ++kk) af[kk] = *(const bf16x8*)(qs + (16 * i + r) * 136 + 32 * kk + 8 * q8);
        for (int jt = (wave & 1); jt <= i; jt += 2) {
            f32x4 acc = (f32x4){0.f, 0.f, 0.f, 0.f};
#pragma unroll
            for (int kk = 0; kk < 4; ++kk) { const bf16x8 bfr = *(const bf16x8*)(ks + (off + 16 * jt + r) * 136 + 32 * kk + 8 * q8);
                acc = __builtin_amdgcn_mfma_f32_16x16x32_bf16(af[kk], bfr, acc, 0, 0, 0); }
#pragma unroll
            for (int j = 0; j < 4; ++j) { float v = acc[j]; if (jt == i && r > 4 * q8 + j) v = 0.f;
                pS[(16 * i + 4 * q8 + j) * 72 + 16 * jt + r] = f2bf(v); }
        }
    }
    __syncthreads();
    {
        const int i = oi, eh = oeh;
        bf16x8 ap[2], aq[4];
#pragma unroll
        for (int kk = 0; kk < 2; ++kk) ap[kk] = *(const bf16x8*)(pS + (16 * i + r) * 72 + 32 * kk + 8 * q8);
#pragma unroll
        for (int kk = 0; kk < 4; ++kk) aq[kk] = *(const bf16x8*)(qh + (16 * i + r) * 136 + 32 * kk + 8 * q8);
        f32x4 o[NT];
        float ss[4] = {0.f, 0.f, 0.f, 0.f};
#pragma unroll
        for (int nt = 0; nt < NT; ++nt) {
            const int e0 = eh * (DV / 2) + 16 * nt;
            f32x4 acc = (f32x4){0.f, 0.f, 0.f, 0.f};
#pragma unroll
            for (int kk = 0; kk < 2; ++kk) { const bf16x8 bfr = *(const bf16x8*)(vS + (e0 + r) * 72 + 32 * kk + 8 * q8);
                acc = __builtin_amdgcn_mfma_f32_16x16x32_bf16(ap[kk], bfr, acc, 0, 0, 0); }
#pragma unroll
            for (int kk = 0; kk < 4; ++kk) { bf16x8 bfr;
                if (nt < NPRE) bfr = bst[nt < NPRE ? nt : 0][kk]; else bfr = *(const bf16x8*)(stb + (size_t)(e0 + r) * 128 + 32 * kk + 8 * q8);
                acc = __builtin_amdgcn_mfma_f32_16x16x32_bf16(aq[kk], bfr, acc, 0, 0, 0); }
            o[nt] = acc;
#pragma unroll
            for (int j = 0; j < 4; ++j) ss[j] += acc[j] * acc[j];
        }
#pragma unroll
        for (int j = 0; j < 4; ++j) {
#pragma unroll
            for (int ofs = 1; ofs < 16; ofs <<= 1) ss[j] += __shfl_xor(ss[j], ofs);
            if (r == 0) ssq[eh * 64 + 16 * i + 4 * q8 + j] = ss[j];
        }
        __syncthreads();
        const float* ng = (KIND ? p.gla_ng + hd * 256 : p.hgrn_ng + hd * 128);
        const int ycol = KIND ? 1024 + hd * 256 : hd * 128;
#pragma unroll
        for (int j = 0; j < 4; ++j) {
            const int t = 16 * i + 4 * q8 + j;
            const float rstd = __builtin_amdgcn_rsqf((ssq[t] + ssq[64 + t]) * (1.f / DV) + EPS);
            bf16_t* yp = ycat + (size_t)(tok0 + t) * DM + ycol;
#pragma unroll
            for (int nt = 0; nt < NT; ++nt) { const int e = eh * (DV / 2) + 16 * nt + r;
                const float g = bf2f(graw[j][nt]);
                yp[e] = f2bf(o[nt][j] * rstd * ng[e] * (g * sigmoidf_(g))); }
        }
    }
}

#define XB_TMO      128
#define XB_XCNT(j)  (256  + 64 * (j))
#define XB_XSUB(j)  (1280 + 64 * (j))
#define XB_XGEN(j)  (2304 + 64 * (j))
#define XB_TOP      3328
#define XB_TOPGEN   3392
#define XCD_BAR_WORDS 3456
#define XB_SPIN_CAP (1u << 18)
__device__ __forceinline__ unsigned xb_ld(unsigned* p)              { return __hip_atomic_load(p, __ATOMIC_RELAXED, __HIP_MEMORY_SCOPE_AGENT); }
__device__ __forceinline__ unsigned xb_add(unsigned* p, unsigned v) { return __hip_atomic_fetch_add(p, v, __ATOMIC_RELAXED, __HIP_MEMORY_SCOPE_AGENT); }
__device__ __forceinline__ unsigned xb_xcc_id() { return (unsigned)__builtin_amdgcn_s_getreg((3 << 11) | 20) & 0xFu; }
#define XB_SPIN(cond, bar) do { unsigned _sp = 0; while (cond) { __builtin_amdgcn_s_sleep(1); \
    if ((++_sp & 255u) == 0u) { if (xb_ld(&(bar)[XB_TMO])) break; if (_sp > XB_SPIN_CAP) { atomicAdd(&(bar)[XB_TMO], 1u); break; } } } } while (0)
struct XcdBarrier { unsigned* bar; unsigned x; volatile LAS unsigned* st; };
__device__ __forceinline__ XcdBarrier xcd_barrier_post(unsigned* bar, volatile LAS unsigned* st) {
    XcdBarrier b; b.bar = bar; b.x = xb_xcc_id(); b.st = st;
    if (threadIdx.x == 0) (void)xb_add(&bar[XB_XCNT(b.x)], 1u);
    return b;
}
__device__ __forceinline__ void xcd_barrier_complete(unsigned* bar, unsigned x, unsigned& nloc, unsigned& nx) {
    const unsigned G = gridDim.x * gridDim.y * gridDim.z;
    unsigned sum, cnt, mine, sp = 0u;
    for (;;) {
        sum = 0u; cnt = 0u; mine = 0u;
#pragma unroll
        for (unsigned j = 0; j < 16; ++j) { const unsigned c = xb_ld(&bar[XB_XCNT(j)]); sum += c; cnt += (c > 0u) ? 1u : 0u; mine = (j == x) ? c : mine; }
        if (sum == G) break;
        __builtin_amdgcn_s_sleep(1);
        if ((++sp & 255u) == 0u) { if (xb_ld(&bar[XB_TMO])) break; if (sp > XB_SPIN_CAP) { atomicAdd(&bar[XB_TMO], 1u); break; } }
    }
    nloc = mine > 0u ? mine : 1u; nx = cnt > 0u ? cnt : 1u;
}
__device__ __forceinline__ void xcd_barrier(const XcdBarrier& b) {
    asm volatile("s_waitcnt vmcnt(0)" ::: "memory");
    __syncthreads();
    if (threadIdx.x == 0) {
        unsigned* bar = b.bar;
        __builtin_amdgcn_s_waitcnt(0);
        unsigned nloc = b.st[0], nx = b.st[1];
        if (nloc == 0u) { xcd_barrier_complete(bar, b.x, nloc, nx); b.st[0] = nloc; b.st[1] = nx; }
        const unsigned old = xb_add(&bar[XB_XSUB(b.x)], 1u);
        const unsigned gen = old / nloc;
        if (old + 1u == (gen + 1u) * nloc) {
            __builtin_amdgcn_fence(__ATOMIC_RELEASE, "agent");
            asm volatile("s_waitcnt vmcnt(0)" ::: "memory");
            const unsigned og = xb_add(&bar[XB_TOP], 1u);
            const unsigned tg = og / nx;
            if (og + 1u == (tg + 1u) * nx) xb_add(&bar[XB_TOPGEN], 1u);
            else XB_SPIN(xb_ld(&bar[XB_TOPGEN]) == tg, bar);
            __builtin_amdgcn_fence(__ATOMIC_ACQUIRE, "agent");
            xb_add(&bar[XB_XGEN(b.x)], 1u);
            asm volatile("s_waitcnt vmcnt(0)" ::: "memory");
        } else {
            XB_SPIN(xb_ld(&bar[XB_XGEN(b.x)]) == gen, bar);
            __builtin_amdgcn_fence(__ATOMIC_ACQUIRE, "agent");
            asm volatile("s_waitcnt vmcnt(0)" ::: "memory");
        }
    }
    __syncthreads();
}

__global__ void __launch_bounds__(512, 2) fwd_kernel(Params p) {
    extern __shared__ __attribute__((aligned(16))) unsigned char smem[];
    cg::grid_group grid = cg::this_grid();
    const int tid = threadIdx.x, lane = tid & 63, wave = tid >> 6;
    const int G = gridDim.x, gw = blockIdx.x * 8 + wave, NGW = G * 8;
    unsigned char* ws = p.ws;
    bf16_t* Wout = (bf16_t*)(ws + WS_WOUT); bf16_t* W1t = (bf16_t*)(ws + WS_W1); bf16_t* W2t = (bf16_t*)(ws + WS_W2); bf16_t* Win = (bf16_t*)(ws + WS_WIN);
    bf16_t* U = (bf16_t*)(ws + WS_U); bf16_t* BIG = (bf16_t*)(ws + WS_BIG); bf16_t* YZ = (bf16_t*)(ws + WS_YZ);
    bf16_t* VTE = (bf16_t*)(ws + WS_VT_E); bf16_t* VTO = (bf16_t*)(ws + WS_VT_O); bf16_t* ST = (bf16_t*)(ws + WS_ST); float* DEC = (float*)(ws + WS_DEC);
    float* RS = (float*)(ws + WS_RS); bf16_t* YC = (bf16_t*)p.out;
    float* scr = (float*)(smem + wave * 8448);
    LAS unsigned char* lds = (LAS unsigned char*)smem;
    const int lo = p.ph_lo, hi = p.ph_hi;
#define IN(k) (lo <= (k) && (k) < hi)
#define SEAM(k) do { if (IN(k) && IN((k) + 1)) xcd_barrier(xbar); } while (0)
    if (lo < 0) grid.sync();
    volatile LAS unsigned* xst = (volatile LAS unsigned*)(lds + 131072 + 1024);
    if (tid < 4) xst[tid] = 0u;
    __syncthreads();
    XcdBarrier xbar; xbar.bar = (unsigned*)(ws + WS_BAR); xbar.x = 0; xbar.st = xst;
    if (hi - lo > 1) xbar = xcd_barrier_post((unsigned*)(ws + WS_BAR), xst);

    if (IN(0)) {
        cvt_seg(p.even_w_in, DM, 6144, 0, 5120, Win, 0, p.norm_g, scr, gw, NGW, lane);
        cvt_seg(p.even_w_in, DM, 6144, 5120, 1024, Win, 5120, p.norm_g, scr, gw, NGW, lane);
        cvt_seg(p.even_w_out, DM, DM, 0, DM, Wout, 0, nullptr, scr, gw, NGW, lane);
        cvt_seg(p.w1, DM, DFF, 0, DFF, W1t, 0, p.norm_g + 2 * DM, scr, gw, NGW, lane);
        cvt_seg(p.w2, DFF, DM, 0, DM, W2t, 0, nullptr, scr, gw, NGW, lane);
        rowwise<0>(p.x, nullptr, nullptr, U, RS, nullptr, gw, NGW, lane);
    }
    SEAM(0);
    if (IN(1)) {
        { pg8::Gemm g{U, Win, NTOK, LDE, DM}; pg8::StaticOrder S; S.init(NTOK, LDE, G, blockIdx.x); pg8::EpiB<0, 1> E{BIG, LDE, RS}; pg8::gemm_phase(lds, g, S, E); }
        { pg8::Gemm g{Win + (size_t)5120 * DM, U, 1024, NTOK, DM}; pg8::StaticOrder S; S.init(1024, NTOK, G, blockIdx.x); pg8::EpiB<0, 2> E{VTE, NTOK, RS}; pg8::gemm_phase(lds, g, S, E); }
    }
    SEAM(1);
    if (IN(2)) { conv_phase(BIG, p.conv_w, YC); attn_phase(smem, BIG, VTE, p.rel_bias, YC); }
    SEAM(2);
    if (IN(3)) { pg8::Gemm g{YC, Wout, NTOK, DM, DM}; pg8::StaticOrder S; S.init(NTOK, DM, G, blockIdx.x); pg8::EpiB<0, 0> E{YZ, DM, nullptr}; pg8::gemm_phase(lds, g, S, E); }
    SEAM(3);
    if (IN(4)) rowwise<1>(nullptr, YZ, p.norm_g + 1 * DM, U, RS, nullptr, gw, NGW, lane);
    SEAM(4);
    if (IN(5)) { pg8::Gemm g{U, W1t, NTOK, DFF, DM}; pg8::StaticOrder S; S.init(NTOK, DFF, G, blockIdx.x); pg8::EpiB<1, 1> E{BIG, DFF, RS}; pg8::gemm_phase(lds, g, S, E); }
    SEAM(5);
    if (IN(6)) { pg8::Gemm g{BIG, W2t, NTOK, DM, DFF}; pg8::StaticOrder S; S.init(NTOK, DM, G, blockIdx.x); pg8::EpiB<0, 0> E{YZ, DM, nullptr}; pg8::gemm_phase(lds, g, S, E); }
    SEAM(6);
    if (IN(7)) {
        rowwise<1>(nullptr, YZ, p.norm_g + 3 * DM, U, RS, nullptr, gw, NGW, lane);
        const float* wi = p.odd_w_in;
        cvt_seg(wi, DM, 7184, 0, 2048, Win, 0, p.norm_g + 4 * DM, scr, gw, NGW, lane);
        cvt_seg(wi, DM, 7184, 3072, 2048, Win, 2048, p.norm_g + 4 * DM, scr, gw, NGW, lane);
        cvt_seg(wi, DM, 7184, 6144, 1040, Win, 4096, p.norm_g + 4 * DM, scr, gw, NGW, lane);
        cvt_seg(wi, DM, 7184, 2048, 1024, Win, 5376, p.norm_g + 4 * DM, scr, gw, NGW, lane);
        cvt_seg(wi, DM, 7184, 5120, 1024, Win, 6400, p.norm_g + 4 * DM, scr, gw, NGW, lane);
        cvt_seg(p.odd_w_out, DM, DM, 0, DM, Wout, 0, nullptr, scr, gw, NGW, lane);
        cvt_seg(p.w1 + (size_t)DM * DFF, DM, DFF, 0, DFF, W1t, 0, p.norm_g + 6 * DM, scr, gw, NGW, lane);
        cvt_seg(p.w2 + (size_t)DM * DFF, DFF, DM, 0, DM, W2t, 0, nullptr, scr, gw, NGW, lane);
    }
    SEAM(7);
    if (IN(8)) {
        { pg8::Gemm g{U, Win, NTOK, 5120, DM}; pg8::StaticOrder S; S.init(NTOK, 5120, G, blockIdx.x); pg8::EpiB<0, 1> E{BIG, LDO, RS}; pg8::gemm_phase(lds, g, S, E); }
        { pg8::Gemm g{Win + (size_t)5376 * DM, U, 2048, NTOK, DM}; pg8::StaticOrder S; S.init(2048, NTOK, G, blockIdx.x); pg8::EpiB<0, 2> E{VTO, NTOK, RS}; pg8::gemm_phase(lds, g, S, E); }
        if (wave < 4) {
            const int r = lane & 15, q8 = lane >> 4, t0 = (blockIdx.x * 4 + wave) * 16;
            if (t0 < NTOK) {
                const bf16_t* ap = U + (size_t)(t0 + r) * DM + 8 * q8;
                const bf16_t* bp = Win + (size_t)(5120 + r) * DM + 8 * q8;
                f32x4 acc = (f32x4){0.f, 0.f, 0.f, 0.f};
#pragma unroll 8
                for (int kk = 0; kk < DM / 32; ++kk) { const bf16x8 a = *(const bf16x8*)(ap + 32 * kk), b = *(const bf16x8*)(bp + 32 * kk);
                    acc = __builtin_amdgcn_mfma_f32_16x16x32_bf16(a, b, acc, 0, 0, 0); }
#pragma unroll
                for (int j = 0; j < 4; ++j) BIG[(size_t)(t0 + 4 * q8 + j) * LDO + 5120 + r] = f2bf(acc[j] * RS[t0 + 4 * q8 + j]);
            }
        }
    }
    SEAM(8);
    if (IN(9)) {
        int par = 0;
        for (int it = blockIdx.x; it < 2048; it += G) { passA_item<0>(p, smem, BIG, VTO, ST, DEC, it, par); par ^= 1; }
        for (int it = blockIdx.x; it < 1024; it += G) { passA_item<1>(p, smem, BIG, VTO, ST, DEC, it, par); par ^= 1; }
    }
    SEAM(9);
    if (IN(10)) scan_phase(ST, DEC);
    SEAM(10);
    if (IN(11)) {
        for (int it = blockIdx.x; it < 2048; it += G) passC_item<0>(p, smem, BIG, VTO, ST, YC, it);
        for (int it = blockIdx.x; it < 1024; it += G) passC_item<1>(p, smem, BIG, VTO, ST, YC, it);
    }
    SEAM(11);
    if (IN(12)) { pg8::Gemm g{YC, Wout, NTOK, DM, DM}; pg8::StaticOrder S; S.init(NTOK, DM, G, blockIdx.x); pg8::EpiB<0, 0> E{YZ, DM, nullptr}; pg8::gemm_phase(lds, g, S, E); }
    SEAM(12);
    if (IN(13)) rowwise<1>(nullptr, YZ, p.norm_g + 5 * DM, U, RS, nullptr, gw, NGW, lane);
    SEAM(13);
    if (IN(14)) { pg8::Gemm g{U, W1t, NTOK, DFF, DM}; pg8::StaticOrder S; S.init(NTOK, DFF, G, blockIdx.x); pg8::EpiB<1, 1> E{BIG, DFF, RS}; pg8::gemm_phase(lds, g, S, E); }
    SEAM(14);
    if (IN(15)) { pg8::Gemm g{BIG, W2t, NTOK, DM, DFF}; pg8::StaticOrder S; S.init(NTOK, DM, G, blockIdx.x); pg8::EpiB<0, 0> E{YZ, DM, nullptr}; pg8::gemm_phase(lds, g, S, E); }
    SEAM(15);
    if (IN(16)) rowwise<2>(nullptr, YZ, p.norm_g + 7 * DM, U, nullptr, p.out, gw, NGW, lane);
#undef IN
#undef SEAM
}

constexpr int NPHASE = 17;

extern "C" void kernel_launch(void* const* d_in, const int* in_sizes, int n_in, void* d_out, int out_size, void* d_ws, size_t ws_size, hipStream_t stream) {
    static int grid = 0;
    if (grid == 0) {
        if (ws_size < WS_END) fprintf(stderr, "kernel_launch: workspace too small: %zu < %zu\n", ws_size, (size_t)WS_END);
        int dev = 0, cus = 0, per_cu = 0;
        hipGetDevice(&dev);
        hipDeviceGetAttribute(&cus, hipDeviceAttributeMultiprocessorCount, dev);
        if (hipFuncSetAttribute((const void*)fwd_kernel, hipFuncAttributeMaxDynamicSharedMemorySize, LDS_BYTES) != hipSuccess) fprintf(stderr, "kernel_launch: hipFuncSetAttribute failed\n");
        if (hipOccupancyMaxActiveBlocksPerMultiprocessor(&per_cu, (const void*)fwd_kernel, 512, LDS_BYTES) != hipSuccess || per_cu < 1) { per_cu = 1; (void)hipGetLastError(); }
        grid = cus * (per_cu > 1 ? 1 : per_cu);
        if (grid <= 0) grid = 256;
    }
    Params p{};
    p.x = (const float*)d_in[0]; p.norm_g = (const float*)d_in[1]; p.even_w_in = (const float*)d_in[2]; p.conv_w = (const float*)d_in[3];
    p.rel_bias = (const float*)d_in[4]; p.even_w_out = (const float*)d_in[5]; p.odd_w_in = (const float*)d_in[6]; p.hgrn_lb = (const float*)d_in[7];
    p.hgrn_ng = (const float*)d_in[8]; p.wa2 = (const float*)d_in[9]; p.ba = (const float*)d_in[10]; p.gla_ng = (const float*)d_in[11];
    p.odd_w_out = (const float*)d_in[12]; p.w1 = (const float*)d_in[13]; p.w2 = (const float*)d_in[14];
    p.out = (float*)d_out; p.ws = (unsigned char*)d_ws;
#if ONE_LAUNCH
    (void)hipMemsetAsync((unsigned char*)d_ws + WS_BAR, 0, 16384, stream);
    p.ph_lo = 0; p.ph_hi = NPHASE;
    void* args[] = {&p};
    hipError_t e = hipLaunchCooperativeKernel((const void*)fwd_kernel, dim3(grid), dim3(512), args, LDS_BYTES, stream);
    if (e != hipSuccess) fprintf(stderr, "cooperative launch failed: %s (grid %d)\n", hipGetErrorString(e), grid);
#else
    for (int k = 0; k < NPHASE; ++k) {
        p.ph_lo = k; p.ph_hi = k + 1;
        hipLaunchKernelGGL(fwd_kernel, dim3(grid), dim3(512), LDS_BYTES, stream, p);
    }
#endif
}
```

```cpp
#include <hip/hip_runtime.h>
#include <hip/hip_cooperative_groups.h>
#include <cstdio>
namespace cg = cooperative_groups;

#ifndef ONE_LAUNCH
#define ONE_LAUNCH 1
#endif

typedef unsigned short bf16_t;
typedef short bf16x8 __attribute__((ext_vector_type(8)));
typedef float f32x4 __attribute__((ext_vector_type(4)));
typedef unsigned u32x4 __attribute__((ext_vector_type(4)));
typedef unsigned u32x2 __attribute__((ext_vector_type(2)));
#define LAS __attribute__((address_space(3)))

constexpr int DM = 2048, NTOK = 16384, SEQ = 4096, DFF = 8192;
constexpr int LDE = 5120;
constexpr int LDO = 5376;
constexpr float EPS = 1e-6f;

constexpr size_t WS_WOUT = 0;
constexpr size_t WS_W1 = 8388608;
constexpr size_t WS_W2 = WS_W1 + 33554432;
constexpr size_t WS_U = WS_W2 + 33554432;
constexpr size_t WS_BIG = WS_U + 67108864;
constexpr size_t WS_WIN = WS_BIG + 268435456;
constexpr size_t WS_YZ = WS_WIN + 30408704;
constexpr size_t WS_VT_E = WS_BIG + (size_t)NTOK * LDE * 2;
constexpr size_t WS_VT_O = WS_BIG + (size_t)NTOK * LDO * 2;
constexpr size_t WS_ST = WS_VT_O + 67108864;
constexpr size_t WS_DEC = WS_ST + 134217728;
constexpr size_t WS_BAR = WS_DEC + 3072 * 128 * 4;
constexpr size_t WS_RS = WS_BAR + 16384;
constexpr size_t WS_END = WS_RS + 65536;

constexpr int LDS_BYTES = 131072 + 4096;

__device__ __forceinline__ float bf2f(bf16_t v) { return __uint_as_float(((unsigned)v) << 16); }
typedef float f32x2 __attribute__((ext_vector_type(2)));
typedef __bf16 bf16x2v __attribute__((ext_vector_type(2)));
__device__ __forceinline__ unsigned pk2(float lo, float hi) { f32x2 v = {lo, hi}; bf16x2v b = __builtin_convertvector(v, bf16x2v); return __builtin_bit_cast(unsigned, b); }
__device__ __forceinline__ bf16_t f2bf(float f) { return __builtin_bit_cast(bf16_t, (__bf16)f); }
__device__ __forceinline__ float wave_sum(float v) {
#pragma unroll
    for (int o = 1; o < 64; o <<= 1) v += __shfl_xor(v, o);
    return v;
}
__device__ __forceinline__ float frcp(float x) { return __builtin_amdgcn_rcpf(x); }
__device__ __forceinline__ float sigmoidf_(float x) { return frcp(1.f + __expf(-x)); }
#define LDS_WAIT() asm volatile("s_waitcnt lgkmcnt(0)" ::: "memory")
__device__ __forceinline__ float dpp_f(float v, int ctrl_sel) {
    const int x = __float_as_int(v); int y;
    if (ctrl_sel == 0) y = __builtin_amdgcn_update_dpp(x, x, 0xB1, 0xF, 0xF, false);
    else if (ctrl_sel == 1) y = __builtin_amdgcn_update_dpp(x, x, 0x4E, 0xF, 0xF, false);
    else if (ctrl_sel == 2) y = __builtin_amdgcn_update_dpp(x, x, 0x141, 0xF, 0xF, false);
    else y = __builtin_amdgcn_update_dpp(x, x, 0x140, 0xF, 0xF, false);
    return __int_as_float(y);
}
__device__ __forceinline__ float row16_max(float v) { v = fmaxf(v, dpp_f(v, 0)); v = fmaxf(v, dpp_f(v, 1)); v = fmaxf(v, dpp_f(v, 2)); v = fmaxf(v, dpp_f(v, 3)); return v; }
__device__ __forceinline__ float row16_sum(float v) { v += dpp_f(v, 0); v += dpp_f(v, 1); v += dpp_f(v, 2); v += dpp_f(v, 3); return v; }

namespace pg8 {
constexpr int BM = 256, BK = 64, HALF = 128, HTB = HALF * BK * 2, STAGE_BYTES = 8 * HTB, NXCD = 8, WGM = 8;
__host__ __device__ __forceinline__ int lds_byte(int r, int c) { const int st = (r >> 4) * 2 + (c >> 5), rr = r & 15, cc = c & 31, ob = rr * 64 + cc * 2; return st * 1024 + (ob ^ (((ob >> 9) & 1) << 5)); }
__host__ __device__ __forceinline__ void stage_rc(int b, int& R, int& C) { const int st = b / 1024, sb = b % 1024, swz = sb ^ (((sb >> 9) & 1) << 5); R = (st >> 1) * 16 + swz / 64; C = (st & 1) * 32 + (swz % 64) / 2; }
__host__ __device__ __forceinline__ int perm32(int rho) { const int n = rho >> 4, i = rho & 15; return 8 * (i >> 2) + 4 * n + (i & 3); }
struct Unit { int pm, pn; };
struct Gemm { const bf16_t* A; const bf16_t* Bt; int M, N, K; };
struct StaticOrder {
    int nM, nN, nwg, G, c;
    __device__ void init(int M, int N, int G_, int c_) { nM = M / BM; nN = N / BM; nwg = nM * nN; G = G_; c = c_; }
    __device__ bool next(int i, Unit& u) const {
        const long L = (long)i * G + c; if (L >= nwg) return false;
        int wgid = (int)L; { const int q = nwg / NXCD, r = nwg % NXCD, xcd = wgid % NXCD, off = wgid / NXCD; wgid = (xcd < r ? xcd * (q + 1) : r * (q + 1) + (xcd - r) * q) + off; }
        const int nig = WGM * nN, gid = wgid / nig, fm = gid * WGM, gsz = (nM - fm) < WGM ? (nM - fm) : WGM;
        u.pm = fm + ((wgid % nig) % gsz); u.pn = (wgid % nig) / gsz; return true;
    }
};
template <int ACT, int RS> struct EpiB {
    static constexpr bool PERM = true;
    bf16_t* O; int ldc; const float* rs;
    __device__ __forceinline__ void load_rs(const Unit& u, int wr, int fr, float (&rsv)[8]) const {
        if (RS == 1) {
#pragma unroll
            for (int q = 0; q < 8; ++q) rsv[q] = rs[u.pm * BM + wr * 64 + fr + (q >> 2) * HALF + (q & 3) * 16]; }
    }
    __device__ __forceinline__ void operator()(const f32x4 (&acc)[2][2][4][2], const Unit& u, int wr, int wc, int fr, int fq, const float (&rsv)[8]) const {
        const int row0 = u.pm * BM + wr * 64 + fr, col0 = u.pn * BM + wc * 32 + 8 * fq;
        f32x4 cs[2][2];
        if (RS == 2) {
#pragma unroll
            for (int bj = 0; bj < 2; ++bj) { cs[bj][0] = *(const f32x4*)(rs + col0 + bj * HALF); cs[bj][1] = *(const f32x4*)(rs + col0 + bj * HALF + 4); } }
#pragma unroll
        for (int ai = 0; ai < 2; ++ai)
#pragma unroll
            for (int m = 0; m < 4; ++m) { const int row = row0 + ai * HALF + m * 16; bf16_t* rowp = O + (size_t)row * ldc + col0;
                float rsc = 1.f; if (RS == 1) rsc = rsv[ai * 4 + m];
#pragma unroll
                for (int bj = 0; bj < 2; ++bj) { f32x4 v0 = acc[ai][bj][m][0], v1 = acc[ai][bj][m][1];
                    if (RS == 1) { v0 *= rsc; v1 *= rsc; }
                    if (RS == 2) { v0 *= cs[bj][0]; v1 *= cs[bj][1]; }
                    if (ACT == 1) {
#pragma unroll
                        for (int j = 0; j < 4; ++j) { float a = fmaxf(v0[j], 0.f), b = fmaxf(v1[j], 0.f); v0[j] = a * a; v1[j] = b * b; } }
                    u32x4 w; w.x = pk2(v0[0], v0[1]); w.y = pk2(v0[2], v0[3]); w.z = pk2(v1[0], v1[1]); w.w = pk2(v1[2], v1[3]);
                    *(u32x4*)(rowp + bj * HALF) = w; } }
    }
};

template <class Epi, class Sched>
__device__ __forceinline__ void gemm_phase(LAS unsigned char* lds, const Gemm g, const Sched& S, const Epi& E) {
    const int tid = threadIdx.x, wid = __builtin_amdgcn_readfirstlane(tid >> 6), lane = tid & 63, wr = wid >> 2, wc = wid & 3, fr = lane & 15, fq = lane >> 4;
    const int K = g.K, nt = K / BK;
    unsigned voffA[2], voffB[2];
#pragma unroll
    for (int i = 0; i < 2; ++i) { int R, C; stage_rc(tid * 16 + i * 8192, R, C); const int Rb = Epi::PERM ? ((R & ~31) + perm32(R & 31)) : R;
        voffA[i] = (unsigned)(R * K + C) * 2u; voffB[i] = (unsigned)(Rb * K + C) * 2u; }
    const size_t kstep = (size_t)(BK * 2);
    const size_t hstep = (size_t)HALF * K * 2;
    const size_t tstep = 2 * hstep;
    const unsigned ldsw = (unsigned)wid * 1024u;
    const int aoff = lds_byte(wr * 64 + fr, fq * 8), boff = lds_byte(wc * 32 + fr, fq * 8);
#define PG8_SA(b, h) (((b) * 2 + (h)) * HTB)
#define PG8_SB(b, h) ((4 + (b) * 2 + (h)) * HTB)
#define PG8_STAGE(bufoff, gbase, voff) do { _Pragma("unroll") for (int _i = 0; _i < 2; ++_i) \
        __builtin_amdgcn_global_load_lds((const unsigned*)((const char*)(gbase) + (voff)[_i]), (LAS unsigned*)(lds + (bufoff) + ldsw + _i * 8192), 16, 0, 0); } while (0)
#define PG8_LDA(dst, b, h) do { _Pragma("unroll") for (int m = 0; m < 4; ++m) _Pragma("unroll") for (int k = 0; k < 2; ++k) dst[m][k] = *(const LAS bf16x8*)(lds + PG8_SA(b, h) + aoff + m * 2048 + k * 1024); } while (0)
#define PG8_LDB(dst, b, h) do { _Pragma("unroll") for (int n = 0; n < 2; ++n) _Pragma("unroll") for (int k = 0; k < 2; ++k) dst[n][k] = *(const LAS bf16x8*)(lds + PG8_SB(b, h) + boff + n * 2048 + k * 1024); } while (0)
#define PG8_MMA(ai, bj, At, Bt) do { __builtin_amdgcn_s_setprio(1); _Pragma("unroll") for (int m = 0; m < 4; ++m) _Pragma("unroll") for (int n = 0; n < 2; ++n) _Pragma("unroll") for (int k = 0; k < 2; ++k) \
        acc[ai][bj][m][n] = __builtin_amdgcn_mfma_f32_16x16x32_bf16(Bt[n][k], At[m][k], acc[ai][bj][m][n], 0, 0, 0); __builtin_amdgcn_s_setprio(0); } while (0)
#define PG8_WAIT_V(n) asm volatile("s_waitcnt vmcnt(" #n ")" ::: "memory")
#define PG8_WAIT_L(n) asm volatile("s_waitcnt lgkmcnt(" #n ")" ::: "memory")
#define PG8_BAR __builtin_amdgcn_s_barrier()
#define PG8_SCHED __builtin_amdgcn_sched_barrier(0)
    Unit cur, nxt; int ui = 0;
    if (!S.next(0, cur)) return;
    f32x4 acc[2][2][4][2];
#pragma unroll
    for (int a = 0; a < 2; ++a)
#pragma unroll
        for (int b = 0; b < 2; ++b)
#pragma unroll
            for (int m = 0; m < 4; ++m)
#pragma unroll
                for (int n = 0; n < 2; ++n) acc[a][b][m][n] = (f32x4){0.f, 0.f, 0.f, 0.f};
    bf16x8 At[4][2], B0[2][2], B1[2][2];
    const char* cA = (const char*)g.A + (size_t)cur.pm * tstep; const char* cB = (const char*)g.Bt + (size_t)cur.pn * tstep;
    float rsv[8] = {1.f, 1.f, 1.f, 1.f, 1.f, 1.f, 1.f, 1.f};
    E.load_rs(cur, wr, fr, rsv);
    PG8_STAGE(PG8_SB(0, 0), cB, voffB); PG8_STAGE(PG8_SB(0, 1), cB + hstep, voffB); PG8_STAGE(PG8_SA(0, 0), cA, voffA); PG8_STAGE(PG8_SA(0, 1), cA + hstep, voffA);
    if (wr == 1) PG8_BAR;
    PG8_WAIT_V(2); PG8_BAR;
    PG8_STAGE(PG8_SB(1, 0), cB + kstep, voffB); PG8_STAGE(PG8_SA(1, 0), cA + kstep, voffA); PG8_STAGE(PG8_SB(1, 1), cB + hstep + kstep, voffB);
    PG8_WAIT_V(6); PG8_BAR;
    for (;;) {
        const bool has_next = S.next(ui + 1, nxt);
        const char* nA = has_next ? (const char*)g.A + (size_t)nxt.pm * tstep : cA; const char* nB = has_next ? (const char*)g.Bt + (size_t)nxt.pn * tstep : cB;
        for (int t = 0; t < nt; t += 2) {
            const bool last = (t == nt - 2);
            const char* a1 = cA + (size_t)(t + 1) * kstep;
            const char* a2 = last ? nA : cA + (size_t)(t + 2) * kstep; const char* b2 = last ? nB : cB + (size_t)(t + 2) * kstep;
            const char* a3 = a2 + kstep; const char* b3 = b2 + kstep;
            PG8_LDB(B0, 0, 0); PG8_LDB(B1, 0, 1); PG8_SCHED; PG8_LDA(At, 0, 0); PG8_STAGE(PG8_SA(1, 1), a1 + hstep, voffA);
            PG8_WAIT_V(8); PG8_WAIT_L(0); PG8_BAR; PG8_MMA(0, 0, At, B0); PG8_MMA(0, 1, At, B1); PG8_BAR; PG8_SCHED;
            PG8_LDA(At, 0, 1); PG8_STAGE(PG8_SB(0, 0), b2, voffB); PG8_STAGE(PG8_SB(0, 1), b2 + hstep, voffB); PG8_STAGE(PG8_SA(0, 0), a2, voffA);
            PG8_WAIT_V(8); PG8_WAIT_L(0); PG8_BAR; PG8_MMA(1, 0, At, B0); PG8_MMA(1, 1, At, B1); PG8_BAR; PG8_SCHED;
            PG8_LDB(B0, 1, 0); PG8_LDB(B1, 1, 1); PG8_SCHED; PG8_LDA(At, 1, 0); PG8_STAGE(PG8_SA(0, 1), a2 + hstep, voffA);
            PG8_WAIT_V(8); PG8_WAIT_L(0); PG8_BAR; PG8_MMA(0, 0, At, B0); PG8_MMA(0, 1, At, B1); PG8_BAR; PG8_SCHED;
            PG8_LDA(At, 1, 1); PG8_STAGE(PG8_SB(1, 0), b3, voffB); PG8_STAGE(PG8_SB(1, 1), b3 + hstep, voffB); PG8_STAGE(PG8_SA(1, 0), a3, voffA);
            PG8_WAIT_V(8); PG8_WAIT_L(0); PG8_BAR; PG8_MMA(1, 0, At, B0); PG8_MMA(1, 1, At, B1); PG8_BAR; PG8_SCHED;
        }
        if (wr == 0) PG8_BAR;
        E(acc, cur, wr, wc, fr, fq, rsv);
        if (!has_next) break;
        E.load_rs(nxt, wr, fr, rsv);
#pragma unroll
        for (int a = 0; a < 2; ++a)
#pragma unroll
            for (int b = 0; b < 2; ++b)
#pragma unroll
                for (int m = 0; m < 4; ++m)
#pragma unroll
                    for (int n = 0; n < 2; ++n) acc[a][b][m][n] = (f32x4){0.f, 0.f, 0.f, 0.f};
        cur = nxt; cA = nA; cB = nB; ++ui;
        if (wr == 1) PG8_BAR;
    }
    PG8_WAIT_V(0);
    PG8_BAR;
#undef PG8_SA
#undef PG8_SB
#undef PG8_STAGE
#undef PG8_LDA
#undef PG8_LDB
#undef PG8_MMA
#undef PG8_WAIT_V
#undef PG8_WAIT_L
#undef PG8_BAR
#undef PG8_SCHED
}
}

struct Params {
    const float* x; const float* norm_g; const float* even_w_in; const float* conv_w; const float* rel_bias; const float* even_w_out;
    const float* odd_w_in; const float* hgrn_lb; const float* hgrn_ng; const float* wa2; const float* ba; const float* gla_ng; const float* odd_w_out;
    const float* w1; const float* w2; float* out; unsigned char* ws; int ph_lo, ph_hi;
};

__device__ __forceinline__ void cvt_seg(const float* __restrict__ W, int K, int NS, int c0, int nc, bf16_t* __restrict__ WT, int r0, const float* __restrict__ gf, float* scr, int gw, int NGW, int lane) {
    const int nblk = (nc + 31) >> 5, nitems = (K >> 6) * nblk;
    const int krow = lane >> 3, c4 = (lane & 7) * 4;
    for (int it = gw; it < nitems; it += NGW) {
        const int kb = it / nblk, nb = it - kb * nblk, k0 = kb * 64, n0 = nb * 32;
        const bool ok = (n0 + c4) < nc;
        const float* src = W + (size_t)(k0 + krow) * NS + c0 + n0 + c4;
        f32x4 v[8];
#pragma unroll
        for (int i = 0; i < 8; ++i) v[i] = ok ? *(const f32x4*)(src + (size_t)(8 * i) * NS) : (f32x4){0.f, 0.f, 0.f, 0.f};
        if (gf) {
#pragma unroll
            for (int i = 0; i < 8; ++i) v[i] *= gf[k0 + 8 * i + krow]; }
#pragma unroll
        for (int i = 0; i < 8; ++i) { float* d = scr + (8 * i + krow) * 33 + c4; d[0] = v[i][0]; d[1] = v[i][1]; d[2] = v[i][2]; d[3] = v[i][3]; }
        LDS_WAIT();
        const int c = lane & 7;
#pragma unroll
        for (int j = 0; j < 4; ++j) { const int n = (lane >> 3) + 8 * j; const float* s = scr + (8 * c) * 33 + n;
            u32x4 o; o.x = pk2(s[0], s[33]); o.y = pk2(s[66], s[99]); o.z = pk2(s[132], s[165]); o.w = pk2(s[198], s[231]);
            if (n0 + n < nc) *(u32x4*)(WT + (size_t)(r0 + n0 + n) * K + k0 + 8 * c) = o; }
        LDS_WAIT();
    }
}

template <int MODE>
__device__ __forceinline__ void rowwise(const float* __restrict__ xin, const bf16_t* __restrict__ ysrc, const float* __restrict__ g1,
                                        bf16_t* hb, float* __restrict__ rsout, float* __restrict__ out, int gw, int NGW, int lane) {
    for (int row0 = gw; row0 < NTOK; row0 += 2 * NGW) {
        f32x4 h[2][4][2]; u32x4 yw[2][4], hw[2][4];
#pragma unroll
        for (int rr = 0; rr < 2; ++rr) { const size_t rb = (size_t)(row0 + rr * NGW) * DM;
#pragma unroll
            for (int j = 0; j < 4; ++j) { const int col = 512 * j + 8 * lane;
                if (MODE == 0) { h[rr][j][0] = *(const f32x4*)(xin + rb + col); h[rr][j][1] = *(const f32x4*)(xin + rb + col + 4); }
                else { hw[rr][j] = *(const u32x4*)(hb + rb + col); yw[rr][j] = *(const u32x4*)(ysrc + rb + col); } } }
#pragma unroll
        for (int rr = 0; rr < 2; ++rr) {
            const int row = row0 + rr * NGW; const size_t rb = (size_t)row * DM;
            if (MODE != 0) {
                float y[4][8]; float ss = 0.f;
#pragma unroll
                for (int j = 0; j < 4; ++j) {
#pragma unroll
                    for (int e = 0; e < 4; ++e) { y[j][2 * e] = __uint_as_float(yw[rr][j][e] << 16); y[j][2 * e + 1] = __uint_as_float(yw[rr][j][e] & 0xffff0000u);
                        h[rr][j][e >> 1][(2 * e) & 3] = __uint_as_float(hw[rr][j][e] << 16); h[rr][j][e >> 1][(2 * e + 1) & 3] = __uint_as_float(hw[rr][j][e] & 0xffff0000u); }
#pragma unroll
                    for (int e = 0; e < 8; ++e) ss += y[j][e] * y[j][e]; }
                const float rs = rsqrtf(wave_sum(ss) * (1.f / DM) + EPS);
#pragma unroll
                for (int j = 0; j < 4; ++j) { const int col = 512 * j + 8 * lane; const f32x4 ga = *(const f32x4*)(g1 + col), gb = *(const f32x4*)(g1 + col + 4);
#pragma unroll
                    for (int e = 0; e < 4; ++e) { h[rr][j][0][e] += y[j][e] * rs * ga[e]; h[rr][j][1][e] += y[j][4 + e] * rs * gb[e]; }
                    if (MODE == 2) { *(f32x4*)(out + rb + col) = h[rr][j][0]; *(f32x4*)(out + rb + col + 4) = h[rr][j][1]; } }
            }
            if (MODE != 2) {
                float ss = 0.f;
#pragma unroll
                for (int j = 0; j < 4; ++j)
#pragma unroll
                    for (int e = 0; e < 4; ++e) ss += h[rr][j][0][e] * h[rr][j][0][e] + h[rr][j][1][e] * h[rr][j][1][e];
                const float rs = rsqrtf(wave_sum(ss) * (1.f / DM) + EPS);
                if (lane == 0) rsout[row] = rs;
#pragma unroll
                for (int j = 0; j < 4; ++j) { const int col = 512 * j + 8 * lane;
                    u32x4 o; o.x = pk2(h[rr][j][0][0], h[rr][j][0][1]); o.y = pk2(h[rr][j][0][2], h[rr][j][0][3]);
                    o.z = pk2(h[rr][j][1][0], h[rr][j][1][1]); o.w = pk2(h[rr][j][1][2], h[rr][j][1][3]);
                    *(u32x4*)(hb + rb + col) = o; }
            }
        }
    }
}

__device__ __forceinline__ void conv_phase(const bf16_t* __restrict__ P, const float* __restrict__ cw, bf16_t* __restrict__ ycat) {
    const int nthr = gridDim.x * 512;
#pragma unroll 2
    for (int it = blockIdx.x * 512 + threadIdx.x; it < NTOK * 128; it += nthr) {
        const int t = it >> 7, c0 = (it & 127) * 8, tp = t & (SEQ - 1);
        const bf16_t* row = P + (size_t)t * LDE + c0;
        const u32x4 bg = *(const u32x4*)(row), c2 = *(const u32x4*)(row + 1024), h2 = *(const u32x4*)(row + 2048);
        u32x4 c1 = (u32x4){0, 0, 0, 0}, h1 = c1, cz = c1, hz = c1;
        if (tp >= 1) { c1 = *(const u32x4*)(row - LDE + 1024); h1 = *(const u32x4*)(row - LDE + 2048); }
        if (tp >= 2) { cz = *(const u32x4*)(row - 2 * LDE + 1024); hz = *(const u32x4*)(row - 2 * LDE + 2048); }
        float o[8];
#pragma unroll
        for (int e = 0; e < 8; ++e) {
            const int sh = (e & 1) ? 0 : 16; const int w = e >> 1;
            auto get = [&](const u32x4& v) { return __uint_as_float((v[w] << sh) & 0xffff0000u); };
            const float u2 = get(c2) * get(h2), u1 = get(c1) * get(h1), u0 = get(cz) * get(hz);
            const float y = cw[c0 + e] * u0 + cw[1024 + c0 + e] * u1 + cw[2048 + c0 + e] * u2;
            o[e] = get(bg) * y;
        }
        u32x4 w; w.x = pk2(o[0], o[1]); w.y = pk2(o[2], o[3]); w.z = pk2(o[4], o[5]); w.w = pk2(o[6], o[7]);
        *(u32x4*)(ycat + (size_t)t * DM + c0) = w;
    }
}

__device__ __forceinline__ void attn_phase(unsigned char* smem, const bf16_t* __restrict__ P, const bf16_t* __restrict__ VT, const float* __restrict__ relb, bf16_t* __restrict__ ycat) {
    const int tid = threadIdx.x, lane = tid & 63, wave = tid >> 6, half = wave >> 2, w4 = wave & 3, ltid = tid & 255, r = lane & 15, q8 = lane >> 4;
    unsigned char* base = smem + half * 47616;
    bf16_t* kS = (bf16_t*)base;
    bf16_t* vS = (bf16_t*)(base + 17408);
    bf16_t* pS = (bf16_t*)(base + 35840);
    float* bS = (float*)(base + 45056);
    const float scale = 0.08838834764831845f * 1.4426950408889634f;
    for (int pair = blockIdx.x; pair < 1024; pair += gridDim.x) {
        const int hp = pair & 3, n = (pair >> 2) & 63, b = pair >> 8, head = hp * 2 + half;
        const int tok0 = b * SEQ + n * 64;
        __syncthreads();
        for (int i = ltid; i < 640; i += 256) bS[i] = relb[head * 320 + (i < 319 ? i : 319)] * 1.4426950408889634f;
        bf16x8 qf[4];
        { const bf16_t* qp = P + (size_t)(tok0 + 16 * w4 + r) * LDE + 3072 + head * 128 + 8 * q8;
#pragma unroll
          for (int kk = 0; kk < 4; ++kk) qf[kk] = *(const bf16x8*)(qp + 32 * kk); }
        float m[4], l[4]; f32x4 o[8];
#pragma unroll
        for (int j = 0; j < 4; ++j) { m[j] = -1e30f; l[j] = 0.f; }
#pragma unroll
        for (int i = 0; i < 8; ++i) o[i] = (f32x4){0.f, 0.f, 0.f, 0.f};
        const int js0 = (n < 8 ? 8 - n : 0);
        u32x4 kreg[4], vreg[4];
        { const int ktok0 = tok0 + (js0 - 8) * 64;
#pragma unroll
          for (int i = 0; i < 4; ++i) { const int ch = ltid + 256 * i;
              kreg[i] = *(const u32x4*)(P + (size_t)(ktok0 + (ch >> 4)) * LDE + 4096 + head * 128 + (ch & 15) * 8);
              vreg[i] = *(const u32x4*)(VT + (size_t)(head * 128 + (ch >> 3)) * NTOK + ktok0 + (ch & 7) * 8); } }
        for (int js = js0; js <= 8; ++js) {
            __syncthreads();
#pragma unroll
            for (int i = 0; i < 4; ++i) { const int ch = ltid + 256 * i;
                *(u32x4*)(kS + (ch >> 4) * 136 + (ch & 15) * 8) = kreg[i];
                *(u32x4*)(vS + (ch >> 3) * 72 + (ch & 7) * 8) = vreg[i]; }
            __syncthreads();
            if (js < 8) { const int ktok0 = tok0 + (js + 1 - 8) * 64;
#pragma unroll
                for (int i = 0; i < 4; ++i) { const int ch = ltid + 256 * i;
                    kreg[i] = *(const u32x4*)(P + (size_t)(ktok0 + (ch >> 4)) * LDE + 4096 + head * 128 + (ch & 15) * 8);
                    vreg[i] = *(const u32x4*)(VT + (size_t)(head * 128 + (ch >> 3)) * NTOK + ktok0 + (ch & 7) * 8); } }
            f32x4 s[4];
#pragma unroll
            for (int nt = 0; nt < 4; ++nt) { s[nt] = (f32x4){0.f, 0.f, 0.f, 0.f};
#pragma unroll
                for (int kk = 0; kk < 4; ++kk) { const bf16x8 kf = *(const bf16x8*)(kS + (16 * nt + r) * 136 + 32 * kk + 8 * q8);
                    s[nt] = __builtin_amdgcn_mfma_f32_16x16x32_bf16(qf[kk], kf, s[nt], 0, 0, 0); } }
            const float* bT = bS + (16 * w4 + 4 * q8 - r + 63 + (8 - js) * 64);
            float mx[4];
            if (js <= 3) {
                const float cb = bS[639];
#pragma unroll
                for (int j = 0; j < 4; ++j) { float t = -1e30f;
#pragma unroll
                    for (int nt = 0; nt < 4; ++nt) { const float v = s[nt][j] * scale + cb; s[nt][j] = v; t = fmaxf(t, v); }
                    mx[j] = row16_max(t); }
            } else {
#pragma unroll
                for (int j = 0; j < 4; ++j) { float t = -1e30f;
#pragma unroll
                    for (int nt = 0; nt < 4; ++nt) { const float v = s[nt][j] * scale + bT[j - 16 * nt]; s[nt][j] = v; t = fmaxf(t, v); }
                    mx[j] = row16_max(t); }
            }
            bool grow = false;
#pragma unroll
            for (int j = 0; j < 4; ++j) grow = grow || (mx[j] > m[j] + 8.f);
            if (__any(grow)) {
#pragma unroll
                for (int j = 0; j < 4; ++j) { const float mn = fmaxf(m[j], mx[j]); const float al = __builtin_amdgcn_exp2f(m[j] - mn); m[j] = mn; l[j] *= al;
#pragma unroll
                    for (int i = 0; i < 8; ++i) o[i][j] *= al; }
            }
#pragma unroll
            for (int j = 0; j < 4; ++j) { float ps = 0.f;
#pragma unroll
                for (int nt = 0; nt < 4; ++nt) { const float pp = __builtin_amdgcn_exp2f(s[nt][j] - m[j]); ps += pp; pS[(16 * w4 + 4 * q8 + j) * 72 + 16 * nt + r] = f2bf(pp); }
                l[j] += ps; }
            LDS_WAIT();
#pragma unroll
            for (int kk = 0; kk < 2; ++kk) { const bf16x8 pf = *(const bf16x8*)(pS + (16 * w4 + r) * 72 + 32 * kk + 8 * q8);
#pragma unroll
                for (int i = 0; i < 8; ++i) { const bf16x8 vf = *(const bf16x8*)(vS + (16 * i + r) * 72 + 32 * kk + 8 * q8);
                    o[i] = __builtin_amdgcn_mfma_f32_16x16x32_bf16(pf, vf, o[i], 0, 0, 0); } }
        }
#pragma unroll
        for (int j = 0; j < 4; ++j) { float lt = l[j];
#pragma unroll
            for (int ofs = 1; ofs < 16; ofs <<= 1) lt += __shfl_xor(lt, ofs);
            const float inv = frcp(lt);
            bf16_t* op = ycat + (size_t)(tok0 + 16 * w4 + 4 * q8 + j) * DM + 1024 + head * 128 + r;
#pragma unroll
            for (int i = 0; i < 8; ++i) op[16 * i] = f2bf(o[i][j] * inv); }
    }
}

template <int KIND, bool WANT_Q>
__device__ __forceinline__ void decay_qk(const Params& p, const bf16_t* __restrict__ P, int tok0, int hd, int d, int tq, float (&bl)[16], float (&kv)[16], float (&qv)[16]) {
    const int col = hd * 128 + d;
    const bf16_t* rp = P + (size_t)(tok0 + 16 * tq) * LDO;
    if (KIND == 0) {
        const float lb = frcp(1.f + __expf(p.hgrn_lb[col] - p.hgrn_lb[1024 + col]));
        float run = 0.f;
#pragma unroll
        for (int jj = 0; jj < 16; ++jj) {
            const float fr = bf2f(rp[(size_t)jj * LDO + 1024 + col]);
            const float f = lb + (1.f - lb) * sigmoidf_(fr);
            run += __logf(f); bl[jj] = run; kv[jj] = 1.f - f;
            if (WANT_Q) { const float qr = bf2f(rp[(size_t)jj * LDO + col]); qv[jj] = qr * sigmoidf_(qr); }
        }
    } else {
        float w[16];
#pragma unroll
        for (int rr = 0; rr < 16; ++rr) w[rr] = p.wa2[rr * 512 + col];
        const float bias = p.ba[col];
        float run = 0.f;
#pragma unroll
        for (int jj = 0; jj < 16; ++jj) {
            const u32x4 g0 = *(const u32x4*)(rp + (size_t)jj * LDO + 5120), g1 = *(const u32x4*)(rp + (size_t)jj * LDO + 5128);
            float xx = bias;
#pragma unroll
            for (int e = 0; e < 4; ++e) {
                xx += __uint_as_float(g0[e] << 16) * w[2 * e] + __uint_as_float(g0[e] & 0xffff0000u) * w[2 * e + 1];
                xx += __uint_as_float(g1[e] << 16) * w[8 + 2 * e] + __uint_as_float(g1[e] & 0xffff0000u) * w[8 + 2 * e + 1];
            }
            const float ls = fminf(xx, 0.f) - __logf(1.f + __expf(-fabsf(xx)));
            run += ls * (1.f / 16.f); bl[jj] = run;
            kv[jj] = bf2f(rp[(size_t)jj * LDO + 3584 + col]);
            if (WANT_Q) qv[jj] = bf2f(rp[(size_t)jj * LDO + 3072 + col]) * 0.08838834764831845f;
        }
    }
}

template <int KIND>
__device__ __forceinline__ void passA_item(const Params& p, unsigned char* smem_base, const bf16_t* __restrict__ P, const bf16_t* __restrict__ VT, bf16_t* __restrict__ ST, float* __restrict__ DEC, int idx, int par) {
    unsigned char* smem = smem_base + par * 57344;
    constexpr int DV = KIND ? 256 : 128;
    const int tid = threadIdx.x, lane = tid & 63, wave = tid >> 6, r = lane & 15, q8 = lane >> 4, d = tid & 127, tq = tid >> 7;
    const int c = idx & 63, bh = idx >> 6, hd = KIND ? (bh & 3) : (bh & 7), b = KIND ? (bh >> 2) : (bh >> 3);
    const int tok0 = b * SEQ + c * 64;
    bf16_t* kT = (bf16_t*)smem;
    bf16_t* vS = (bf16_t*)(smem + 18432);
    float* tot = (float*)(smem + 18432 + 36864);
    float bl[16], kv[16], qv[16];
    u32x4 vr[DV / 64];
    { const bf16_t* vsrc = VT + (size_t)((KIND ? 1024 + hd * 256 : hd * 128)) * NTOK + tok0;
#pragma unroll
      for (int i = 0; i < DV / 64; ++i) { const int ch = tid + 512 * i, row = ch >> 3, c8 = ch & 7; vr[i] = *(const u32x4*)(vsrc + (size_t)row * NTOK + c8 * 8); } }
    decay_qk<KIND, false>(p, P, tok0, hd, d, tq, bl, kv, qv);
    tot[tq * 128 + d] = bl[15];
#pragma unroll
    for (int i = 0; i < DV / 64; ++i) { const int ch = tid + 512 * i, row = ch >> 3, c8 = ch & 7; *(u32x4*)(vS + row * 72 + c8 * 8) = vr[i]; }
    __syncthreads();
    const float t0 = tot[d], t1 = tot[128 + d], t2 = tot[256 + d], t3 = tot[384 + d];
    const float r4 = t0 + t1 + t2 + t3;
    const float rpre = (tq > 0 ? t0 : 0.f) + (tq > 1 ? t1 : 0.f) + (tq > 2 ? t2 : 0.f);
    {
        float kt[16];
#pragma unroll
        for (int jj = 0; jj < 16; ++jj) kt[jj] = kv[jj] * __expf(r4 - rpre - bl[jj]);
        u32x4 w0, w1;
        w0.x = pk2(kt[0], kt[1]); w0.y = pk2(kt[2], kt[3]); w0.z = pk2(kt[4], kt[5]); w0.w = pk2(kt[6], kt[7]);
        w1.x = pk2(kt[8], kt[9]); w1.y = pk2(kt[10], kt[11]); w1.z = pk2(kt[12], kt[13]); w1.w = pk2(kt[14], kt[15]);
        *(u32x4*)(kT + d * 72 + 16 * tq) = w0; *(u32x4*)(kT + d * 72 + 16 * tq + 8) = w1;
    }
    const int gitem = (KIND ? 2048 : 0) + idx;
    if (tq == 0) DEC[(size_t)gitem * 128 + d] = __expf(r4);
    __syncthreads();
    const int d0 = 16 * wave;
    bf16x8 af[2];
#pragma unroll
    for (int kk = 0; kk < 2; ++kk) af[kk] = *(const bf16x8*)(kT + (d0 + r) * 72 + 32 * kk + 8 * q8);
    bf16_t* stb = ST + (KIND ? (size_t)33554432 : 0) + (size_t)idx * (DV * 128);
#pragma unroll
    for (int nt = 0; nt < DV / 16; ++nt) {
        f32x4 acc = (f32x4){0.f, 0.f, 0.f, 0.f};
#pragma unroll
        for (int kk = 0; kk < 2; ++kk) { const bf16x8 bfr = *(const bf16x8*)(vS + (16 * nt + r) * 72 + 32 * kk + 8 * q8);
            acc = __builtin_amdgcn_mfma_f32_16x16x32_bf16(af[kk], bfr, acc, 0, 0, 0); }
        u32x2 w; w.x = pk2(acc[0], acc[1]); w.y = pk2(acc[2], acc[3]);
        *(u32x2*)(stb + (size_t)(16 * nt + r) * 128 + d0 + 4 * q8) = w;
    }
}

__device__ __forceinline__ void scan_phase(bf16_t* __restrict__ ST, const float* __restrict__ DEC) {
    const int nthr = gridDim.x * 512;
    for (int gid = blockIdx.x * 512 + threadIdx.x; gid < 131072; gid += nthr) {
        const int kind = gid >> 16, v = gid & 65535;
        const int vper = kind ? 4096 : 2048, bh = v / vper, vi = v - bh * vper, d0 = (vi * 8) & 127;
        const size_t csz = kind ? 32768 : 16384;
        bf16_t* sp = ST + (kind ? (size_t)33554432 : 0) + (size_t)bh * 64 * csz + (size_t)vi * 8;
        const float* dp = DEC + (size_t)((kind ? 2048 : 0) + bh * 64) * 128 + d0;
        float S[8];
#pragma unroll
        for (int e = 0; e < 8; ++e) S[e] = 0.f;
#pragma unroll 8
        for (int c = 0; c < 64; ++c) {
            const u32x4 u = *(const u32x4*)(sp + (size_t)c * csz);
            const f32x4 da = *(const f32x4*)(dp + c * 128), db = *(const f32x4*)(dp + c * 128 + 4);
            u32x4 w; w.x = pk2(S[0], S[1]); w.y = pk2(S[2], S[3]); w.z = pk2(S[4], S[5]); w.w = pk2(S[6], S[7]);
            *(u32x4*)(sp + (size_t)c * csz) = w;
#pragma unroll
            for (int e = 0; e < 4; ++e) {
                S[2 * e] = S[2 * e] * (e < 2 ? da[2 * e] : db[2 * e - 4]) + __uint_as_float(u[e] << 16);
                S[2 * e + 1] = S[2 * e + 1] * (e < 2 ? da[2 * e + 1] : db[2 * e - 3]) + __uint_as_float(u[e] & 0xffff0000u);
            }
        }
    }
}

template <int KIND>
__device__ __forceinline__ void passC_item(const Params& p, unsigned char* smem, const bf16_t* __restrict__ P, const bf16_t* __restrict__ VT, const bf16_t* __restrict__ ST, bf16_t* __restrict__ ycat, int idx) {
    constexpr int DV = KIND ? 256 : 128;
    const int tid = threadIdx.x, lane = tid & 63, wave = tid >> 6, r = lane & 15, q8 = lane >> 4, d = tid & 127, tq = tid >> 7;
    const int c = idx & 63, bh = idx >> 6, hd = KIND ? (bh & 3) : (bh & 7), b = KIND ? (bh >> 2) : (bh >> 3);
    const int tok0 = b * SEQ + c * 64;
    bf16_t* qs = (bf16_t*)smem;
    bf16_t* qh = (bf16_t*)(smem + 17408);
    bf16_t* ks = (bf16_t*)(smem + 34816);
    bf16_t* vS = (bf16_t*)(smem + 78336);
    bf16_t* pS = (bf16_t*)(smem + 115200);
    float* tot = (float*)(smem + 124416);
    float* ssq = (float*)(smem + 126464);
    float bl[16], kv[16], qv[16];
    u32x4 vr[DV / 64];
    { const bf16_t* vsrc = VT + (size_t)((KIND ? 1024 + hd * 256 : hd * 128)) * NTOK + tok0;
#pragma unroll
      for (int i = 0; i < DV / 64; ++i) { const int ch = tid + 512 * i, row = ch >> 3, c8 = ch & 7; vr[i] = *(const u32x4*)(vsrc + (size_t)row * NTOK + c8 * 8); } }
    decay_qk<KIND, true>(p, P, tok0, hd, d, tq, bl, kv, qv);
    tot[tq * 128 + d] = bl[15];
#pragma unroll
    for (int i = 0; i < DV / 64; ++i) { const int ch = tid + 512 * i, row = ch >> 3, c8 = ch & 7; *(u32x4*)(vS + row * 72 + c8 * 8) = vr[i]; }
    for (int i = tid; i < 64 * 72 / 8; i += 512) *(u32x4*)(pS + i * 8) = (u32x4){0, 0, 0, 0};
    __syncthreads();
    constexpr int NT = DV / 32;
    constexpr int NPRE = 4;
    const int oi = wave & 3, oeh = wave >> 2;
    const bf16_t* stb = ST + (KIND ? (size_t)33554432 : 0) + (size_t)idx * (DV * 128);
    const int gcol = KIND ? 4096 + hd * 256 : 2048 + hd * 128;
    bf16x8 bst[NPRE][4];
#pragma unroll
    for (int nt = 0; nt < NPRE; ++nt)
#pragma unroll
        for (int kk = 0; kk < 4; ++kk) bst[nt][kk] = *(const bf16x8*)(stb + (size_t)(oeh * (DV / 2) + 16 * nt + r) * 128 + 32 * kk + 8 * q8);
    bf16_t graw[4][NT];
#pragma unroll
    for (int j = 0; j < 4; ++j)
#pragma unroll
        for (int nt = 0; nt < NT; ++nt) graw[j][nt] = P[(size_t)(tok0 + 16 * oi + 4 * q8 + j) * LDO + gcol + oeh * (DV / 2) + 16 * nt + r];
    {
        const float t0 = tot[d], t1 = tot[128 + d], t2 = tot[256 + d];
        const float rpre = (tq > 0 ? t0 : 0.f) + (tq > 1 ? t1 : 0.f) + (tq > 2 ? t2 : 0.f);
        const float Ttq = bl[15], rn = rpre + Ttq;
        const float einv = __expf(fminf(-Ttq, 80.f));
        const float f1 = (tq == 1) ? einv : __expf(fminf(t0 - rn, 0.f));
        const float f2 = (tq == 2) ? einv : __expf(fminf(t0 + t1 - rn, 0.f));
        const float f3 = (tq == 3) ? einv : __expf(fminf(t0 + t1 + t2 - rn, 0.f));
        const float erp = __expf(rpre);
#pragma unroll
        for (int jj = 0; jj < 16; ++jj) {
            const int t = 16 * tq + jj;
            const float ql = qv[jj] * __expf(bl[jj]);
            qs[t * 136 + d] = f2bf(ql);
            qh[t * 136 + d] = f2bf(ql * erp);
            const float kb = kv[jj] * __expf(Ttq - bl[jj]);
            if (tq == 0) ks[(0 + t) * 136 + d] = f2bf(kb * einv);
            if (tq <= 1) ks[(16 + t) * 136 + d] = f2bf(kb * f1);
            if (tq <= 2) ks[(48 + t) * 136 + d] = f2bf(kb * f2);
            ks[(96 + t) * 136 + d] = f2bf(kb * f3);
        }
    }
    __syncthreads();
    {
        const int i = wave >> 1, off = 8 * i * (i + 1);
        bf16x8 af[4];
#pragma unroll
        for (int kk = 0; kk < 4; ++kk) af[kk] = *(const bf16x8*)(qs + (16 * i + r) * 136 + 32 * kk + 8 * q8);
        for (int jt = (wave & 1); jt <= i; jt += 2) {
            f32x4 acc = (f32x4){0.f, 0.f, 0.f, 0.f};
#pragma unroll
            for (int kk = 0; kk < 4; ++kk) { const bf16x8 bfr = *(const bf16x8*)(ks + (off + 16 * jt + r) * 136 + 32 * kk + 8 * q8);
                acc = __builtin_amdgcn_mfma_f32_16x16x32_bf16(af[kk], bfr, acc, 0, 0, 0); }
#pragma unroll
            for (int j = 0; j < 4; ++j) { float v = acc[j]; if (jt == i && r > 4 * q8 + j) v = 0.f;
                pS[(16 * i + 4 * q8 + j) * 72 + 16 * jt + r] = f2bf(v); }
        }
    }
    __syncthreads();
    {
        const int i = oi, eh = oeh;
        bf16x8 ap[2], aq[4];
#pragma unroll
        for (int kk = 0; kk < 2; ++kk) ap[kk] = *(const bf16x8*)(pS + (16 * i + r) * 72 + 32 * kk + 8 * q8);
#pragma unroll
        for (int kk = 0; kk < 4; ++kk) aq[kk] = *(const bf16x8*)(qh + (16 * i + r) * 136 + 32 * kk + 8 * q8);
        f32x4 o[NT];
        float ss[4] = {0.f, 0.f, 0.f, 0.f};
#pragma unroll
        for (int nt = 0; nt < NT; ++nt) {
            const int e0 = eh * (DV / 2) + 16 * nt;
            f32x4 acc = (f32x4){0.f, 0.f, 0.f, 0.f};
#pragma unroll
            for (int kk = 0; kk < 2; ++kk) { const bf16x8 bfr = *(const bf16x8*)(vS + (e0 + r) * 72 + 32 * kk + 8 * q8);
                acc = __builtin_amdgcn_mfma_f32_16x16x32_bf16(ap[kk], bfr, acc, 0, 0, 0); }
#pragma unroll
            for (int kk = 0; kk < 4; ++kk) { bf16x8 bfr;
                if (nt < NPRE) bfr = bst[nt < NPRE ? nt : 0][kk]; else bfr = *(const bf16x8*)(stb + (size_t)(e0 + r) * 128 + 32 * kk + 8 * q8);
                acc = __builtin_amdgcn_mfma_f32_16x16x32_bf16(aq[kk], bfr, acc, 0, 0, 0); }
            o[nt] = acc;
#pragma unroll
            for (int j = 0; j < 4; ++j) ss[j] += acc[j] * acc[j];
        }
#pragma unroll
        for (int j = 0; j < 4; ++j) {
#pragma unroll
            for (int ofs = 1; ofs < 16; ofs <<= 1) ss[j] += __shfl_xor(ss[j], ofs);
            if (r == 0) ssq[eh * 64 + 16 * i + 4 * q8 + j] = ss[j];
        }
        __syncthreads();
        const float* ng = (KIND ? p.gla_ng + hd * 256 : p.hgrn_ng + hd * 128);
        const int ycol = KIND ? 1024 + hd * 256 : hd * 128;
#pragma unroll
        for (int j = 0; j < 4; ++j) {
            const int t = 16 * i + 4 * q8 + j;
            const float rstd = __builtin_amdgcn_rsqf((ssq[t] + ssq[64 + t]) * (1.f / DV) + EPS);
            bf16_t* yp = ycat + (size_t)(tok0 + t) * DM + ycol;
#pragma unroll
            for (int nt = 0; nt < NT; ++nt) { const int e = eh * (DV / 2) + 16 * nt + r;
                const float g = bf2f(graw[j][nt]);
                yp[e] = f2bf(o[nt][j] * rstd * ng[e] * (g * sigmoidf_(g))); }
        }
    }
}

#define XB_TMO      128
#define XB_XCNT(j)  (256  + 64 * (j))
#define XB_XSUB(j)  (1280 + 64 * (j))
#define XB_XGEN(j)  (2304 + 64 * (j))
#define XB_TOP      3328
#define XB_TOPGEN   3392
#define XCD_BAR_WORDS 3456
#define XB_SPIN_CAP (1u << 18)
__device__ __forceinline__ unsigned xb_ld(unsigned* p)              { return __hip_atomic_load(p, __ATOMIC_RELAXED, __HIP_MEMORY_SCOPE_AGENT); }
__device__ __forceinline__ unsigned xb_add(unsigned* p, unsigned v) { return __hip_atomic_fetch_add(p, v, __ATOMIC_RELAXED, __HIP_MEMORY_SCOPE_AGENT); }
__device__ __forceinline__ unsigned xb_xcc_id() { return (unsigned)__builtin_amdgcn_s_getreg((3 << 11) | 20) & 0xFu; }
#define XB_SPIN(cond, bar) do { unsigned _sp = 0; while (cond) { __builtin_amdgcn_s_sleep(1); \
    if ((++_sp & 255u) == 0u) { if (xb_ld(&(bar)[XB_TMO])) break; if (_sp > XB_SPIN_CAP) { atomicAdd(&(bar)[XB_TMO], 1u); break; } } } } while (0)
struct XcdBarrier { unsigned* bar; unsigned x; volatile LAS unsigned* st; };
__device__ __forceinline__ XcdBarrier xcd_barrier_post(unsigned* bar, volatile LAS unsigned* st) {
    XcdBarrier b; b.bar = bar; b.x = xb_xcc_id(); b.st = st;
    if (threadIdx.x == 0) (void)xb_add(&bar[XB_XCNT(b.x)], 1u);
    return b;
}
__device__ __forceinline__ void xcd_barrier_complete(unsigned* bar, unsigned x, unsigned& nloc, unsigned& nx) {
    const unsigned G = gridDim.x * gridDim.y * gridDim.z;
    unsigned sum, cnt, mine, sp = 0u;
    for (;;) {
        sum = 0u; cnt = 0u; mine = 0u;
#pragma unroll
        for (unsigned j = 0; j < 16; ++j) { const unsigned c = xb_ld(&bar[XB_XCNT(j)]); sum += c; cnt += (c > 0u) ? 1u : 0u; mine = (j == x) ? c : mine; }
        if (sum == G) break;
        __builtin_amdgcn_s_sleep(1);
        if ((++sp & 255u) == 0u) { if (xb_ld(&bar[XB_TMO])) break; if (sp > XB_SPIN_CAP) { atomicAdd(&bar[XB_TMO], 1u); break; } }
    }
    nloc = mine > 0u ? mine : 1u; nx = cnt > 0u ? cnt : 1u;
}
__device__ __forceinline__ void xcd_barrier(const XcdBarrier& b) {
    asm volatile("s_waitcnt vmcnt(0)" ::: "memory");
    __syncthreads();
    if (threadIdx.x == 0) {
        unsigned* bar = b.bar;
        __builtin_amdgcn_s_waitcnt(0);
        unsigned nloc = b.st[0], nx = b.st[1];
        if (nloc == 0u) { xcd_barrier_complete(bar, b.x, nloc, nx); b.st[0] = nloc; b.st[1] = nx; }
        const unsigned old = xb_add(&bar[XB_XSUB(b.x)], 1u);
        const unsigned gen = old / nloc;
        if (old + 1u == (gen + 1u) * nloc) {
            __builtin_amdgcn_fence(__ATOMIC_RELEASE, "agent");
            asm volatile("s_waitcnt vmcnt(0)" ::: "memory");
            const unsigned og = xb_add(&bar[XB_TOP], 1u);
            const unsigned tg = og / nx;
            if (og + 1u == (tg + 1u) * nx) xb_add(&bar[XB_TOPGEN], 1u);
            else XB_SPIN(xb_ld(&bar[XB_TOPGEN]) == tg, bar);
            __builtin_amdgcn_fence(__ATOMIC_ACQUIRE, "agent");
            xb_add(&bar[XB_XGEN(b.x)], 1u);
            asm volatile("s_waitcnt vmcnt(0)" ::: "memory");
        } else {
            XB_SPIN(xb_ld(&bar[XB_XGEN(b.x)]) == gen, bar);
            __builtin_amdgcn_fence(__ATOMIC_ACQUIRE, "agent");
            asm volatile("s_waitcnt vmcnt(0)" ::: "memory");
        }
    }
    __syncthreads();
}

__global__ void __launch_bounds__(512, 2) fwd_kernel(Params p) {
    extern __shared__ __attribute__((aligned(16))) unsigned char smem[];
    cg::grid_group grid = cg::this_grid();
    const int tid = threadIdx.x, lane = tid & 63, wave = tid >> 6;
    const int G = gridDim.x, gw = blockIdx.x * 8 + wave, NGW = G * 8;
    unsigned char* ws = p.ws;
    bf16_t* Wout = (bf16_t*)(ws + WS_WOUT); bf16_t* W1t = (bf16_t*)(ws + WS_W1); bf16_t* W2t = (bf16_t*)(ws + WS_W2); bf16_t* Win = (bf16_t*)(ws + WS_WIN);
    bf16_t* U = (bf16_t*)(ws + WS_U); bf16_t* BIG = (bf16_t*)(ws + WS_BIG); bf16_t* YZ = (bf16_t*)(ws + WS_YZ);
    bf16_t* VTE = (bf16_t*)(ws + WS_VT_E); bf16_t* VTO = (bf16_t*)(ws + WS_VT_O); bf16_t* ST = (bf16_t*)(ws + WS_ST); float* DEC = (float*)(ws + WS_DEC);
    float* RS = (float*)(ws + WS_RS); bf16_t* YC = (bf16_t*)p.out;
    float* scr = (float*)(smem + wave * 8448);
    LAS unsigned char* lds = (LAS unsigned char*)smem;
    const int lo = p.ph_lo, hi = p.ph_hi;
#define IN(k) (lo <= (k) && (k) < hi)
#define SEAM(k) do { if (IN(k) && IN((k) + 1)) xcd_barrier(xbar); } while (0)
    if (lo < 0) grid.sync();
    volatile LAS unsigned* xst = (volatile LAS unsigned*)(lds + 131072 + 1024);
    if (tid < 4) xst[tid] = 0u;
    __syncthreads();
    XcdBarrier xbar; xbar.bar = (unsigned*)(ws + WS_BAR); xbar.x = 0; xbar.st = xst;
    if (hi - lo > 1) xbar = xcd_barrier_post((unsigned*)(ws + WS_BAR), xst);

    if (IN(0)) {
        cvt_seg(p.even_w_in, DM, 6144, 0, 5120, Win, 0, p.norm_g, scr, gw, NGW, lane);
        cvt_seg(p.even_w_in, DM, 6144, 5120, 1024, Win, 5120, p.norm_g, scr, gw, NGW, lane);
        cvt_seg(p.even_w_out, DM, DM, 0, DM, Wout, 0, nullptr, scr, gw, NGW, lane);
        cvt_seg(p.w1, DM, DFF, 0, DFF, W1t, 0, p.norm_g + 2 * DM, scr, gw, NGW, lane);
        cvt_seg(p.w2, DFF, DM, 0, DM, W2t, 0, nullptr, scr, gw, NGW, lane);
        rowwise<0>(p.x, nullptr, nullptr, U, RS, nullptr, gw, NGW, lane);
    }
    SEAM(0);
    if (IN(1)) {
        { pg8::Gemm g{U, Win, NTOK, LDE, DM}; pg8::StaticOrder S; S.init(NTOK, LDE, G, blockIdx.x); pg8::EpiB<0, 1> E{BIG, LDE, RS}; pg8::gemm_phase(lds, g, S, E); }
        { pg8::Gemm g{Win + (size_t)5120 * DM, U, 1024, NTOK, DM}; pg8::StaticOrder S; S.init(1024, NTOK, G, blockIdx.x); pg8::EpiB<0, 2> E{VTE, NTOK, RS}; pg8::gemm_phase(lds, g, S, E); }
    }
    SEAM(1);
    if (IN(2)) { conv_phase(BIG, p.conv_w, YC); attn_phase(smem, BIG, VTE, p.rel_bias, YC); }
    SEAM(2);
    if (IN(3)) { pg8::Gemm g{YC, Wout, NTOK, DM, DM}; pg8::StaticOrder S; S.init(NTOK, DM, G, blockIdx.x); pg8::EpiB<0, 0> E{YZ, DM, nullptr}; pg8::gemm_phase(lds, g, S, E); }
    SEAM(3);
    if (IN(4)) rowwise<1>(nullptr, YZ, p.norm_g + 1 * DM, U, RS, nullptr, gw, NGW, lane);
    SEAM(4);
    if (IN(5)) { pg8::Gemm g{U, W1t, NTOK, DFF, DM}; pg8::StaticOrder S; S.init(NTOK, DFF, G, blockIdx.x); pg8::EpiB<1, 1> E{BIG, DFF, RS}; pg8::gemm_phase(lds, g, S, E); }
    SEAM(5);
    if (IN(6)) { pg8::Gemm g{BIG, W2t, NTOK, DM, DFF}; pg8::StaticOrder S; S.init(NTOK, DM, G, blockIdx.x); pg8::EpiB<0, 0> E{YZ, DM, nullptr}; pg8::gemm_phase(lds, g, S, E); }
    SEAM(6);
    if (IN(7)) {
        rowwise<1>(nullptr, YZ, p.norm_g + 3 * DM, U, RS, nullptr, gw, NGW, lane);
        const float* wi = p.odd_w_in;
        cvt_seg(wi, DM, 7184, 0, 2048, Win, 0, p.norm_g + 4 * DM, scr, gw, NGW, lane);
        cvt_seg(wi, DM, 7184, 3072, 2048, Win, 2048, p.norm_g + 4 * DM, scr, gw, NGW, lane);
        cvt_seg(wi, DM, 7184, 6144, 1040, Win, 4096, p.norm_g + 4 * DM, scr, gw, NGW, lane);
        cvt_seg(wi, DM, 7184, 2048, 1024, Win, 5376, p.norm_g + 4 * DM, scr, gw, NGW, lane);
        cvt_seg(wi, DM, 7184, 5120, 1024, Win, 6400, p.norm_g + 4 * DM, scr, gw, NGW, lane);
        cvt_seg(p.odd_w_out, DM, DM, 0, DM, Wout, 0, nullptr, scr, gw, NGW, lane);
        cvt_seg(p.w1 + (size_t)DM * DFF, DM, DFF, 0, DFF, W1t, 0, p.norm_g + 6 * DM, scr, gw, NGW, lane);
        cvt_seg(p.w2 + (size_t)DM * DFF, DFF, DM, 0, DM, W2t, 0, nullptr, scr, gw, NGW, lane);
    }
    SEAM(7);
    if (IN(8)) {
        { pg8::Gemm g{U, Win, NTOK, 5120, DM}; pg8::StaticOrder S; S.init(NTOK, 5120, G, blockIdx.x); pg8::EpiB<0, 1> E{BIG, LDO, RS}; pg8::gemm_phase(lds, g, S, E); }
        { pg8::Gemm g{Win + (size_t)5376 * DM, U, 2048, NTOK, DM}; pg8::StaticOrder S; S.init(2048, NTOK, G, blockIdx.x); pg8::EpiB<0, 2> E{VTO, NTOK, RS}; pg8::gemm_phase(lds, g, S, E); }
        if (wave < 4) {
            const int r = lane & 15, q8 = lane >> 4, t0 = (blockIdx.x * 4 + wave) * 16;
            if (t0 < NTOK) {
                const bf16_t* ap = U + (size_t)(t0 + r) * DM + 8 * q8;
                const bf16_t* bp = Win + (size_t)(5120 + r) * DM + 8 * q8;
                f32x4 acc = (f32x4){0.f, 0.f, 0.f, 0.f};
#pragma unroll 8
                for (int kk = 0; kk < DM / 32; ++kk) { const bf16x8 a = *(const bf16x8*)(ap + 32 * kk), b = *(const bf16x8*)(bp + 32 * kk);
                    acc = __builtin_amdgcn_mfma_f32_16x16x32_bf16(a, b, acc, 0, 0, 0); }
#pragma unroll
                for (int j = 0; j < 4; ++j) BIG[(size_t)(t0 + 4 * q8 + j) * LDO + 5120 + r] = f2bf(acc[j] * RS[t0 + 4 * q8 + j]);
            }
        }
    }
    SEAM(8);
    if (IN(9)) {
        int par = 0;
        for (int it = blockIdx.x; it < 2048; it += G) { passA_item<0>(p, smem, BIG, VTO, ST, DEC, it, par); par ^= 1; }
        for (int it = blockIdx.x; it < 1024; it += G) { passA_item<1>(p, smem, BIG, VTO, ST, DEC, it, par); par ^= 1; }
    }
    SEAM(9);
    if (IN(10)) scan_phase(ST, DEC);
    SEAM(10);
    if (IN(11)) {
        for (int it = blockIdx.x; it < 2048; it += G) passC_item<0>(p, smem, BIG, VTO, ST, YC, it);
        for (int it = blockIdx.x; it < 1024; it += G) passC_item<1>(p, smem, BIG, VTO, ST, YC, it);
    }
    SEAM(11);
    if (IN(12)) { pg8::Gemm g{YC, Wout, NTOK, DM, DM}; pg8::StaticOrder S; S.init(NTOK, DM, G, blockIdx.x); pg8::EpiB<0, 0> E{YZ, DM, nullptr}; pg8::gemm_phase(lds, g, S, E); }
    SEAM(12);
    if (IN(13)) rowwise<1>(nullptr, YZ, p.norm_g + 5 * DM, U, RS, nullptr, gw, NGW, lane);
    SEAM(13);
    if (IN(14)) { pg8::Gemm g{U, W1t, NTOK, DFF, DM}; pg8::StaticOrder S; S.init(NTOK, DFF, G, blockIdx.x); pg8::EpiB<1, 1> E{BIG, DFF, RS}; pg8::gemm_phase(lds, g, S, E); }
    SEAM(14);
    if (IN(15)) { pg8::Gemm g{BIG, W2t, NTOK, DM, DFF}; pg8::StaticOrder S; S.init(NTOK, DM, G, blockIdx.x); pg8::EpiB<0, 0> E{YZ, DM, nullptr}; pg8::gemm_phase(lds, g, S, E); }
    SEAM(15);
    if (IN(16)) rowwise<2>(nullptr, YZ, p.norm_g + 7 * DM, U, nullptr, p.out, gw, NGW, lane);
#undef IN
#undef SEAM
}

constexpr int NPHASE = 17;

extern "C" void kernel_launch(void* const* d_in, const int* in_sizes, int n_in, void* d_out, int out_size, void* d_ws, size_t ws_size, hipStream_t stream) {
    static int grid = 0;
    if (grid == 0) {
        if (ws_size < WS_END) fprintf(stderr, "kernel_launch: workspace too small: %zu < %zu\n", ws_size, (size_t)WS_END);
        int dev = 0, cus = 0, per_cu = 0;
        hipGetDevice(&dev);
        hipDeviceGetAttribute(&cus, hipDeviceAttributeMultiprocessorCount, dev);
        if (hipFuncSetAttribute((const void*)fwd_kernel, hipFuncAttributeMaxDynamicSharedMemorySize, LDS_BYTES) != hipSuccess) fprintf(stderr, "kernel_launch: hipFuncSetAttribute failed\n");
        if (hipOccupancyMaxActiveBlocksPerMultiprocessor(&per_cu, (const void*)fwd_kernel, 512, LDS_BYTES) != hipSuccess || per_cu < 1) { per_cu = 1; (void)hipGetLastError(); }
        grid = cus * (per_cu > 1 ? 1 : per_cu);
        if (grid <= 0) grid = 256;
    }
    Params p{};
    p.x = (const float*)d_in[0]; p.norm_g = (const float*)d_in[1]; p.even_w_in = (const float*)d_in[2]; p.conv_w = (const float*)d_in[3];
    p.rel_bias = (const float*)d_in[4]; p.even_w_out = (const float*)d_in[5]; p.odd_w_in = (const float*)d_in[6]; p.hgrn_lb = (const float*)d_in[7];
    p.hgrn_ng = (const float*)d_in[8]; p.wa2 = (const float*)d_in[9]; p.ba = (const float*)d_in[10]; p.gla_ng = (const float*)d_in[11];
    p.odd_w_out = (const float*)d_in[12]; p.w1 = (const float*)d_in[13]; p.w2 = (const float*)d_in[14];
    p.out = (float*)d_out; p.ws = (unsigned char*)d_ws;
#if ONE_LAUNCH
    (void)hipMemsetAsync((unsigned char*)d_ws + WS_BAR, 0, 16384, stream);
    p.ph_lo = 0; p.ph_hi = NPHASE;
    void* args[] = {&p};
    hipError_t e = hipLaunchCooperativeKernel((const void*)fwd_kernel, dim3(grid), dim3(512), args, LDS_BYTES, stream);
    if (e != hipSuccess) fprintf(stderr, "cooperative launch failed: %s (grid %d)\n", hipGetErrorString(e), grid);
#else
    for (int k = 0; k < NPHASE; ++k) {
        p.ph_lo = k; p.ph_hi = k + 1;
        hipLaunchKernelGGL(fwd_kernel, dim3(grid), dim3(512), LDS_BYTES, stream, p);
    }
#endif
}
```

```cpp
#include <hip/hip_runtime.h>
#include <hip/hip_cooperative_groups.h>
#include <cstdio>
namespace cg = cooperative_groups;

#ifndef ONE_LAUNCH
#define ONE_LAUNCH 1
#endif

typedef unsigned short bf16_t;
typedef short bf16x8 __attribute__((ext_vector_type(8)));
typedef float f32x4 __attribute__((ext_vector_type(4)));
typedef unsigned u32x4 __attribute__((ext_vector_type(4)));
typedef unsigned u32x2 __attribute__((ext_vector_type(2)));
#define LAS __attribute__((address_space(3)))

constexpr int DM = 2048, NTOK = 16384, SEQ = 4096, DFF = 8192;
constexpr int LDE = 5120;
constexpr int LDO = 5376;
constexpr float EPS = 1e-6f;

constexpr size_t WS_WOUT = 0;
constexpr size_t WS_W1 = 8388608;
constexpr size_t WS_W2 = WS_W1 + 33554432;
constexpr size_t WS_U = WS_W2 + 33554432;
constexpr size_t WS_BIG = WS_U + 67108864;
constexpr size_t WS_WIN = WS_BIG + 268435456;
constexpr size_t WS_YZ = WS_WIN + 30408704;
constexpr size_t WS_VT_E = WS_BIG + (size_t)NTOK * LDE * 2;
constexpr size_t WS_VT_O = WS_BIG + (size_t)NTOK * LDO * 2;
constexpr size_t WS_ST = WS_VT_O + 67108864;
constexpr size_t WS_DEC = WS_ST + 134217728;
constexpr size_t WS_BAR = WS_DEC + 3072 * 128 * 4;
constexpr size_t WS_SS = WS_BAR + 16384;
constexpr size_t WS_PCNT = WS_SS + 8 * 65536;
constexpr size_t WS_END = WS_PCNT + 4096;
constexpr size_t WS_ZERO_BYTES = WS_END - WS_BAR;

constexpr int LDS_BYTES = 131072 + 4096;

__device__ __forceinline__ float bf2f(bf16_t v) { return __uint_as_float(((unsigned)v) << 16); }
typedef float f32x2 __attribute__((ext_vector_type(2)));
typedef __bf16 bf16x2v __attribute__((ext_vector_type(2)));
__device__ __forceinline__ unsigned pk2(float lo, float hi) { f32x2 v = {lo, hi}; bf16x2v b = __builtin_convertvector(v, bf16x2v); return __builtin_bit_cast(unsigned, b); }
__device__ __forceinline__ bf16_t f2bf(float f) { return __builtin_bit_cast(bf16_t, (__bf16)f); }
__device__ __forceinline__ float wave_sum(float v) {
#pragma unroll
    for (int o = 1; o < 64; o <<= 1) v += __shfl_xor(v, o);
    return v;
}
__device__ __forceinline__ float frcp(float x) { return __builtin_amdgcn_rcpf(x); }
__device__ __forceinline__ float sigmoidf_(float x) { return frcp(1.f + __expf(-x)); }
#define LDS_WAIT() asm volatile("s_waitcnt lgkmcnt(0)" ::: "memory")
__device__ __forceinline__ float dpp_f(float v, int ctrl_sel) {
    const int x = __float_as_int(v); int y;
    if (ctrl_sel == 0) y = __builtin_amdgcn_update_dpp(x, x, 0xB1, 0xF, 0xF, false);
    else if (ctrl_sel == 1) y = __builtin_amdgcn_update_dpp(x, x, 0x4E, 0xF, 0xF, false);
    else if (ctrl_sel == 2) y = __builtin_amdgcn_update_dpp(x, x, 0x141, 0xF, 0xF, false);
    else y = __builtin_amdgcn_update_dpp(x, x, 0x140, 0xF, 0xF, false);
    return __int_as_float(y);
}
__device__ __forceinline__ float row16_max(float v) { v = fmaxf(v, dpp_f(v, 0)); v = fmaxf(v, dpp_f(v, 1)); v = fmaxf(v, dpp_f(v, 2)); v = fmaxf(v, dpp_f(v, 3)); return v; }
__device__ __forceinline__ float row16_sum(float v) { v += dpp_f(v, 0); v += dpp_f(v, 1); v += dpp_f(v, 2); v += dpp_f(v, 3); return v; }

namespace pg8 {
constexpr int BM = 256, BK = 64, HALF = 128, HTB = HALF * BK * 2, STAGE_BYTES = 8 * HTB, NXCD = 8, WGM = 8;
__host__ __device__ __forceinline__ int lds_byte(int r, int c) { const int st = (r >> 4) * 2 + (c >> 5), rr = r & 15, cc = c & 31, ob = rr * 64 + cc * 2; return st * 1024 + (ob ^ (((ob >> 9) & 1) << 5)); }
__host__ __device__ __forceinline__ void stage_rc(int b, int& R, int& C) { const int st = b / 1024, sb = b % 1024, swz = sb ^ (((sb >> 9) & 1) << 5); R = (st >> 1) * 16 + swz / 64; C = (st & 1) * 32 + (swz % 64) / 2; }
__host__ __device__ __forceinline__ int perm32(int rho) { const int n = rho >> 4, i = rho & 15; return 8 * (i >> 2) + 4 * n + (i & 3); }
struct Unit { int pm, pn; };
struct Gemm { const bf16_t* A; const bf16_t* Bt; int M, N, K; };
struct StaticOrder {
    int nM, nN, nwg, G, c;
    __device__ void init(int M, int N, int G_, int c_) { nM = M / BM; nN = N / BM; nwg = nM * nN; G = G_; c = c_; }
    __device__ bool next(int i, Unit& u) const {
        const long L = (long)i * G + c; if (L >= nwg) return false;
        int wgid = (int)L; { const int q = nwg / NXCD, r = nwg % NXCD, xcd = wgid % NXCD, off = wgid / NXCD; wgid = (xcd < r ? xcd * (q + 1) : r * (q + 1) + (xcd - r) * q) + off; }
        const int nig = WGM * nN, gid = wgid / nig, fm = gid * WGM, gsz = (nM - fm) < WGM ? (nM - fm) : WGM;
        u.pm = fm + ((wgid % nig) % gsz); u.pn = (wgid % nig) / gsz; return true;
    }
};
template <int ACT, int RS> struct EpiB {
    static constexpr bool PERM = true;
    bf16_t* O; int ldc; const float* rs;
    __device__ __forceinline__ void load_rs(const Unit& u, int wr, int fr, float (&rsv)[8]) const {
        if (RS == 1) {
#pragma unroll
            for (int q = 0; q < 8; ++q) rsv[q] = __builtin_amdgcn_rsqf(rs[u.pm * BM + wr * 64 + fr + (q >> 2) * HALF + (q & 3) * 16] * (1.f / 2048.f) + 1e-6f); }
    }
    __device__ __forceinline__ void operator()(const f32x4 (&acc)[2][2][4][2], const Unit& u, int wr, int wc, int fr, int fq, const float (&rsv)[8]) const {
        const int row0 = u.pm * BM + wr * 64 + fr, col0 = u.pn * BM + wc * 32 + 8 * fq;
        f32x4 cs[2][2];
        if (RS == 2) {
#pragma unroll
            for (int bj = 0; bj < 2; ++bj) { cs[bj][0] = *(const f32x4*)(rs + col0 + bj * HALF); cs[bj][1] = *(const f32x4*)(rs + col0 + bj * HALF + 4);
#pragma unroll
                for (int e = 0; e < 4; ++e) { cs[bj][0][e] = __builtin_amdgcn_rsqf(cs[bj][0][e] * (1.f / 2048.f) + 1e-6f); cs[bj][1][e] = __builtin_amdgcn_rsqf(cs[bj][1][e] * (1.f / 2048.f) + 1e-6f); } } }
#pragma unroll
        for (int ai = 0; ai < 2; ++ai)
#pragma unroll
            for (int m = 0; m < 4; ++m) { const int row = row0 + ai * HALF + m * 16; bf16_t* rowp = O + (size_t)row * ldc + col0;
                float rsc = 1.f; if (RS == 1) rsc = rsv[ai * 4 + m];
#pragma unroll
                for (int bj = 0; bj < 2; ++bj) { f32x4 v0 = acc[ai][bj][m][0], v1 = acc[ai][bj][m][1];
                    if (RS == 1) { v0 *= rsc; v1 *= rsc; }
                    if (RS == 2) { v0 *= cs[bj][0]; v1 *= cs[bj][1]; }
                    if (ACT == 1) {
#pragma unroll
                        for (int j = 0; j < 4; ++j) { float a = fmaxf(v0[j], 0.f), b = fmaxf(v1[j], 0.f); v0[j] = a * a; v1[j] = b * b; } }
                    u32x4 w; w.x = pk2(v0[0], v0[1]); w.y = pk2(v0[2], v0[3]); w.z = pk2(v1[0], v1[1]); w.w = pk2(v1[2], v1[3]);
                    *(u32x4*)(rowp + bj * HALF) = w; } }
    }
};

struct PanelOrder {
    int c;
    __device__ bool next(int i, Unit& u) const { if (i >= 2) return false; const int x = c & 7, k = c >> 3; u.pm = i * 32 + x * 4 + (k >> 3); u.pn = k & 7; return true; }
};
template <bool FINAL> struct EpiRes {
    static constexpr bool PERM = true;
    bf16_t* hb; float* out; const float* g1; float* ssY; float* ssH; unsigned* cnt;
    __device__ __forceinline__ void load_rs(const Unit&, int, int, float (&)[8]) const {}
    __device__ __forceinline__ void operator()(const f32x4 (&acc)[2][2][4][2], const Unit& u, int wr, int wc, int fr, int fq, const float (&)[8]) const {
        const int row0 = u.pm * BM + wr * 64 + fr, col0 = u.pn * BM + wc * 32 + 8 * fq;
#pragma unroll
        for (int q = 0; q < 8; ++q) { const int ai = q >> 2, m = q & 3; float sq = 0.f;
#pragma unroll
            for (int bj = 0; bj < 2; ++bj)
#pragma unroll
                for (int n = 0; n < 2; ++n)
#pragma unroll
                    for (int e = 0; e < 4; ++e) sq += acc[ai][bj][m][n][e] * acc[ai][bj][m][n][e];
            sq += __shfl_xor(sq, 16); sq += __shfl_xor(sq, 32);
            if (fq == 0) (void)__hip_atomic_fetch_add(ssY + row0 + ai * HALF + m * 16, sq, __ATOMIC_RELAXED, __HIP_MEMORY_SCOPE_AGENT); }
        asm volatile("s_waitcnt vmcnt(0)" ::: "memory");
        __builtin_amdgcn_s_barrier();
        if (threadIdx.x == 0) {
            (void)__hip_atomic_fetch_add(cnt + u.pm, 1u, __ATOMIC_RELAXED, __HIP_MEMORY_SCOPE_AGENT);
            unsigned sp = 0;
            while (__hip_atomic_load(cnt + u.pm, __ATOMIC_RELAXED, __HIP_MEMORY_SCOPE_AGENT) < 8u) { __builtin_amdgcn_s_sleep(1); if (++sp > (1u << 22)) break; }
        }
        asm volatile("" ::: "memory");
        __builtin_amdgcn_s_barrier();
        asm volatile("" ::: "memory");
        f32x4 gv[2][2];
#pragma unroll
        for (int bj = 0; bj < 2; ++bj) { gv[bj][0] = *(const f32x4*)(g1 + col0 + bj * HALF); gv[bj][1] = *(const f32x4*)(g1 + col0 + bj * HALF + 4); }
#pragma unroll
        for (int q = 0; q < 8; ++q) { const int ai = q >> 2, m = q & 3, row = row0 + ai * HALF + m * 16;
            const float rs1 = __builtin_amdgcn_rsqf(__hip_atomic_load(ssY + row, __ATOMIC_RELAXED, __HIP_MEMORY_SCOPE_AGENT) * (1.f / 2048.f) + 1e-6f);
            bf16_t* rowp = hb + (size_t)row * 2048 + col0; float s2 = 0.f;
#pragma unroll
            for (int bj = 0; bj < 2; ++bj) { const u32x4 hw = *(const u32x4*)(rowp + bj * HALF);
                f32x4 h0, h1;
                h0[0] = __uint_as_float(hw[0] << 16); h0[1] = __uint_as_float(hw[0] & 0xffff0000u); h0[2] = __uint_as_float(hw[1] << 16); h0[3] = __uint_as_float(hw[1] & 0xffff0000u);
                h1[0] = __uint_as_float(hw[2] << 16); h1[1] = __uint_as_float(hw[2] & 0xffff0000u); h1[2] = __uint_as_float(hw[3] << 16); h1[3] = __uint_as_float(hw[3] & 0xffff0000u);
                h0 += acc[ai][bj][m][0] * rs1 * gv[bj][0]; h1 += acc[ai][bj][m][1] * rs1 * gv[bj][1];
                if (FINAL) { float* op = out + (size_t)row * 2048 + col0 + bj * HALF; *(f32x4*)op = h0; *(f32x4*)(op + 4) = h1; }
                else {
#pragma unroll
                    for (int e = 0; e < 4; ++e) s2 += h0[e] * h0[e] + h1[e] * h1[e];
                    u32x4 w; w.x = pk2(h0[0], h0[1]); w.y = pk2(h0[2], h0[3]); w.z = pk2(h1[0], h1[1]); w.w = pk2(h1[2], h1[3]);
                    *(u32x4*)(rowp + bj * HALF) = w; } }
            if (!FINAL) { s2 += __shfl_xor(s2, 16); s2 += __shfl_xor(s2, 32);
                if (fq == 0) (void)__hip_atomic_fetch_add(ssH + row, s2, __ATOMIC_RELAXED, __HIP_MEMORY_SCOPE_AGENT); } }
    }
};

template <class Epi, class Sched>
__device__ __forceinline__ void gemm_phase(LAS unsigned char* lds, const Gemm g, const Sched& S, const Epi& E) {
    const int tid = threadIdx.x, wid = __builtin_amdgcn_readfirstlane(tid >> 6), lane = tid & 63, wr = wid >> 2, wc = wid & 3, fr = lane & 15, fq = lane >> 4;
    const int K = g.K, nt = K / BK;
    unsigned voffA[2], voffB[2];
#pragma unroll
    for (int i = 0; i < 2; ++i) { int R, C; stage_rc(tid * 16 + i * 8192, R, C); const int Rb = Epi::PERM ? ((R & ~31) + perm32(R & 31)) : R;
        voffA[i] = (unsigned)(R * K + C) * 2u; voffB[i] = (unsigned)(Rb * K + C) * 2u; }
    const size_t kstep = (size_t)(BK * 2);
    const size_t hstep = (size_t)HALF * K * 2;
    const size_t tstep = 2 * hstep;
    const unsigned ldsw = (unsigned)wid * 1024u;
    const int aoff = lds_byte(wr * 64 + fr, fq * 8), boff = lds_byte(wc * 32 + fr, fq * 8);
#define PG8_SA(b, h) (((b) * 2 + (h)) * HTB)
#define PG8_SB(b, h) ((4 + (b) * 2 + (h)) * HTB)
#define PG8_STAGE(bufoff, gbase, voff) do { _Pragma("unroll") for (int _i = 0; _i < 2; ++_i) \
        __builtin_amdgcn_global_load_lds((const unsigned*)((const char*)(gbase) + (voff)[_i]), (LAS unsigned*)(lds + (bufoff) + ldsw + _i * 8192), 16, 0, 0); } while (0)
#define PG8_LDA(dst, b, h) do { _Pragma("unroll") for (int m = 0; m < 4; ++m) _Pragma("unroll") for (int k = 0; k < 2; ++k) dst[m][k] = *(const LAS bf16x8*)(lds + PG8_SA(b, h) + aoff + m * 2048 + k * 1024); } while (0)
#define PG8_LDB(dst, b, h) do { _Pragma("unroll") for (int n = 0; n < 2; ++n) _Pragma("unroll") for (int k = 0; k < 2; ++k) dst[n][k] = *(const LAS bf16x8*)(lds + PG8_SB(b, h) + boff + n * 2048 + k * 1024); } while (0)
#define PG8_MMA(ai, bj, At, Bt) do { __builtin_amdgcn_s_setprio(1); _Pragma("unroll") for (int m = 0; m < 4; ++m) _Pragma("unroll") for (int n = 0; n < 2; ++n) _Pragma("unroll") for (int k = 0; k < 2; ++k) \
        acc[ai][bj][m][n] = __builtin_amdgcn_mfma_f32_16x16x32_bf16(Bt[n][k], At[m][k], acc[ai][bj][m][n], 0, 0, 0); __builtin_amdgcn_s_setprio(0); } while (0)
#define PG8_WAIT_V(n) asm volatile("s_waitcnt vmcnt(" #n ")" ::: "memory")
#define PG8_WAIT_L(n) asm volatile("s_waitcnt lgkmcnt(" #n ")" ::: "memory")
#define PG8_BAR __builtin_amdgcn_s_barrier()
#define PG8_SCHED __builtin_amdgcn_sched_barrier(0)
    Unit cur, nxt; int ui = 0;
    if (!S.next(0, cur)) return;
    f32x4 acc[2][2][4][2];
#pragma unroll
    for (int a = 0; a < 2; ++a)
#pragma unroll
        for (int b = 0; b < 2; ++b)
#pragma unroll
            for (int m = 0; m < 4; ++m)
#pragma unroll
                for (int n = 0; n < 2; ++n) acc[a][b][m][n] = (f32x4){0.f, 0.f, 0.f, 0.f};
    bf16x8 At[4][2], B0[2][2], B1[2][2];
    const char* cA = (const char*)g.A + (size_t)cur.pm * tstep; const char* cB = (const char*)g.Bt + (size_t)cur.pn * tstep;
    float rsv[8] = {1.f, 1.f, 1.f, 1.f, 1.f, 1.f, 1.f, 1.f};
    E.load_rs(cur, wr, fr, rsv);
    PG8_STAGE(PG8_SB(0, 0), cB, voffB); PG8_STAGE(PG8_SB(0, 1), cB + hstep, voffB); PG8_STAGE(PG8_SA(0, 0), cA, voffA); PG8_STAGE(PG8_SA(0, 1), cA + hstep, voffA);
    if (wr == 1) PG8_BAR;
    PG8_WAIT_V(2); PG8_BAR;
    PG8_STAGE(PG8_SB(1, 0), cB + kstep, voffB); PG8_STAGE(PG8_SA(1, 0), cA + kstep, voffA); PG8_STAGE(PG8_SB(1, 1), cB + hstep + kstep, voffB);
    PG8_WAIT_V(6); PG8_BAR;
    for (;;) {
        const bool has_next = S.next(ui + 1, nxt);
        const char* nA = has_next ? (const char*)g.A + (size_t)nxt.pm * tstep : cA; const char* nB = has_next ? (const char*)g.Bt + (size_t)nxt.pn * tstep : cB;
        for (int t = 0; t < nt; t += 2) {
            const bool last = (t == nt - 2);
            const char* a1 = cA + (size_t)(t + 1) * kstep;
            const char* a2 = last ? nA : cA + (size_t)(t + 2) * kstep; const char* b2 = last ? nB : cB + (size_t)(t + 2) * kstep;
            const char* a3 = a2 + kstep; const char* b3 = b2 + kstep;
            PG8_LDB(B0, 0, 0); PG8_LDB(B1, 0, 1); PG8_SCHED; PG8_LDA(At, 0, 0); PG8_STAGE(PG8_SA(1, 1), a1 + hstep, voffA);
            PG8_WAIT_V(8); PG8_WAIT_L(0); PG8_BAR; PG8_MMA(0, 0, At, B0); PG8_MMA(0, 1, At, B1); PG8_BAR; PG8_SCHED;
            PG8_LDA(At, 0, 1); PG8_STAGE(PG8_SB(0, 0), b2, voffB); PG8_STAGE(PG8_SB(0, 1), b2 + hstep, voffB); PG8_STAGE(PG8_SA(0, 0), a2, voffA);
            PG8_WAIT_V(8); PG8_WAIT_L(0); PG8_BAR; PG8_MMA(1, 0, At, B0); PG8_MMA(1, 1, At, B1); PG8_BAR; PG8_SCHED;
            PG8_LDB(B0, 1, 0); PG8_LDB(B1, 1, 1); PG8_SCHED; PG8_LDA(At, 1, 0); PG8_STAGE(PG8_SA(0, 1), a2 + hstep, voffA);
            PG8_WAIT_V(8); PG8_WAIT_L(0); PG8_BAR; PG8_MMA(0, 0, At, B0); PG8_MMA(0, 1, At, B1); PG8_BAR; PG8_SCHED;
            PG8_LDA(At, 1, 1); PG8_STAGE(PG8_SB(1, 0), b3, voffB); PG8_STAGE(PG8_SB(1, 1), b3 + hstep, voffB); PG8_STAGE(PG8_SA(1, 0), a3, voffA);
            PG8_WAIT_V(8); PG8_WAIT_L(0); PG8_BAR; PG8_MMA(1, 0, At, B0); PG8_MMA(1, 1, At, B1); PG8_BAR; PG8_SCHED;
        }
        if (wr == 0) PG8_BAR;
        E(acc, cur, wr, wc, fr, fq, rsv);
        if (!has_next) break;
        E.load_rs(nxt, wr, fr, rsv);
#pragma unroll
        for (int a = 0; a < 2; ++a)
#pragma unroll
            for (int b = 0; b < 2; ++b)
#pragma unroll
                for (int m = 0; m < 4; ++m)
#pragma unroll
                    for (int n = 0; n < 2; ++n) acc[a][b][m][n] = (f32x4){0.f, 0.f, 0.f, 0.f};
        cur = nxt; cA = nA; cB = nB; ++ui;
        if (wr == 1) PG8_BAR;
    }
    PG8_WAIT_V(0);
    PG8_BAR;
#undef PG8_SA
#undef PG8_SB
#undef PG8_STAGE
#undef PG8_LDA
#undef PG8_LDB
#undef PG8_MMA
#undef PG8_WAIT_V
#undef PG8_WAIT_L
#undef PG8_BAR
#undef PG8_SCHED
}
}

struct Params {
    const float* x; const float* norm_g; const float* even_w_in; const float* conv_w; const float* rel_bias; const float* even_w_out;
    const float* odd_w_in; const float* hgrn_lb; const float* hgrn_ng; const float* wa2; const float* ba; const float* gla_ng; const float* odd_w_out;
    const float* w1; const float* w2; float* out; unsigned char* ws; int ph_lo, ph_hi;
};

__device__ __forceinline__ void cvt_seg(const float* __restrict__ W, int K, int NS, int c0, int nc, bf16_t* __restrict__ WT, int r0, const float* __restrict__ gf, float* scr, int gw, int NGW, int lane) {
    const int nblk = (nc + 31) >> 5, nitems = (K >> 6) * nblk;
    const int krow = lane >> 3, c4 = (lane & 7) * 4;
    for (int it = gw; it < nitems; it += NGW) {
        const int kb = it / nblk, nb = it - kb * nblk, k0 = kb * 64, n0 = nb * 32;
        const bool ok = (n0 + c4) < nc;
        const float* src = W + (size_t)(k0 + krow) * NS + c0 + n0 + c4;
        f32x4 v[8];
#pragma unroll
        for (int i = 0; i < 8; ++i) v[i] = ok ? *(const f32x4*)(src + (size_t)(8 * i) * NS) : (f32x4){0.f, 0.f, 0.f, 0.f};
        if (gf) {
#pragma unroll
            for (int i = 0; i < 8; ++i) v[i] *= gf[k0 + 8 * i + krow]; }
#pragma unroll
        for (int i = 0; i < 8; ++i) { float* d = scr + (8 * i + krow) * 33 + c4; d[0] = v[i][0]; d[1] = v[i][1]; d[2] = v[i][2]; d[3] = v[i][3]; }
        LDS_WAIT();
        const int c = lane & 7;
#pragma unroll
        for (int j = 0; j < 4; ++j) { const int n = (lane >> 3) + 8 * j; const float* s = scr + (8 * c) * 33 + n;
            u32x4 o; o.x = pk2(s[0], s[33]); o.y = pk2(s[66], s[99]); o.z = pk2(s[132], s[165]); o.w = pk2(s[198], s[231]);
            if (n0 + n < nc) *(u32x4*)(WT + (size_t)(r0 + n0 + n) * K + k0 + 8 * c) = o; }
        LDS_WAIT();
    }
}

template <int MODE>
__device__ __forceinline__ void rowwise(const float* __restrict__ xin, const bf16_t* __restrict__ ysrc, const float* __restrict__ g1,
                                        bf16_t* hb, float* __restrict__ rsout, float* __restrict__ out, int gw, int NGW, int lane) {
    for (int row0 = gw; row0 < NTOK; row0 += 2 * NGW) {
        f32x4 h[2][4][2]; u32x4 yw[2][4], hw[2][4];
#pragma unroll
        for (int rr = 0; rr < 2; ++rr) { const size_t rb = (size_t)(row0 + rr * NGW) * DM;
#pragma unroll
            for (int j = 0; j < 4; ++j) { const int col = 512 * j + 8 * lane;
                if (MODE == 0) { h[rr][j][0] = *(const f32x4*)(xin + rb + col); h[rr][j][1] = *(const f32x4*)(xin + rb + col + 4); }
                else { hw[rr][j] = *(const u32x4*)(hb + rb + col); yw[rr][j] = *(const u32x4*)(ysrc + rb + col); } } }
#pragma unroll
        for (int rr = 0; rr < 2; ++rr) {
            const int row = row0 + rr * NGW; const size_t rb = (size_t)row * DM;
            if (MODE != 0) {
                float y[4][8]; float ss = 0.f;
#pragma unroll
                for (int j = 0; j < 4; ++j) {
#pragma unroll
                    for (int e = 0; e < 4; ++e) { y[j][2 * e] = __uint_as_float(yw[rr][j][e] << 16); y[j][2 * e + 1] = __uint_as_float(yw[rr][j][e] & 0xffff0000u);
                        h[rr][j][e >> 1][(2 * e) & 3] = __uint_as_float(hw[rr][j][e] << 16); h[rr][j][e >> 1][(2 * e + 1) & 3] = __uint_as_float(hw[rr][j][e] & 0xffff0000u); }
#pragma unroll
                    for (int e = 0; e < 8; ++e) ss += y[j][e] * y[j][e]; }
                const float rs = rsqrtf(wave_sum(ss) * (1.f / DM) + EPS);
#pragma unroll
                for (int j = 0; j < 4; ++j) { const int col = 512 * j + 8 * lane; const f32x4 ga = *(const f32x4*)(g1 + col), gb = *(const f32x4*)(g1 + col + 4);
#pragma unroll
                    for (int e = 0; e < 4; ++e) { h[rr][j][0][e] += y[j][e] * rs * ga[e]; h[rr][j][1][e] += y[j][4 + e] * rs * gb[e]; }
                    if (MODE == 2) { *(f32x4*)(out + rb + col) = h[rr][j][0]; *(f32x4*)(out + rb + col + 4) = h[rr][j][1]; } }
            }
            if (MODE != 2) {
                float ss = 0.f;
#pragma unroll
                for (int j = 0; j < 4; ++j)
#pragma unroll
                    for (int e = 0; e < 4; ++e) ss += h[rr][j][0][e] * h[rr][j][0][e] + h[rr][j][1][e] * h[rr][j][1][e];
                const float sst = wave_sum(ss);
                if (lane == 0) rsout[row] = sst;
#pragma unroll
                for (int j = 0; j < 4; ++j) { const int col = 512 * j + 8 * lane;
                    u32x4 o; o.x = pk2(h[rr][j][0][0], h[rr][j][0][1]); o.y = pk2(h[rr][j][0][2], h[rr][j][0][3]);
                    o.z = pk2(h[rr][j][1][0], h[rr][j][1][1]); o.w = pk2(h[rr][j][1][2], h[rr][j][1][3]);
                    *(u32x4*)(hb + rb + col) = o; }
            }
        }
    }
}

__device__ __forceinline__ void conv_phase(const bf16_t* __restrict__ P, const float* __restrict__ cw, bf16_t* __restrict__ ycat) {
    const int nthr = gridDim.x * 512;
#pragma unroll 2
    for (int it = blockIdx.x * 512 + threadIdx.x; it < NTOK * 128; it += nthr) {
        const int t = it >> 7, c0 = (it & 127) * 8, tp = t & (SEQ - 1);
        const bf16_t* row = P + (size_t)t * LDE + c0;
        const u32x4 bg = *(const u32x4*)(row), c2 = *(const u32x4*)(row + 1024), h2 = *(const u32x4*)(row + 2048);
        u32x4 c1 = (u32x4){0, 0, 0, 0}, h1 = c1, cz = c1, hz = c1;
        if (tp >= 1) { c1 = *(const u32x4*)(row - LDE + 1024); h1 = *(const u32x4*)(row - LDE + 2048); }
        if (tp >= 2) { cz = *(const u32x4*)(row - 2 * LDE + 1024); hz = *(const u32x4*)(row - 2 * LDE + 2048); }
        float o[8];
#pragma unroll
        for (int e = 0; e < 8; ++e) {
            const int sh = (e & 1) ? 0 : 16; const int w = e >> 1;
            auto get = [&](const u32x4& v) { return __uint_as_float((v[w] << sh) & 0xffff0000u); };
            const float u2 = get(c2) * get(h2), u1 = get(c1) * get(h1), u0 = get(cz) * get(hz);
            const float y = cw[c0 + e] * u0 + cw[1024 + c0 + e] * u1 + cw[2048 + c0 + e] * u2;
            o[e] = get(bg) * y;
        }
        u32x4 w; w.x = pk2(o[0], o[1]); w.y = pk2(o[2], o[3]); w.z = pk2(o[4], o[5]); w.w = pk2(o[6], o[7]);
        *(u32x4*)(ycat + (size_t)t * DM + c0) = w;
    }
}

__device__ __forceinline__ void attn_phase(unsigned char* smem, const bf16_t* __restrict__ P, const bf16_t* __restrict__ VT, const float* __restrict__ relb, bf16_t* __restrict__ ycat) {
    const int tid = threadIdx.x, lane = tid & 63, wave = tid >> 6, half = wave >> 2, w4 = wave & 3, ltid = tid & 255, r = lane & 15, q8 = lane >> 4;
    unsigned char* base = smem + half * 47616;
    bf16_t* kS = (bf16_t*)base;
    bf16_t* vS = (bf16_t*)(base + 17408);
    bf16_t* pS = (bf16_t*)(base + 35840);
    float* bS = (float*)(base + 45056);
    const float scale = 0.08838834764831845f * 1.4426950408889634f;
    for (int pair = blockIdx.x; pair < 1024; pair += gridDim.x) {
        const int hp = pair & 3, n = (pair >> 2) & 63, b = pair >> 8, head = hp * 2 + half;
        const int tok0 = b * SEQ + n * 64;
        __syncthreads();
        for (int i = ltid; i < 640; i += 256) bS[i] = relb[head * 320 + (i < 319 ? i : 319)] * 1.4426950408889634f;
        bf16x8 qf[4];
        { const bf16_t* qp = P + (size_t)(tok0 + 16 * w4 + r) * LDE + 3072 + head * 128 + 8 * q8;
#pragma unroll
          for (int kk = 0; kk < 4; ++kk) qf[kk] = *(const bf16x8*)(qp + 32 * kk); }
        float m[4], l[4]; f32x4 o[8];
#pragma unroll
        for (int j = 0; j < 4; ++j) { m[j] = -1e30f; l[j] = 0.f; }
#pragma unroll
        for (int i = 0; i < 8; ++i) o[i] = (f32x4){0.f, 0.f, 0.f, 0.f};
        const int js0 = (n < 8 ? 8 - n : 0);
        u32x4 kreg[4], vreg[4];
        { const int ktok0 = tok0 + (js0 - 8) * 64;
#pragma unroll
          for (int i = 0; i < 4; ++i) { const int ch = ltid + 256 * i;
              kreg[i] = *(const u32x4*)(P + (size_t)(ktok0 + (ch >> 4)) * LDE + 4096 + head * 128 + (ch & 15) * 8);
              vreg[i] = *(const u32x4*)(VT + (size_t)(head * 128 + (ch >> 3)) * NTOK + ktok0 + (ch & 7) * 8); } }
        for (int js = js0; js <= 8; ++js) {
            __syncthreads();
#pragma unroll
            for (int i = 0; i < 4; ++i) { const int ch = ltid + 256 * i;
                *(u32x4*)(kS + (ch >> 4) * 136 + (ch & 15) * 8) = kreg[i];
                *(u32x4*)(vS + (ch >> 3) * 72 + (ch & 7) * 8) = vreg[i]; }
            __syncthreads();
            if (js < 8) { const int ktok0 = tok0 + (js + 1 - 8) * 64;
#pragma unroll
                for (int i = 0; i < 4; ++i) { const int ch = ltid + 256 * i;
                    kreg[i] = *(const u32x4*)(P + (size_t)(ktok0 + (ch >> 4)) * LDE + 4096 + head * 128 + (ch & 15) * 8);
                    vreg[i] = *(const u32x4*)(VT + (size_t)(head * 128 + (ch >> 3)) * NTOK + ktok0 + (ch & 7) * 8); } }
            f32x4 s[4];
#pragma unroll
            for (int nt = 0; nt < 4; ++nt) { s[nt] = (f32x4){0.f, 0.f, 0.f, 0.f};
#pragma unroll
                for (int kk = 0; kk < 4; ++kk) { const bf16x8 kf = *(const bf16x8*)(kS + (16 * nt + r) * 136 + 32 * kk + 8 * q8);
                    s[nt] = __builtin_amdgcn_mfma_f32_16x16x32_bf16(qf[kk], kf, s[nt], 0, 0, 0); } }
            float alpha[4];
            const float* bT = bS + (16 * w4 + 4 * q8 - r + 63 + (8 - js) * 64);
#pragma unroll
            for (int j = 0; j < 4; ++j) {
                float mx = -1e30f;
#pragma unroll
                for (int nt = 0; nt < 4; ++nt) { const float v = s[nt][j] * scale + bT[j - 16 * nt]; s[nt][j] = v; mx = fmaxf(mx, v); }
                mx = row16_max(mx);
                const float mn = fmaxf(m[j], mx); alpha[j] = __builtin_amdgcn_exp2f(m[j] - mn); m[j] = mn;
                float ps = 0.f;
#pragma unroll
                for (int nt = 0; nt < 4; ++nt) { const float pp = __builtin_amdgcn_exp2f(s[nt][j] - mn); ps += pp; pS[(16 * w4 + 4 * q8 + j) * 72 + 16 * nt + r] = f2bf(pp); }
                l[j] = l[j] * alpha[j] + ps;
            }
#pragma unroll
            for (int i = 0; i < 8; ++i)
#pragma unroll
                for (int j = 0; j < 4; ++j) o[i][j] *= alpha[j];
            LDS_WAIT();
#pragma unroll
            for (int kk = 0; kk < 2; ++kk) { const bf16x8 pf = *(const bf16x8*)(pS + (16 * w4 + r) * 72 + 32 * kk + 8 * q8);
#pragma unroll
                for (int i = 0; i < 8; ++i) { const bf16x8 vf = *(const bf16x8*)(vS + (16 * i + r) * 72 + 32 * kk + 8 * q8);
                    o[i] = __builtin_amdgcn_mfma_f32_16x16x32_bf16(pf, vf, o[i], 0, 0, 0); } }
        }
#pragma unroll
        for (int j = 0; j < 4; ++j) { float lt = l[j];
#pragma unroll
            for (int ofs = 1; ofs < 16; ofs <<= 1) lt += __shfl_xor(lt, ofs);
            const float inv = frcp(lt);
            bf16_t* op = ycat + (size_t)(tok0 + 16 * w4 + 4 * q8 + j) * DM + 1024 + head * 128 + r;
#pragma unroll
            for (int i = 0; i < 8; ++i) op[16 * i] = f2bf(o[i][j] * inv); }
    }
}

template <int KIND, bool WANT_Q>
__device__ __forceinline__ void decay_qk(const Params& p, const bf16_t* __restrict__ P, int tok0, int hd, int d, int tq, float (&bl)[16], float (&kv)[16], float (&qv)[16]) {
    const int col = hd * 128 + d;
    const bf16_t* rp = P + (size_t)(tok0 + 16 * tq) * LDO;
    if (KIND == 0) {
        const float lb = frcp(1.f + __expf(p.hgrn_lb[col] - p.hgrn_lb[1024 + col]));
        float run = 0.f;
#pragma unroll
        for (int jj = 0; jj < 16; ++jj) {
            const float fr = bf2f(rp[(size_t)jj * LDO + 1024 + col]);
            const float f = lb + (1.f - lb) * sigmoidf_(fr);
            run += __logf(f); bl[jj] = run; kv[jj] = 1.f - f;
            if (WANT_Q) { const float qr = bf2f(rp[(size_t)jj * LDO + col]); qv[jj] = qr * sigmoidf_(qr); }
        }
    } else {
        float w[16];
#pragma unroll
        for (int rr = 0; rr < 16; ++rr) w[rr] = p.wa2[rr * 512 + col];
        const float bias = p.ba[col];
        float run = 0.f;
#pragma unroll
        for (int jj = 0; jj < 16; ++jj) {
            const u32x4 g0 = *(const u32x4*)(rp + (size_t)jj * LDO + 5120), g1 = *(const u32x4*)(rp + (size_t)jj * LDO + 5128);
            float xx = bias;
#pragma unroll
            for (int e = 0; e < 4; ++e) {
                xx += __uint_as_float(g0[e] << 16) * w[2 * e] + __uint_as_float(g0[e] & 0xffff0000u) * w[2 * e + 1];
                xx += __uint_as_float(g1[e] << 16) * w[8 + 2 * e] + __uint_as_float(g1[e] & 0xffff0000u) * w[8 + 2 * e + 1];
            }
            const float ls = fminf(xx, 0.f) - __logf(1.f + __expf(-fabsf(xx)));
            run += ls * (1.f / 16.f); bl[jj] = run;
            kv[jj] = bf2f(rp[(size_t)jj * LDO + 3584 + col]);
            if (WANT_Q) qv[jj] = bf2f(rp[(size_t)jj * LDO + 3072 + col]) * 0.08838834764831845f;
        }
    }
}

template <int KIND>
__device__ __forceinline__ void passA_item(const Params& p, unsigned char* smem_base, const bf16_t* __restrict__ P, const bf16_t* __restrict__ VT, bf16_t* __restrict__ ST, float* __restrict__ DEC, int idx, int par) {
    unsigned char* smem = smem_base + par * 57344;
    constexpr int DV = KIND ? 256 : 128;
    const int tid = threadIdx.x, lane = tid & 63, wave = tid >> 6, r = lane & 15, q8 = lane >> 4, d = tid & 127, tq = tid >> 7;
    const int c = idx & 63, bh = idx >> 6, hd = KIND ? (bh & 3) : (bh & 7), b = KIND ? (bh >> 2) : (bh >> 3);
    const int tok0 = b * SEQ + c * 64;
    bf16_t* kT = (bf16_t*)smem;
    bf16_t* vS = (bf16_t*)(smem + 18432);
    float* tot = (float*)(smem + 18432 + 36864);
    float bl[16], kv[16], qv[16];
    u32x4 vr[DV / 64];
    { const bf16_t* vsrc = VT + (size_t)((KIND ? 1024 + hd * 256 : hd * 128)) * NTOK + tok0;
#pragma unroll
      for (int i = 0; i < DV / 64; ++i) { const int ch = tid + 512 * i, row = ch >> 3, c8 = ch & 7; vr[i] = *(const u32x4*)(vsrc + (size_t)row * NTOK + c8 * 8); } }
    decay_qk<KIND, false>(p, P, tok0, hd, d, tq, bl, kv, qv);
    tot[tq * 128 + d] = bl[15];
#pragma unroll
    for (int i = 0; i < DV / 64; ++i) { const int ch = tid + 512 * i, row = ch >> 3, c8 = ch & 7; *(u32x4*)(vS + row * 72 + c8 * 8) = vr[i]; }
    __syncthreads();
    const float t0 = tot[d], t1 = tot[128 + d], t2 = tot[256 + d], t3 = tot[384 + d];
    const float r4 = t0 + t1 + t2 + t3;
    const float rpre = (tq > 0 ? t0 : 0.f) + (tq > 1 ? t1 : 0.f) + (tq > 2 ? t2 : 0.f);
    {
        float kt[16];
#pragma unroll
        for (int jj = 0; jj < 16; ++jj) kt[jj] = kv[jj] * __expf(r4 - rpre - bl[jj]);
        u32x4 w0, w1;
        w0.x = pk2(kt[0], kt[1]); w0.y = pk2(kt[2], kt[3]); w0.z = pk2(kt[4], kt[5]); w0.w = pk2(kt[6], kt[7]);
        w1.x = pk2(kt[8], kt[9]); w1.y = pk2(kt[10], kt[11]); w1.z = pk2(kt[12], kt[13]); w1.w = pk2(kt[14], kt[15]);
        *(u32x4*)(kT + d * 72 + 16 * tq) = w0; *(u32x4*)(kT + d * 72 + 16 * tq + 8) = w1;
    }
    const int gitem = (KIND ? 2048 : 0) + idx;
    if (tq == 0) DEC[(size_t)gitem * 128 + d] = __expf(r4);
    __syncthreads();
    const int d0 = 16 * wave;
    bf16x8 af[2];
#pragma unroll
    for (int kk = 0; kk < 2; ++kk) af[kk] = *(const bf16x8*)(kT + (d0 + r) * 72 + 32 * kk + 8 * q8);
    bf16_t* stb = ST + (KIND ? (size_t)33554432 : 0) + (size_t)idx * (DV * 128);
#pragma unroll
    for (int nt = 0; nt < DV / 16; ++nt) {
        f32x4 acc = (f32x4){0.f, 0.f, 0.f, 0.f};
#pragma unroll
        for (int kk = 0; kk < 2; ++kk) { const bf16x8 bfr = *(const bf16x8*)(vS + (16 * nt + r) * 72 + 32 * kk + 8 * q8);
            acc = __builtin_amdgcn_mfma_f32_16x16x32_bf16(af[kk], bfr, acc, 0, 0, 0); }
        u32x2 w; w.x = pk2(acc[0], acc[1]); w.y = pk2(acc[2], acc[3]);
        *(u32x2*)(stb + (size_t)(16 * nt + r) * 128 + d0 + 4 * q8) = w;
    }
}

__device__ __forceinline__ void scan_phase(bf16_t* __restrict__ ST, const float* __restrict__ DEC) {
    const int nthr = gridDim.x * 512;
    for (int gid = blockIdx.x * 512 + threadIdx.x; gid < 131072; gid += nthr) {
        const int kind = gid >> 16, v = gid & 65535;
        const int vper = kind ? 4096 : 2048, bh = v / vper, vi = v - bh * vper, d0 = (vi * 8) & 127;
        const size_t csz = kind ? 32768 : 16384;
        bf16_t* sp = ST + (kind ? (size_t)33554432 : 0) + (size_t)bh * 64 * csz + (size_t)vi * 8;
        const float* dp = DEC + (size_t)((kind ? 2048 : 0) + bh * 64) * 128 + d0;
        float S[8];
#pragma unroll
        for (int e = 0; e < 8; ++e) S[e] = 0.f;
#pragma unroll 8
        for (int c = 0; c < 64; ++c) {
            const u32x4 u = *(const u32x4*)(sp + (size_t)c * csz);
            const f32x4 da = *(const f32x4*)(dp + c * 128), db = *(const f32x4*)(dp + c * 128 + 4);
            u32x4 w; w.x = pk2(S[0], S[1]); w.y = pk2(S[2], S[3]); w.z = pk2(S[4], S[5]); w.w = pk2(S[6], S[7]);
            *(u32x4*)(sp + (size_t)c * csz) = w;
#pragma unroll
            for (int e = 0; e < 4; ++e) {
                S[2 * e] = S[2 * e] * (e < 2 ? da[2 * e] : db[2 * e - 4]) + __uint_as_float(u[e] << 16);
                S[2 * e + 1] = S[2 * e + 1] * (e < 2 ? da[2 * e + 1] : db[2 * e - 3]) + __uint_as_float(u[e] & 0xffff0000u);
            }
        }
    }
}

template <int KIND>
__device__ __forceinline__ void passC_item(const Params& p, unsigned char* smem, const bf16_t* __restrict__ P, const bf16_t* __restrict__ VT, const bf16_t* __restrict__ ST, bf16_t* __restrict__ ycat, int idx) {
    constexpr int DV = KIND ? 256 : 128;
    const int tid = threadIdx.x, lane = tid & 63, wave = tid >> 6, r = lane & 15, q8 = lane >> 4, d = tid & 127, tq = tid >> 7;
    const int c = idx & 63, bh = idx >> 6, hd = KIND ? (bh & 3) : (bh & 7), b = KIND ? (bh >> 2) : (bh >> 3);
    const int tok0 = b * SEQ + c * 64;
    bf16_t* qs = (bf16_t*)smem;
    bf16_t* qh = (bf16_t*)(smem + 17408);
    bf16_t* ks = (bf16_t*)(smem + 34816);
    bf16_t* vS = (bf16_t*)(smem + 78336);
    bf16_t* pS = (bf16_t*)(smem + 115200);
    float* tot = (float*)(smem + 124416);
    float* ssq = (float*)(smem + 126464);
    float bl[16], kv[16], qv[16];
    u32x4 vr[DV / 64];
    { const bf16_t* vsrc = VT + (size_t)((KIND ? 1024 + hd * 256 : hd * 128)) * NTOK + tok0;
#pragma unroll
      for (int i = 0; i < DV / 64; ++i) { const int ch = tid + 512 * i, row = ch >> 3, c8 = ch & 7; vr[i] = *(const u32x4*)(vsrc + (size_t)row * NTOK + c8 * 8); } }
    decay_qk<KIND, true>(p, P, tok0, hd, d, tq, bl, kv, qv);
    tot[tq * 128 + d] = bl[15];
#pragma unroll
    for (int i = 0; i < DV / 64; ++i) { const int ch = tid + 512 * i, row = ch >> 3, c8 = ch & 7; *(u32x4*)(vS + row * 72 + c8 * 8) = vr[i]; }
    for (int i = tid; i < 64 * 72 / 8; i += 512) *(u32x4*)(pS + i * 8) = (u32x4){0, 0, 0, 0};
    __syncthreads();
    constexpr int NT = DV / 32;
    constexpr int NPRE = 4;
    const int oi = wave & 3, oeh = wave >> 2;
    const bf16_t* stb = ST + (KIND ? (size_t)33554432 : 0) + (size_t)idx * (DV * 128);
    const int gcol = KIND ? 4096 + hd * 256 : 2048 + hd * 128;
    bf16x8 bst[NPRE][4];
#pragma unroll
    for (int nt = 0; nt < NPRE; ++nt)
#pragma unroll
        for (int kk = 0; kk < 4; ++kk) bst[nt][kk] = *(const bf16x8*)(stb + (size_t)(oeh * (DV / 2) + 16 * nt + r) * 128 + 32 * kk + 8 * q8);
    bf16_t graw[4][NT];
#pragma unroll
    for (int j = 0; j < 4; ++j)
#pragma unroll
        for (int nt = 0; nt < NT; ++nt) graw[j][nt] = P[(size_t)(tok0 + 16 * oi + 4 * q8 + j) * LDO + gcol + oeh * (DV / 2) + 16 * nt + r];
    {
        const float t0 = tot[d], t1 = tot[128 + d], t2 = tot[256 + d];
        const float rpre = (tq > 0 ? t0 : 0.f) + (tq > 1 ? t1 : 0.f) + (tq > 2 ? t2 : 0.f);
        const float Ttq = bl[15], rn = rpre + Ttq;
        const float einv = __expf(fminf(-Ttq, 80.f));
        const float f1 = (tq == 1) ? einv : __expf(fminf(t0 - rn, 0.f));
        const float f2 = (tq == 2) ? einv : __expf(fminf(t0 + t1 - rn, 0.f));
        const float f3 = (tq == 3) ? einv : __expf(fminf(t0 + t1 + t2 - rn, 0.f));
        const float erp = __expf(rpre);
#pragma unroll
        for (int jj = 0; jj < 16; ++jj) {
            const int t = 16 * tq + jj;
            const float ql = qv[jj] * __expf(bl[jj]);
            qs[t * 136 + d] = f2bf(ql);
            qh[t * 136 + d] = f2bf(ql * erp);
            const float kb = kv[jj] * __expf(Ttq - bl[jj]);
            if (tq == 0) ks[(0 + t) * 136 + d] = f2bf(kb * einv);
            if (tq <= 1) ks[(16 + t) * 136 + d] = f2bf(kb * f1);
            if (tq <= 2) ks[(48 + t) * 136 + d] = f2bf(kb * f2);
            ks[(96 + t) * 136 + d] = f2bf(kb * f3);
        }
    }
    __syncthreads();
    {
        const int i = wave >> 1, off = 8 * i * (i + 1);
        bf16x8 af[4];
#pragma unroll
        for (int kk = 0; kk < 4; ++kk) af[kk] = *(const bf16x8*)(qs + (16 * i + r) * 136 + 32 * kk + 8 * q8);
        for (int jt = (wave & 1); jt <= i; jt += 2) {
            f32x4 acc = (f32x4){0.f, 0.f, 0.f, 0.f};
#pragma unroll
            for (int kk = 0; kk < 4; ++kk) { const bf16x8 bfr = *(const bf16x8*)(ks + (off + 16 * jt + r) * 136 + 32 * kk + 8 * q8);
                acc = __builtin_amdgcn_mfma_f32_16x16x32_bf16(af[kk], bfr, acc, 0, 0, 0); }
#pragma unroll
            for (int j = 0; j < 4; ++j) { float v = acc[j]; if (jt == i && r > 4 * q8 + j) v = 0.f;
                pS[(16 * i + 4 * q8 + j) * 72 + 16 * jt + r] = f2bf(v); }
        }
    }
    __syncthreads();
    {
        const int i = oi, eh = oeh;
        bf16x8 ap[2], aq[4];
#pragma unroll
        for (int kk = 0; kk < 2; ++kk) ap[kk] = *(const bf16x8*)(pS + (16 * i + r) * 72 + 32 * kk + 8 * q8);
#pragma unroll
        for (int kk = 0; kk < 4; ++kk) aq[kk] = *(const bf16x8*)(qh + (16 * i + r) * 136 + 32 * kk + 8 * q8);
        f32x4 o[NT];
        float ss[4] = {0.f, 0.f, 0.f, 0.f};
#pragma unroll
        for (int nt = 0; nt < NT; ++nt) {
            const int e0 = eh * (DV / 2) + 16 * nt;
            f32x4 acc = (f32x4){0.f, 0.f, 0.f, 0.f};
#pragma unroll
            for (int kk = 0; kk < 2; ++kk) { const bf16x8 bfr = *(const bf16x8*)(vS + (e0 + r) * 72 + 32 * kk + 8 * q8);
                acc = __builtin_amdgcn_mfma_f32_16x16x32_bf16(ap[kk], bfr, acc, 0, 0, 0); }
#pragma unroll
            for (int kk = 0; kk < 4; ++kk) { bf16x8 bfr;
                if (nt < NPRE) bfr = bst[nt < NPRE ? nt : 0][kk]; else bfr = *(const bf16x8*)(stb + (size_t)(e0 + r) * 128 + 32 * kk + 8 * q8);
                acc = __builtin_amdgcn_mfma_f32_16x16x32_bf16(aq[kk], bfr, acc, 0, 0, 0); }
            o[nt] = acc;
#pragma unroll
            for (int j = 0; j < 4; ++j) ss[j] += acc[j] * acc[j];
        }
#pragma unroll
        for (int j = 0; j < 4; ++j) {
#pragma unroll
            for (int ofs = 1; ofs < 16; ofs <<= 1) ss[j] += __shfl_xor(ss[j], ofs);
            if (r == 0) ssq[eh * 64 + 16 * i + 4 * q8 + j] = ss[j];
        }
        __syncthreads();
        const float* ng = (KIND ? p.gla_ng + hd * 256 : p.hgrn_ng + hd * 128);
        const int ycol = KIND ? 1024 + hd * 256 : hd * 128;
#pragma unroll
        for (int j = 0; j < 4; ++j) {
            const int t = 16 * i + 4 * q8 + j;
            const float rstd = __builtin_amdgcn_rsqf((ssq[t] + ssq[64 + t]) * (1.f / DV) + EPS);
            bf16_t* yp = ycat + (size_t)(tok0 + t) * DM + ycol;
#pragma unroll
            for (int nt = 0; nt < NT; ++nt) { const int e = eh * (DV / 2) + 16 * nt + r;
                const float g = bf2f(graw[j][nt]);
                yp[e] = f2bf(o[nt][j] * rstd * ng[e] * (g * sigmoidf_(g))); }
        }
    }
}

#define XB_TMO      128
#define XB_XCNT(j)  (256  + 64 * (j))
#define XB_XSUB(j)  (1280 + 64 * (j))
#define XB_XGEN(j)  (2304 + 64 * (j))
#define XB_TOP      3328
#define XB_TOPGEN   3392
#define XCD_BAR_WORDS 3456
#define XB_SPIN_CAP (1u << 18)
__device__ __forceinline__ unsigned xb_ld(unsigned* p)              { return __hip_atomic_load(p, __ATOMIC_RELAXED, __HIP_MEMORY_SCOPE_AGENT); }
__device__ __forceinline__ unsigned xb_add(unsigned* p, unsigned v) { return __hip_atomic_fetch_add(p, v, __ATOMIC_RELAXED, __HIP_MEMORY_SCOPE_AGENT); }
__device__ __forceinline__ unsigned xb_xcc_id() { return (unsigned)__builtin_amdgcn_s_getreg((3 << 11) | 20) & 0xFu; }
#define XB_SPIN(cond, bar) do { unsigned _sp = 0; while (cond) { __builtin_amdgcn_s_sleep(1); \
    if ((++_sp & 255u) == 0u) { if (xb_ld(&(bar)[XB_TMO])) break; if (_sp > XB_SPIN_CAP) { atomicAdd(&(bar)[XB_TMO], 1u); break; } } } } while (0)
struct XcdBarrier { unsigned* bar; unsigned x; volatile LAS unsigned* st; };
__device__ __forceinline__ XcdBarrier xcd_barrier_post(unsigned* bar, volatile LAS unsigned* st) {
    XcdBarrier b; b.bar = bar; b.x = xb_xcc_id(); b.st = st;
    if (threadIdx.x == 0) (void)xb_add(&bar[XB_XCNT(b.x)], 1u);
    return b;
}
__device__ __forceinline__ void xcd_barrier_complete(unsigned* bar, unsigned x, unsigned& nloc, unsigned& nx) {
    const unsigned G = gridDim.x * gridDim.y * gridDim.z;
    unsigned sum, cnt, mine, sp = 0u;
    for (;;) {
        sum = 0u; cnt = 0u; mine = 0u;
#pragma unroll
        for (unsigned j = 0; j < 16; ++j) { const unsigned c = xb_ld(&bar[XB_XCNT(j)]); sum += c; cnt += (c > 0u) ? 1u : 0u; mine = (j == x) ? c : mine; }
        if (sum == G) break;
        __builtin_amdgcn_s_sleep(1);
        if ((++sp & 255u) == 0u) { if (xb_ld(&bar[XB_TMO])) break; if (sp > XB_SPIN_CAP) { atomicAdd(&bar[XB_TMO], 1u); break; } }
    }
    nloc = mine > 0u ? mine : 1u; nx = cnt > 0u ? cnt : 1u;
}
__device__ __forceinline__ void xcd_barrier(const XcdBarrier& b) {
    asm volatile("s_waitcnt vmcnt(0)" ::: "memory");
    __syncthreads();
    if (threadIdx.x == 0) {
        unsigned* bar = b.bar;
        __builtin_amdgcn_s_waitcnt(0);
        unsigned nloc = b.st[0], nx = b.st[1];
        if (nloc == 0u) { xcd_barrier_complete(bar, b.x, nloc, nx); b.st[0] = nloc; b.st[1] = nx; }
        const unsigned old = xb_add(&bar[XB_XSUB(b.x)], 1u);
        const unsigned gen = old / nloc;
        if (old + 1u == (gen + 1u) * nloc) {
            __builtin_amdgcn_fence(__ATOMIC_RELEASE, "agent");
            asm volatile("s_waitcnt vmcnt(0)" ::: "memory");
            const unsigned og = xb_add(&bar[XB_TOP], 1u);
            const unsigned tg = og / nx;
            if (og + 1u == (tg + 1u) * nx) xb_add(&bar[XB_TOPGEN], 1u);
            else XB_SPIN(xb_ld(&bar[XB_TOPGEN]) == tg, bar);
            __builtin_amdgcn_fence(__ATOMIC_ACQUIRE, "agent");
            xb_add(&bar[XB_XGEN(b.x)], 1u);
            asm volatile("s_waitcnt vmcnt(0)" ::: "memory");
        } else {
            XB_SPIN(xb_ld(&bar[XB_XGEN(b.x)]) == gen, bar);
            __builtin_amdgcn_fence(__ATOMIC_ACQUIRE, "agent");
            asm volatile("s_waitcnt vmcnt(0)" ::: "memory");
        }
    }
    __syncthreads();
}

__global__ void __launch_bounds__(512, 2) fwd_kernel(Params p) {
    extern __shared__ __attribute__((aligned(16))) unsigned char smem[];
    cg::grid_group grid = cg::this_grid();
    const int tid = threadIdx.x, lane = tid & 63, wave = tid >> 6;
    const int G = gridDim.x, gw = blockIdx.x * 8 + wave, NGW = G * 8;
    unsigned char* ws = p.ws;
    bf16_t* Wout = (bf16_t*)(ws + WS_WOUT); bf16_t* W1t = (bf16_t*)(ws + WS_W1); bf16_t* W2t = (bf16_t*)(ws + WS_W2); bf16_t* Win = (bf16_t*)(ws + WS_WIN);
    bf16_t* U = (bf16_t*)(ws + WS_U); bf16_t* BIG = (bf16_t*)(ws + WS_BIG); bf16_t* YZ = (bf16_t*)(ws + WS_YZ);
    bf16_t* VTE = (bf16_t*)(ws + WS_VT_E); bf16_t* VTO = (bf16_t*)(ws + WS_VT_O); bf16_t* ST = (bf16_t*)(ws + WS_ST); float* DEC = (float*)(ws + WS_DEC);
    float* SS = (float*)(ws + WS_SS); unsigned* PCNT = (unsigned*)(ws + WS_PCNT); bf16_t* YC = (bf16_t*)p.out;
    float* SSH0 = SS; float* SSH1 = SS + NTOK; float* SSH2 = SS + 2 * NTOK; float* SSH3 = SS + 3 * NTOK;
    float* scr = (float*)(smem + wave * 8448);
    LAS unsigned char* lds = (LAS unsigned char*)smem;
    const int lo = p.ph_lo, hi = p.ph_hi;
#define IN(k) (lo <= (k) && (k) < hi)
#define SEAM(k) do { if (IN(k) && IN((k) + 1)) xcd_barrier(xbar); } while (0)
    if (lo < 0) grid.sync();
    volatile LAS unsigned* xst = (volatile LAS unsigned*)(lds + 131072 + 1024);
    if (tid < 4) xst[tid] = 0u;
    __syncthreads();
    XcdBarrier xbar; xbar.bar = (unsigned*)(ws + WS_BAR); xbar.x = 0; xbar.st = xst;
    if (hi - lo > 1) xbar = xcd_barrier_post((unsigned*)(ws + WS_BAR), xst);

    if (IN(0)) {
        cvt_seg(p.even_w_in, DM, 6144, 0, 5120, Win, 0, p.norm_g, scr, gw, NGW, lane);
        cvt_seg(p.even_w_in, DM, 6144, 5120, 1024, Win, 5120, p.norm_g, scr, gw, NGW, lane);
        cvt_seg(p.even_w_out, DM, DM, 0, DM, Wout, 0, nullptr, scr, gw, NGW, lane);
        cvt_seg(p.w1, DM, DFF, 0, DFF, W1t, 0, p.norm_g + 2 * DM, scr, gw, NGW, lane);
        cvt_seg(p.w2, DFF, DM, 0, DM, W2t, 0, nullptr, scr, gw, NGW, lane);
        rowwise<0>(p.x, nullptr, nullptr, U, SSH0, nullptr, gw, NGW, lane);
    }
    SEAM(0);
    if (IN(1)) {
        { pg8::Gemm g{U, Win, NTOK, LDE, DM}; pg8::StaticOrder S; S.init(NTOK, LDE, G, blockIdx.x); pg8::EpiB<0, 1> E{BIG, LDE, SSH0}; pg8::gemm_phase(lds, g, S, E); }
        { pg8::Gemm g{Win + (size_t)5120 * DM, U, 1024, NTOK, DM}; pg8::StaticOrder S; S.init(1024, NTOK, G, blockIdx.x); pg8::EpiB<0, 2> E{VTE, NTOK, SSH0}; pg8::gemm_phase(lds, g, S, E); }
    }
    SEAM(1);
    if (IN(2)) { conv_phase(BIG, p.conv_w, YC); attn_phase(smem, BIG, VTE, p.rel_bias, YC); }
    SEAM(2);
    if (IN(3)) { pg8::Gemm g{YC, Wout, NTOK, DM, DM}; pg8::PanelOrder S{(int)blockIdx.x}; pg8::EpiRes<false> E{U, nullptr, p.norm_g + 1 * DM, SS + 4 * NTOK, SSH1, PCNT}; pg8::gemm_phase(lds, g, S, E); }
    SEAM(3);
    if (IN(5)) { pg8::Gemm g{U, W1t, NTOK, DFF, DM}; pg8::StaticOrder S; S.init(NTOK, DFF, G, blockIdx.x); pg8::EpiB<1, 1> E{BIG, DFF, SSH1}; pg8::gemm_phase(lds, g, S, E); }
    SEAM(5);
    if (IN(6)) { pg8::Gemm g{BIG, W2t, NTOK, DM, DFF}; pg8::PanelOrder S{(int)blockIdx.x}; pg8::EpiRes<false> E{U, nullptr, p.norm_g + 3 * DM, SS + 5 * NTOK, SSH2, PCNT + 64}; pg8::gemm_phase(lds, g, S, E); }
    SEAM(6);
    if (IN(7)) {
        const float* wi = p.odd_w_in;
        cvt_seg(wi, DM, 7184, 0, 2048, Win, 0, p.norm_g + 4 * DM, scr, gw, NGW, lane);
        cvt_seg(wi, DM, 7184, 3072, 2048, Win, 2048, p.norm_g + 4 * DM, scr, gw, NGW, lane);
        cvt_seg(wi, DM, 7184, 6144, 1040, Win, 4096, p.norm_g + 4 * DM, scr, gw, NGW, lane);
        cvt_seg(wi, DM, 7184, 2048, 1024, Win, 5376, p.norm_g + 4 * DM, scr, gw, NGW, lane);
        cvt_seg(wi, DM, 7184, 5120, 1024, Win, 6400, p.norm_g + 4 * DM, scr, gw, NGW, lane);
        cvt_seg(p.odd_w_out, DM, DM, 0, DM, Wout, 0, nullptr, scr, gw, NGW, lane);
        cvt_seg(p.w1 + (size_t)DM * DFF, DM, DFF, 0, DFF, W1t, 0, p.norm_g + 6 * DM, scr, gw, NGW, lane);
        cvt_seg(p.w2 + (size_t)DM * DFF, DFF, DM, 0, DM, W2t, 0, nullptr, scr, gw, NGW, lane);
    }
    SEAM(7);
    if (IN(8)) {
        { pg8::Gemm g{U, Win, NTOK, 5120, DM}; pg8::StaticOrder S; S.init(NTOK, 5120, G, blockIdx.x); pg8::EpiB<0, 1> E{BIG, LDO, SSH2}; pg8::gemm_phase(lds, g, S, E); }
        { pg8::Gemm g{Win + (size_t)5376 * DM, U, 2048, NTOK, DM}; pg8::StaticOrder S; S.init(2048, NTOK, G, blockIdx.x); pg8::EpiB<0, 2> E{VTO, NTOK, SSH2}; pg8::gemm_phase(lds, g, S, E); }
        if (wave < 4) {
            const int r = lane & 15, q8 = lane >> 4, t0 = (blockIdx.x * 4 + wave) * 16;
            if (t0 < NTOK) {
                const bf16_t* ap = U + (size_t)(t0 + r) * DM + 8 * q8;
                const bf16_t* bp = Win + (size_t)(5120 + r) * DM + 8 * q8;
                f32x4 acc = (f32x4){0.f, 0.f, 0.f, 0.f};
#pragma unroll 8
                for (int kk = 0; kk < DM / 32; ++kk) { const bf16x8 a = *(const bf16x8*)(ap + 32 * kk), b = *(const bf16x8*)(bp + 32 * kk);
                    acc = __builtin_amdgcn_mfma_f32_16x16x32_bf16(a, b, acc, 0, 0, 0); }
#pragma unroll
                for (int j = 0; j < 4; ++j) BIG[(size_t)(t0 + 4 * q8 + j) * LDO + 5120 + r] = f2bf(acc[j] * __builtin_amdgcn_rsqf(SSH2[t0 + 4 * q8 + j] * (1.f / DM) + EPS));
            }
        }
    }
    SEAM(8);
    if (IN(9)) {
        int par = 0;
        for (int it = blockIdx.x; it < 2048; it += G) { passA_item<0>(p, smem, BIG, VTO, ST, DEC, it, par); par ^= 1; }
        for (int it = blockIdx.x; it < 1024; it += G) { passA_item<1>(p, smem, BIG, VTO, ST, DEC, it, par); par ^= 1; }
    }
    SEAM(9);
    if (IN(10)) scan_phase(ST, DEC);
    SEAM(10);
    if (IN(11)) {
        for (int it = blockIdx.x; it < 2048; it += G) passC_item<0>(p, smem, BIG, VTO, ST, YC, it);
        for (int it = blockIdx.x; it < 1024; it += G) passC_item<1>(p, smem, BIG, VTO, ST, YC, it);
    }
    SEAM(11);
    if (IN(12)) { pg8::Gemm g{YC, Wout, NTOK, DM, DM}; pg8::PanelOrder S{(int)blockIdx.x}; pg8::EpiRes<false> E{U, nullptr, p.norm_g + 5 * DM, SS + 6 * NTOK, SSH3, PCNT + 128}; pg8::gemm_phase(lds, g, S, E); }
    SEAM(12);
    if (IN(14)) { pg8::Gemm g{U, W1t, NTOK, DFF, DM}; pg8::StaticOrder S; S.init(NTOK, DFF, G, blockIdx.x); pg8::EpiB<1, 1> E{BIG, DFF, SSH3}; pg8::gemm_phase(lds, g, S, E); }
    SEAM(14);
    if (IN(15)) { pg8::Gemm g{BIG, W2t, NTOK, DM, DFF}; pg8::PanelOrder S{(int)blockIdx.x}; pg8::EpiRes<true> E{U, p.out, p.norm_g + 7 * DM, SS + 7 * NTOK, nullptr, PCNT + 192}; pg8::gemm_phase(lds, g, S, E); }
#undef IN
#undef SEAM
}

constexpr int NPHASE = 17;

extern "C" void kernel_launch(void* const* d_in, const int* in_sizes, int n_in, void* d_out, int out_size, void* d_ws, size_t ws_size, hipStream_t stream) {
    static int grid = 0;
    if (grid == 0) {
        if (ws_size < WS_END) fprintf(stderr, "kernel_launch: workspace too small: %zu < %zu\n", ws_size, (size_t)WS_END);
        int dev = 0, cus = 0, per_cu = 0;
        hipGetDevice(&dev);
        hipDeviceGetAttribute(&cus, hipDeviceAttributeMultiprocessorCount, dev);
        if (hipFuncSetAttribute((const void*)fwd_kernel, hipFuncAttributeMaxDynamicSharedMemorySize, LDS_BYTES) != hipSuccess) fprintf(stderr, "kernel_launch: hipFuncSetAttribute failed\n");
        if (hipOccupancyMaxActiveBlocksPerMultiprocessor(&per_cu, (const void*)fwd_kernel, 512, LDS_BYTES) != hipSuccess || per_cu < 1) { per_cu = 1; (void)hipGetLastError(); }
        grid = cus * (per_cu > 1 ? 1 : per_cu);
        if (grid <= 0) grid = 256;
    }
    Params p{};
    p.x = (const float*)d_in[0]; p.norm_g = (const float*)d_in[1]; p.even_w_in = (const float*)d_in[2]; p.conv_w = (const float*)d_in[3];
    p.rel_bias = (const float*)d_in[4]; p.even_w_out = (const float*)d_in[5]; p.odd_w_in = (const float*)d_in[6]; p.hgrn_lb = (const float*)d_in[7];
    p.hgrn_ng = (const float*)d_in[8]; p.wa2 = (const float*)d_in[9]; p.ba = (const float*)d_in[10]; p.gla_ng = (const float*)d_in[11];
    p.odd_w_out = (const float*)d_in[12]; p.w1 = (const float*)d_in[13]; p.w2 = (const float*)d_in[14];
    p.out = (float*)d_out; p.ws = (unsigned char*)d_ws;
#if ONE_LAUNCH
    (void)hipMemsetAsync((unsigned char*)d_ws + WS_BAR, 0, WS_ZERO_BYTES, stream);
    p.ph_lo = 0; p.ph_hi = NPHASE;
    void* args[] = {&p};
    hipError_t e = hipLaunchCooperativeKernel((const void*)fwd_kernel, dim3(grid), dim3(512), args, LDS_BYTES, stream);
    if (e != hipSuccess) fprintf(stderr, "cooperative launch failed: %s (grid %d)\n", hipGetErrorString(e), grid);
#else
    for (int k = 0; k < NPHASE; ++k) {
        p.ph_lo = k; p.ph_hi = k + 1;
        hipLaunchKernelGGL(fwd_kernel, dim3(grid), dim3(512), LDS_BYTES, stream, p);
    }
#endif
}
```

```cpp
#include <hip/hip_runtime.h>
#include <hip/hip_cooperative_groups.h>
#include <cstdio>
namespace cg = cooperative_groups;

#ifndef ONE_LAUNCH
#define ONE_LAUNCH 1
#endif

typedef unsigned short bf16_t;
typedef short bf16x8 __attribute__((ext_vector_type(8)));
typedef float f32x4 __attribute__((ext_vector_type(4)));
typedef unsigned u32x4 __attribute__((ext_vector_type(4)));
typedef unsigned u32x2 __attribute__((ext_vector_type(2)));
#define LAS __attribute__((address_space(3)))

constexpr int DM = 2048, NTOK = 16384, SEQ = 4096, DFF = 8192;
constexpr int LDE = 5120;
constexpr int LDO = 5376;
constexpr float EPS = 1e-6f;

constexpr size_t WS_WOUT = 0;
constexpr size_t WS_W1 = 8388608;
constexpr size_t WS_W2 = WS_W1 + 33554432;
constexpr size_t WS_U = WS_W2 + 33554432;
constexpr size_t WS_BIG = WS_U + 67108864;
constexpr size_t WS_WIN = WS_BIG + 268435456;
constexpr size_t WS_YZ = WS_WIN + 30408704;
constexpr size_t WS_VT_E = WS_BIG + (size_t)NTOK * LDE * 2;
constexpr size_t WS_VT_O = WS_BIG + (size_t)NTOK * LDO * 2;
constexpr size_t WS_ST = WS_VT_O + 67108864;
constexpr size_t WS_DEC = WS_ST + 134217728;
constexpr size_t WS_BAR = WS_DEC + 3072 * 128 * 4;
constexpr size_t WS_SS = WS_BAR + 16384;
constexpr size_t WS_PCNT = WS_SS + 8 * 65536;
constexpr size_t WS_END = WS_PCNT + 4096;
constexpr size_t WS_ZERO_BYTES = WS_END - WS_BAR;

constexpr int LDS_BYTES = 131072 + 4096;

__device__ __forceinline__ float bf2f(bf16_t v) { return __uint_as_float(((unsigned)v) << 16); }
typedef float f32x2 __attribute__((ext_vector_type(2)));
typedef __bf16 bf16x2v __attribute__((ext_vector_type(2)));
__device__ __forceinline__ unsigned pk2(float lo, float hi) { f32x2 v = {lo, hi}; bf16x2v b = __builtin_convertvector(v, bf16x2v); return __builtin_bit_cast(unsigned, b); }
__device__ __forceinline__ bf16_t f2bf(float f) { return __builtin_bit_cast(bf16_t, (__bf16)f); }
__device__ __forceinline__ float wave_sum(float v) {
#pragma unroll
    for (int o = 1; o < 64; o <<= 1) v += __shfl_xor(v, o);
    return v;
}
__device__ __forceinline__ float frcp(float x) { return __builtin_amdgcn_rcpf(x); }
__device__ __forceinline__ float sigmoidf_(float x) { return frcp(1.f + __expf(-x)); }
#define LDS_WAIT() asm volatile("s_waitcnt lgkmcnt(0)" ::: "memory")
__device__ __forceinline__ float dpp_f(float v, int ctrl_sel) {
    const int x = __float_as_int(v); int y;
    if (ctrl_sel == 0) y = __builtin_amdgcn_update_dpp(x, x, 0xB1, 0xF, 0xF, false);
    else if (ctrl_sel == 1) y = __builtin_amdgcn_update_dpp(x, x, 0x4E, 0xF, 0xF, false);
    else if (ctrl_sel == 2) y = __builtin_amdgcn_update_dpp(x, x, 0x141, 0xF, 0xF, false);
    else y = __builtin_amdgcn_update_dpp(x, x, 0x140, 0xF, 0xF, false);
    return __int_as_float(y);
}
__device__ __forceinline__ float row16_max(float v) { v = fmaxf(v, dpp_f(v, 0)); v = fmaxf(v, dpp_f(v, 1)); v = fmaxf(v, dpp_f(v, 2)); v = fmaxf(v, dpp_f(v, 3)); return v; }
__device__ __forceinline__ float row16_sum(float v) { v += dpp_f(v, 0); v += dpp_f(v, 1); v += dpp_f(v, 2); v += dpp_f(v, 3); return v; }

namespace pg8 {
constexpr int BM = 256, BK = 64, HALF = 128, HTB = HALF * BK * 2, STAGE_BYTES = 8 * HTB, NXCD = 8, WGM = 8;
__host__ __device__ __forceinline__ int lds_byte(int r, int c) { const int st = (r >> 4) * 2 + (c >> 5), rr = r & 15, cc = c & 31, ob = rr * 64 + cc * 2; return st * 1024 + (ob ^ (((ob >> 9) & 1) << 5)); }
__host__ __device__ __forceinline__ void stage_rc(int b, int& R, int& C) { const int st = b / 1024, sb = b % 1024, swz = sb ^ (((sb >> 9) & 1) << 5); R = (st >> 1) * 16 + swz / 64; C = (st & 1) * 32 + (swz % 64) / 2; }
__host__ __device__ __forceinline__ int perm32(int rho) { const int n = rho >> 4, i = rho & 15; return 8 * (i >> 2) + 4 * n + (i & 3); }
struct Unit { int pm, pn; };
struct Gemm { const bf16_t* A; const bf16_t* Bt; int M, N, K; };
struct StaticOrder {
    int nM, nN, nwg, G, c;
    __device__ void init(int M, int N, int G_, int c_) { nM = M / BM; nN = N / BM; nwg = nM * nN; G = G_; c = c_; }
    __device__ bool next(int i, Unit& u) const {
        const long L = (long)i * G + c; if (L >= nwg) return false;
        int wgid = (int)L; { const int q = nwg / NXCD, r = nwg % NXCD, xcd = wgid % NXCD, off = wgid / NXCD; wgid = (xcd < r ? xcd * (q + 1) : r * (q + 1) + (xcd - r) * q) + off; }
        const int nig = WGM * nN, gid = wgid / nig, fm = gid * WGM, gsz = (nM - fm) < WGM ? (nM - fm) : WGM;
        u.pm = fm + ((wgid % nig) % gsz); u.pn = (wgid % nig) / gsz; return true;
    }
};
template <int ACT, int RS> struct EpiB {
    static constexpr bool PERM = true;
    bf16_t* O; int ldc; const float* rs;
    __device__ __forceinline__ void load_rs(const Unit& u, int wr, int fr, float (&rsv)[8]) const {
        if (RS == 1) {
#pragma unroll
            for (int q = 0; q < 8; ++q) rsv[q] = __builtin_amdgcn_rsqf(rs[u.pm * BM + wr * 64 + fr + (q >> 2) * HALF + (q & 3) * 16] * (1.f / 2048.f) + 1e-6f); }
    }
    __device__ __forceinline__ void operator()(const f32x4 (&acc)[2][2][4][2], const Unit& u, int wr, int wc, int fr, int fq, const float (&rsv)[8]) const {
        const int row0 = u.pm * BM + wr * 64 + fr, col0 = u.pn * BM + wc * 32 + 8 * fq;
        f32x4 cs[2][2];
        if (RS == 2) {
#pragma unroll
            for (int bj = 0; bj < 2; ++bj) { cs[bj][0] = *(const f32x4*)(rs + col0 + bj * HALF); cs[bj][1] = *(const f32x4*)(rs + col0 + bj * HALF + 4);
#pragma unroll
                for (int e = 0; e < 4; ++e) { cs[bj][0][e] = __builtin_amdgcn_rsqf(cs[bj][0][e] * (1.f / 2048.f) + 1e-6f); cs[bj][1][e] = __builtin_amdgcn_rsqf(cs[bj][1][e] * (1.f / 2048.f) + 1e-6f); } } }
#pragma unroll
        for (int ai = 0; ai < 2; ++ai)
#pragma unroll
            for (int m = 0; m < 4; ++m) { const int row = row0 + ai * HALF + m * 16; bf16_t* rowp = O + (size_t)row * ldc + col0;
                float rsc = 1.f; if (RS == 1) rsc = rsv[ai * 4 + m];
#pragma unroll
                for (int bj = 0; bj < 2; ++bj) { f32x4 v0 = acc[ai][bj][m][0], v1 = acc[ai][bj][m][1];
                    if (RS == 1) { v0 *= rsc; v1 *= rsc; }
                    if (RS == 2) { v0 *= cs[bj][0]; v1 *= cs[bj][1]; }
                    if (ACT == 1) {
#pragma unroll
                        for (int j = 0; j < 4; ++j) { float a = fmaxf(v0[j], 0.f), b = fmaxf(v1[j], 0.f); v0[j] = a * a; v1[j] = b * b; } }
                    u32x4 w; w.x = pk2(v0[0], v0[1]); w.y = pk2(v0[2], v0[3]); w.z = pk2(v1[0], v1[1]); w.w = pk2(v1[2], v1[3]);
                    *(u32x4*)(rowp + bj * HALF) = w; } }
    }
};

struct PanelOrder {
    int c;
    __device__ bool next(int i, Unit& u) const { if (i >= 2) return false; const int x = c & 7, k = c >> 3; u.pm = i * 32 + x * 4 + (k >> 3); u.pn = k & 7; return true; }
};
template <bool FINAL> struct EpiRes {
    static constexpr bool PERM = true;
    bf16_t* hb; float* out; const float* g1; float* ssY; float* ssH; unsigned* cnt;
    __device__ __forceinline__ void load_rs(const Unit&, int, int, float (&)[8]) const {}
    __device__ __forceinline__ void operator()(const f32x4 (&acc)[2][2][4][2], const Unit& u, int wr, int wc, int fr, int fq, const float (&)[8]) const {
        const int row0 = u.pm * BM + wr * 64 + fr, col0 = u.pn * BM + wc * 32 + 8 * fq;
#pragma unroll
        for (int q = 0; q < 8; ++q) { const int ai = q >> 2, m = q & 3; float sq = 0.f;
#pragma unroll
            for (int bj = 0; bj < 2; ++bj)
#pragma unroll
                for (int n = 0; n < 2; ++n)
#pragma unroll
                    for (int e = 0; e < 4; ++e) sq += acc[ai][bj][m][n][e] * acc[ai][bj][m][n][e];
            sq += __shfl_xor(sq, 16); sq += __shfl_xor(sq, 32);
            if (fq == 0) (void)__hip_atomic_fetch_add(ssY + row0 + ai * HALF + m * 16, sq, __ATOMIC_RELAXED, __HIP_MEMORY_SCOPE_AGENT); }
        asm volatile("s_waitcnt vmcnt(0)" ::: "memory");
        __builtin_amdgcn_s_barrier();
        if (threadIdx.x == 0) {
            (void)__hip_atomic_fetch_add(cnt + u.pm, 1u, __ATOMIC_RELAXED, __HIP_MEMORY_SCOPE_AGENT);
            unsigned sp = 0;
            while (__hip_atomic_load(cnt + u.pm, __ATOMIC_RELAXED, __HIP_MEMORY_SCOPE_AGENT) < 8u) { __builtin_amdgcn_s_sleep(1); if (++sp > (1u << 22)) break; }
        }
        asm volatile("" ::: "memory");
        __builtin_amdgcn_s_barrier();
        asm volatile("" ::: "memory");
        f32x4 gv[2][2];
#pragma unroll
        for (int bj = 0; bj < 2; ++bj) { gv[bj][0] = *(const f32x4*)(g1 + col0 + bj * HALF); gv[bj][1] = *(const f32x4*)(g1 + col0 + bj * HALF + 4); }
#pragma unroll
        for (int q = 0; q < 8; ++q) { const int ai = q >> 2, m = q & 3, row = row0 + ai * HALF + m * 16;
            const float rs1 = __builtin_amdgcn_rsqf(__hip_atomic_load(ssY + row, __ATOMIC_RELAXED, __HIP_MEMORY_SCOPE_AGENT) * (1.f / 2048.f) + 1e-6f);
            bf16_t* rowp = hb + (size_t)row * 2048 + col0; float s2 = 0.f;
#pragma unroll
            for (int bj = 0; bj < 2; ++bj) { const u32x4 hw = *(const u32x4*)(rowp + bj * HALF);
                f32x4 h0, h1;
                h0[0] = __uint_as_float(hw[0] << 16); h0[1] = __uint_as_float(hw[0] & 0xffff0000u); h0[2] = __uint_as_float(hw[1] << 16); h0[3] = __uint_as_float(hw[1] & 0xffff0000u);
                h1[0] = __uint_as_float(hw[2] << 16); h1[1] = __uint_as_float(hw[2] & 0xffff0000u); h1[2] = __uint_as_float(hw[3] << 16); h1[3] = __uint_as_float(hw[3] & 0xffff0000u);
                h0 += acc[ai][bj][m][0] * rs1 * gv[bj][0]; h1 += acc[ai][bj][m][1] * rs1 * gv[bj][1];
                if (FINAL) { float* op = out + (size_t)row * 2048 + col0 + bj * HALF; *(f32x4*)op = h0; *(f32x4*)(op + 4) = h1; }
                else {
#pragma unroll
                    for (int e = 0; e < 4; ++e) s2 += h0[e] * h0[e] + h1[e] * h1[e];
                    u32x4 w; w.x = pk2(h0[0], h0[1]); w.y = pk2(h0[2], h0[3]); w.z = pk2(h1[0], h1[1]); w.w = pk2(h1[2], h1[3]);
                    *(u32x4*)(rowp + bj * HALF) = w; } }
            if (!FINAL) { s2 += __shfl_xor(s2, 16); s2 += __shfl_xor(s2, 32);
                if (fq == 0) (void)__hip_atomic_fetch_add(ssH + row, s2, __ATOMIC_RELAXED, __HIP_MEMORY_SCOPE_AGENT); } }
    }
};

template <class Epi, class Sched>
__device__ __forceinline__ void gemm_phase(LAS unsigned char* lds, const Gemm g, const Sched& S, const Epi& E) {
    const int tid = threadIdx.x, wid = __builtin_amdgcn_readfirstlane(tid >> 6), lane = tid & 63, wr = wid >> 2, wc = wid & 3, fr = lane & 15, fq = lane >> 4;
    const int K = g.K, nt = K / BK;
    unsigned voffA[2], voffB[2];
#pragma unroll
    for (int i = 0; i < 2; ++i) { int R, C; stage_rc(tid * 16 + i * 8192, R, C); const int Rb = Epi::PERM ? ((R & ~31) + perm32(R & 31)) : R;
        voffA[i] = (unsigned)(R * K + C) * 2u; voffB[i] = (unsigned)(Rb * K + C) * 2u; }
    const size_t kstep = (size_t)(BK * 2);
    const size_t hstep = (size_t)HALF * K * 2;
    const size_t tstep = 2 * hstep;
    const unsigned ldsw = (unsigned)wid * 1024u;
    const int aoff = lds_byte(wr * 64 + fr, fq * 8), boff = lds_byte(wc * 32 + fr, fq * 8);
#define PG8_SA(b, h) (((b) * 2 + (h)) * HTB)
#define PG8_SB(b, h) ((4 + (b) * 2 + (h)) * HTB)
#define PG8_STAGE(bufoff, gbase, voff) do { _Pragma("unroll") for (int _i = 0; _i < 2; ++_i) \
        __builtin_amdgcn_global_load_lds((const unsigned*)((const char*)(gbase) + (voff)[_i]), (LAS unsigned*)(lds + (bufoff) + ldsw + _i * 8192), 16, 0, 0); } while (0)
#define PG8_LDA(dst, b, h) do { _Pragma("unroll") for (int m = 0; m < 4; ++m) _Pragma("unroll") for (int k = 0; k < 2; ++k) dst[m][k] = *(const LAS bf16x8*)(lds + PG8_SA(b, h) + aoff + m * 2048 + k * 1024); } while (0)
#define PG8_LDB(dst, b, h) do { _Pragma("unroll") for (int n = 0; n < 2; ++n) _Pragma("unroll") for (int k = 0; k < 2; ++k) dst[n][k] = *(const LAS bf16x8*)(lds + PG8_SB(b, h) + boff + n * 2048 + k * 1024); } while (0)
#define PG8_MMA(ai, bj, At, Bt) do { __builtin_amdgcn_s_setprio(1); _Pragma("unroll") for (int m = 0; m < 4; ++m) _Pragma("unroll") for (int n = 0; n < 2; ++n) _Pragma("unroll") for (int k = 0; k < 2; ++k) \
        acc[ai][bj][m][n] = __builtin_amdgcn_mfma_f32_16x16x32_bf16(Bt[n][k], At[m][k], acc[ai][bj][m][n], 0, 0, 0); __builtin_amdgcn_s_setprio(0); } while (0)
#define PG8_WAIT_V(n) asm volatile("s_waitcnt vmcnt(" #n ")" ::: "memory")
#define PG8_WAIT_L(n) asm volatile("s_waitcnt lgkmcnt(" #n ")" ::: "memory")
#define PG8_BAR __builtin_amdgcn_s_barrier()
#define PG8_SCHED __builtin_amdgcn_sched_barrier(0)
    Unit cur, nxt; int ui = 0;
    if (!S.next(0, cur)) return;
    f32x4 acc[2][2][4][2];
#pragma unroll
    for (int a = 0; a < 2; ++a)
#pragma unroll
        for (int b = 0; b < 2; ++b)
#pragma unroll
            for (int m = 0; m < 4; ++m)
#pragma unroll
                for (int n = 0; n < 2; ++n) acc[a][b][m][n] = (f32x4){0.f, 0.f, 0.f, 0.f};
    bf16x8 At[4][2], B0[2][2], B1[2][2];
    const char* cA = (const char*)g.A + (size_t)cur.pm * tstep; const char* cB = (const char*)g.Bt + (size_t)cur.pn * tstep;
    float rsv[8] = {1.f, 1.f, 1.f, 1.f, 1.f, 1.f, 1.f, 1.f};
    E.load_rs(cur, wr, fr, rsv);
    PG8_STAGE(PG8_SB(0, 0), cB, voffB); PG8_STAGE(PG8_SB(0, 1), cB + hstep, voffB); PG8_STAGE(PG8_SA(0, 0), cA, voffA); PG8_STAGE(PG8_SA(0, 1), cA + hstep, voffA);
    if (wr == 1) PG8_BAR;
    PG8_WAIT_V(2); PG8_BAR;
    PG8_STAGE(PG8_SB(1, 0), cB + kstep, voffB); PG8_STAGE(PG8_SA(1, 0), cA + kstep, voffA); PG8_STAGE(PG8_SB(1, 1), cB + hstep + kstep, voffB);
    PG8_WAIT_V(6); PG8_BAR;
    for (;;) {
        const bool has_next = S.next(ui + 1, nxt);
        const char* nA = has_next ? (const char*)g.A + (size_t)nxt.pm * tstep : cA; const char* nB = has_next ? (const char*)g.Bt + (size_t)nxt.pn * tstep : cB;
        for (int t = 0; t < nt; t += 2) {
            const bool last = (t == nt - 2);
            const char* a1 = cA + (size_t)(t + 1) * kstep;
            const char* a2 = last ? nA : cA + (size_t)(t + 2) * kstep; const char* b2 = last ? nB : cB + (size_t)(t + 2) * kstep;
            const char* a3 = a2 + kstep; const char* b3 = b2 + kstep;
            PG8_LDB(B0, 0, 0); PG8_LDB(B1, 0, 1); PG8_SCHED; PG8_LDA(At, 0, 0); PG8_STAGE(PG8_SA(1, 1), a1 + hstep, voffA);
            PG8_WAIT_V(8); PG8_WAIT_L(0); PG8_BAR; PG8_MMA(0, 0, At, B0); PG8_MMA(0, 1, At, B1); PG8_BAR; PG8_SCHED;
            PG8_LDA(At, 0, 1); PG8_STAGE(PG8_SB(0, 0), b2, voffB); PG8_STAGE(PG8_SB(0, 1), b2 + hstep, voffB); PG8_STAGE(PG8_SA(0, 0), a2, voffA);
            PG8_WAIT_V(8); PG8_WAIT_L(0); PG8_BAR; PG8_MMA(1, 0, At, B0); PG8_MMA(1, 1, At, B1); PG8_BAR; PG8_SCHED;
            PG8_LDB(B0, 1, 0); PG8_LDB(B1, 1, 1); PG8_SCHED; PG8_LDA(At, 1, 0); PG8_STAGE(PG8_SA(0, 1), a2 + hstep, voffA);
            PG8_WAIT_V(8); PG8_WAIT_L(0); PG8_BAR; PG8_MMA(0, 0, At, B0); PG8_MMA(0, 1, At, B1); PG8_BAR; PG8_SCHED;
            PG8_LDA(At, 1, 1); PG8_STAGE(PG8_SB(1, 0), b3, voffB); PG8_STAGE(PG8_SB(1, 1), b3 + hstep, voffB); PG8_STAGE(PG8_SA(1, 0), a3, voffA);
            PG8_WAIT_V(8); PG8_WAIT_L(0); PG8_BAR; PG8_MMA(1, 0, At, B0); PG8_MMA(1, 1, At, B1); PG8_BAR; PG8_SCHED;
        }
        if (wr == 0) PG8_BAR;
        E(acc, cur, wr, wc, fr, fq, rsv);
        if (!has_next) break;
        E.load_rs(nxt, wr, fr, rsv);
#pragma unroll
        for (int a = 0; a < 2; ++a)
#pragma unroll
            for (int b = 0; b < 2; ++b)
#pragma unroll
                for (int m = 0; m < 4; ++m)
#pragma unroll
                    for (int n = 0; n < 2; ++n) acc[a][b][m][n] = (f32x4){0.f, 0.f, 0.f, 0.f};
        cur = nxt; cA = nA; cB = nB; ++ui;
        if (wr == 1) PG8_BAR;
    }
    PG8_WAIT_V(0);
    PG8_BAR;
#undef PG8_SA
#undef PG8_SB
#undef PG8_STAGE
#undef PG8_LDA
#undef PG8_LDB
#undef PG8_MMA
#undef PG8_WAIT_V
#undef PG8_WAIT_L
#undef PG8_BAR
#undef PG8_SCHED
}
}

struct Params {
    const float* x; const float* norm_g; const float* even_w_in; const float* conv_w; const float* rel_bias; const float* even_w_out;
    const float* odd_w_in; const float* hgrn_lb; const float* hgrn_ng; const float* wa2; const float* ba; const float* gla_ng; const float* odd_w_out;
    const float* w1; const float* w2; float* out; unsigned char* ws; int ph_lo, ph_hi;
};

__device__ __forceinline__ void cvt_seg(const float* __restrict__ W, int K, int NS, int c0, int nc, bf16_t* __restrict__ WT, int r0, const float* __restrict__ gf, float* scr, int gw, int NGW, int lane) {
    const int nblk = (nc + 31) >> 5, nitems = (K >> 6) * nblk;
    const int krow = lane >> 3, c4 = (lane & 7) * 4;
    for (int it = gw; it < nitems; it += NGW) {
        const int kb = it / nblk, nb = it - kb * nblk, k0 = kb * 64, n0 = nb * 32;
        const bool ok = (n0 + c4) < nc;
        const float* src = W + (size_t)(k0 + krow) * NS + c0 + n0 + c4;
        f32x4 v[8];
#pragma unroll
        for (int i = 0; i < 8; ++i) v[i] = ok ? *(const f32x4*)(src + (size_t)(8 * i) * NS) : (f32x4){0.f, 0.f, 0.f, 0.f};
        if (gf) {
#pragma unroll
            for (int i = 0; i < 8; ++i) v[i] *= gf[k0 + 8 * i + krow]; }
#pragma unroll
        for (int i = 0; i < 8; ++i) { float* d = scr + (8 * i + krow) * 33 + c4; d[0] = v[i][0]; d[1] = v[i][1]; d[2] = v[i][2]; d[3] = v[i][3]; }
        LDS_WAIT();
        const int c = lane & 7;
#pragma unroll
        for (int j = 0; j < 4; ++j) { const int n = (lane >> 3) + 8 * j; const float* s = scr + (8 * c) * 33 + n;
            u32x4 o; o.x = pk2(s[0], s[33]); o.y = pk2(s[66], s[99]); o.z = pk2(s[132], s[165]); o.w = pk2(s[198], s[231]);
            if (n0 + n < nc) *(u32x4*)(WT + (size_t)(r0 + n0 + n) * K + k0 + 8 * c) = o; }
        LDS_WAIT();
    }
}

template <int MODE>
__device__ __forceinline__ void rowwise(const float* __restrict__ xin, const bf16_t* __restrict__ ysrc, const float* __restrict__ g1,
                                        bf16_t* hb, float* __restrict__ rsout, float* __restrict__ out, int gw, int NGW, int lane) {
    for (int row0 = gw; row0 < NTOK; row0 += 2 * NGW) {
        f32x4 h[2][4][2]; u32x4 yw[2][4], hw[2][4];
#pragma unroll
        for (int rr = 0; rr < 2; ++rr) { const size_t rb = (size_t)(row0 + rr * NGW) * DM;
#pragma unroll
            for (int j = 0; j < 4; ++j) { const int col = 512 * j + 8 * lane;
                if (MODE == 0) { h[rr][j][0] = *(const f32x4*)(xin + rb + col); h[rr][j][1] = *(const f32x4*)(xin + rb + col + 4); }
                else { hw[rr][j] = *(const u32x4*)(hb + rb + col); yw[rr][j] = *(const u32x4*)(ysrc + rb + col); } } }
#pragma unroll
        for (int rr = 0; rr < 2; ++rr) {
            const int row = row0 + rr * NGW; const size_t rb = (size_t)row * DM;
            if (MODE != 0) {
                float y[4][8]; float ss = 0.f;
#pragma unroll
                for (int j = 0; j < 4; ++j) {
#pragma unroll
                    for (int e = 0; e < 4; ++e) { y[j][2 * e] = __uint_as_float(yw[rr][j][e] << 16); y[j][2 * e + 1] = __uint_as_float(yw[rr][j][e] & 0xffff0000u);
                        h[rr][j][e >> 1][(2 * e) & 3] = __uint_as_float(hw[rr][j][e] << 16); h[rr][j][e >> 1][(2 * e + 1) & 3] = __uint_as_float(hw[rr][j][e] & 0xffff0000u); }
#pragma unroll
                    for (int e = 0; e < 8; ++e) ss += y[j][e] * y[j][e]; }
                const float rs = rsqrtf(wave_sum(ss) * (1.f / DM) + EPS);
#pragma unroll
                for (int j = 0; j < 4; ++j) { const int col = 512 * j + 8 * lane; const f32x4 ga = *(const f32x4*)(g1 + col), gb = *(const f32x4*)(g1 + col + 4);
#pragma unroll
                    for (int e = 0; e < 4; ++e) { h[rr][j][0][e] += y[j][e] * rs * ga[e]; h[rr][j][1][e] += y[j][4 + e] * rs * gb[e]; }
                    if (MODE == 2) { *(f32x4*)(out + rb + col) = h[rr][j][0]; *(f32x4*)(out + rb + col + 4) = h[rr][j][1]; } }
            }
            if (MODE != 2) {
                float ss = 0.f;
#pragma unroll
                for (int j = 0; j < 4; ++j)
#pragma unroll
                    for (int e = 0; e < 4; ++e) ss += h[rr][j][0][e] * h[rr][j][0][e] + h[rr][j][1][e] * h[rr][j][1][e];
                const float sst = wave_sum(ss);
                if (lane == 0) rsout[row] = sst;
#pragma unroll
                for (int j = 0; j < 4; ++j) { const int col = 512 * j + 8 * lane;
                    u32x4 o; o.x = pk2(h[rr][j][0][0], h[rr][j][0][1]); o.y = pk2(h[rr][j][0][2], h[rr][j][0][3]);
                    o.z = pk2(h[rr][j][1][0], h[rr][j][1][1]); o.w = pk2(h[rr][j][1][2], h[rr][j][1][3]);
                    *(u32x4*)(hb + rb + col) = o; }
            }
        }
    }
}

__device__ __forceinline__ void conv_phase(const bf16_t* __restrict__ P, const float* __restrict__ cw, bf16_t* __restrict__ ycat) {
    const int nthr = gridDim.x * 512;
#pragma unroll 2
    for (int it = blockIdx.x * 512 + threadIdx.x; it < NTOK * 128; it += nthr) {
        const int t = it >> 7, c0 = (it & 127) * 8, tp = t & (SEQ - 1);
        const bf16_t* row = P + (size_t)t * LDE + c0;
        const u32x4 bg = *(const u32x4*)(row), c2 = *(const u32x4*)(row + 1024), h2 = *(const u32x4*)(row + 2048);
        u32x4 c1 = (u32x4){0, 0, 0, 0}, h1 = c1, cz = c1, hz = c1;
        if (tp >= 1) { c1 = *(const u32x4*)(row - LDE + 1024); h1 = *(const u32x4*)(row - LDE + 2048); }
        if (tp >= 2) { cz = *(const u32x4*)(row - 2 * LDE + 1024); hz = *(const u32x4*)(row - 2 * LDE + 2048); }
        float o[8];
#pragma unroll
        for (int e = 0; e < 8; ++e) {
            const int sh = (e & 1) ? 0 : 16; const int w = e >> 1;
            auto get = [&](const u32x4& v) { return __uint_as_float((v[w] << sh) & 0xffff0000u); };
            const float u2 = get(c2) * get(h2), u1 = get(c1) * get(h1), u0 = get(cz) * get(hz);
            const float y = cw[c0 + e] * u0 + cw[1024 + c0 + e] * u1 + cw[2048 + c0 + e] * u2;
            o[e] = get(bg) * y;
        }
        u32x4 w; w.x = pk2(o[0], o[1]); w.y = pk2(o[2], o[3]); w.z = pk2(o[4], o[5]); w.w = pk2(o[6], o[7]);
        *(u32x4*)(ycat + (size_t)t * DM + c0) = w;
    }
}

struct ConvRegs { u32x4 bg, c2, h2, c1, h1, cz, hz; };
__device__ __forceinline__ void conv_load(const bf16_t* __restrict__ P, int it, ConvRegs& R) {
    const int t = it >> 7, c0 = (it & 127) * 8, tp = t & (SEQ - 1);
    const bf16_t* row = P + (size_t)t * LDE + c0;
    R.bg = *(const u32x4*)(row); R.c2 = *(const u32x4*)(row + 1024); R.h2 = *(const u32x4*)(row + 2048);
    R.c1 = (u32x4){0, 0, 0, 0}; R.h1 = R.c1; R.cz = R.c1; R.hz = R.c1;
    if (tp >= 1) { R.c1 = *(const u32x4*)(row - LDE + 1024); R.h1 = *(const u32x4*)(row - LDE + 2048); }
    if (tp >= 2) { R.cz = *(const u32x4*)(row - 2 * LDE + 1024); R.hz = *(const u32x4*)(row - 2 * LDE + 2048); }
}
__device__ __forceinline__ void conv_finish(const float* __restrict__ cw, bf16_t* __restrict__ ycat, int it, const ConvRegs& R) {
    const int t = it >> 7, c0 = (it & 127) * 8;
    float o[8];
#pragma unroll
    for (int e = 0; e < 8; ++e) {
        const int sh = (e & 1) ? 0 : 16; const int w = e >> 1;
        auto get = [&](const u32x4& v) { return __uint_as_float((v[w] << sh) & 0xffff0000u); };
        const float u2 = get(R.c2) * get(R.h2), u1 = get(R.c1) * get(R.h1), u0 = get(R.cz) * get(R.hz);
        const float y = cw[c0 + e] * u0 + cw[1024 + c0 + e] * u1 + cw[2048 + c0 + e] * u2;
        o[e] = get(R.bg) * y;
    }
    u32x4 w; w.x = pk2(o[0], o[1]); w.y = pk2(o[2], o[3]); w.z = pk2(o[4], o[5]); w.w = pk2(o[6], o[7]);
    *(u32x4*)(ycat + (size_t)t * DM + c0) = w;
}

__device__ __forceinline__ void attn_phase(unsigned char* smem, const bf16_t* __restrict__ P, const bf16_t* __restrict__ VT, const float* __restrict__ relb, const float* __restrict__ cw, bf16_t* __restrict__ ycat) {
    const int cv_base = blockIdx.x * 512 + threadIdx.x, cv_stride = gridDim.x * 512;
    int cv_it = cv_base; ConvRegs CR;
    const int tid = threadIdx.x, lane = tid & 63, wave = tid >> 6, half = wave >> 2, w4 = wave & 3, ltid = tid & 255, r = lane & 15, q8 = lane >> 4;
    unsigned char* base = smem + half * 47616;
    bf16_t* kS = (bf16_t*)base;
    bf16_t* vS = (bf16_t*)(base + 17408);
    bf16_t* pS = (bf16_t*)(base + 35840);
    float* bS = (float*)(base + 45056);
    const float scale = 0.08838834764831845f * 1.4426950408889634f;
    for (int pair = blockIdx.x; pair < 1024; pair += gridDim.x) {
        const int hp = pair & 3, n = (pair >> 2) & 63, b = pair >> 8, head = hp * 2 + half;
        const int tok0 = b * SEQ + n * 64;
        __syncthreads();
        for (int i = ltid; i < 640; i += 256) bS[i] = relb[head * 320 + (i < 319 ? i : 319)] * 1.4426950408889634f;
        bf16x8 qf[4];
        { const bf16_t* qp = P + (size_t)(tok0 + 16 * w4 + r) * LDE + 3072 + head * 128 + 8 * q8;
#pragma unroll
          for (int kk = 0; kk < 4; ++kk) qf[kk] = *(const bf16x8*)(qp + 32 * kk); }
        float m[4], l[4]; f32x4 o[8];
#pragma unroll
        for (int j = 0; j < 4; ++j) { m[j] = -1e30f; l[j] = 0.f; }
#pragma unroll
        for (int i = 0; i < 8; ++i) o[i] = (f32x4){0.f, 0.f, 0.f, 0.f};
        const int js0 = (n < 8 ? 8 - n : 0);
        u32x4 kreg[4], vreg[4];
        { const int ktok0 = tok0 + (js0 - 8) * 64;
#pragma unroll
          for (int i = 0; i < 4; ++i) { const int ch = ltid + 256 * i;
              kreg[i] = *(const u32x4*)(P + (size_t)(ktok0 + (ch >> 4)) * LDE + 4096 + head * 128 + (ch & 15) * 8);
              vreg[i] = *(const u32x4*)(VT + (size_t)(head * 128 + (ch >> 3)) * NTOK + ktok0 + (ch & 7) * 8); } }
        for (int js = js0; js <= 8; ++js) {
            const bool cv_on = cv_it < NTOK * 128;
            if (cv_on) conv_load(P, cv_it, CR);
            __syncthreads();
#pragma unroll
            for (int i = 0; i < 4; ++i) { const int ch = ltid + 256 * i;
                *(u32x4*)(kS + (ch >> 4) * 136 + (ch & 15) * 8) = kreg[i];
                *(u32x4*)(vS + (ch >> 3) * 72 + (ch & 7) * 8) = vreg[i]; }
            __syncthreads();
            if (js < 8) { const int ktok0 = tok0 + (js + 1 - 8) * 64;
#pragma unroll
                for (int i = 0; i < 4; ++i) { const int ch = ltid + 256 * i;
                    kreg[i] = *(const u32x4*)(P + (size_t)(ktok0 + (ch >> 4)) * LDE + 4096 + head * 128 + (ch & 15) * 8);
                    vreg[i] = *(const u32x4*)(VT + (size_t)(head * 128 + (ch >> 3)) * NTOK + ktok0 + (ch & 7) * 8); } }
            f32x4 s[4];
#pragma unroll
            for (int nt = 0; nt < 4; ++nt) { s[nt] = (f32x4){0.f, 0.f, 0.f, 0.f};
#pragma unroll
                for (int kk = 0; kk < 4; ++kk) { const bf16x8 kf = *(const bf16x8*)(kS + (16 * nt + r) * 136 + 32 * kk + 8 * q8);
                    s[nt] = __builtin_amdgcn_mfma_f32_16x16x32_bf16(qf[kk], kf, s[nt], 0, 0, 0); } }
            float alpha[4];
            const float* bT = bS + (16 * w4 + 4 * q8 - r + 63 + (8 - js) * 64);
#pragma unroll
            for (int j = 0; j < 4; ++j) {
                float mx = -1e30f;
#pragma unroll
                for (int nt = 0; nt < 4; ++nt) { const float v = s[nt][j] * scale + bT[j - 16 * nt]; s[nt][j] = v; mx = fmaxf(mx, v); }
                mx = row16_max(mx);
                const float mn = fmaxf(m[j], mx); alpha[j] = __builtin_amdgcn_exp2f(m[j] - mn); m[j] = mn;
                float ps = 0.f;
#pragma unroll
                for (int nt = 0; nt < 4; ++nt) { const float pp = __builtin_amdgcn_exp2f(s[nt][j] - mn); ps += pp; pS[(16 * w4 + 4 * q8 + j) * 72 + 16 * nt + r] = f2bf(pp); }
                l[j] = l[j] * alpha[j] + ps;
            }
#pragma unroll
            for (int i = 0; i < 8; ++i)
#pragma unroll
                for (int j = 0; j < 4; ++j) o[i][j] *= alpha[j];
            LDS_WAIT();
#pragma unroll
            for (int kk = 0; kk < 2; ++kk) { const bf16x8 pf = *(const bf16x8*)(pS + (16 * w4 + r) * 72 + 32 * kk + 8 * q8);
#pragma unroll
                for (int i = 0; i < 8; ++i) { const bf16x8 vf = *(const bf16x8*)(vS + (16 * i + r) * 72 + 32 * kk + 8 * q8);
                    o[i] = __builtin_amdgcn_mfma_f32_16x16x32_bf16(pf, vf, o[i], 0, 0, 0); } }
            if (cv_on) { conv_finish(cw, ycat, cv_it, CR); cv_it += cv_stride; }
        }
#pragma unroll
        for (int j = 0; j < 4; ++j) { float lt = l[j];
#pragma unroll
            for (int ofs = 1; ofs < 16; ofs <<= 1) lt += __shfl_xor(lt, ofs);
            const float inv = frcp(lt);
            bf16_t* op = ycat + (size_t)(tok0 + 16 * w4 + 4 * q8 + j) * DM + 1024 + head * 128 + r;
#pragma unroll
            for (int i = 0; i < 8; ++i) op[16 * i] = f2bf(o[i][j] * inv); }
    }
    for (; cv_it < NTOK * 128; cv_it += cv_stride) { conv_load(P, cv_it, CR); conv_finish(cw, ycat, cv_it, CR); }
}

template <int KIND, bool WANT_Q>
__device__ __forceinline__ void decay_qk(const Params& p, const bf16_t* __restrict__ P, int tok0, int hd, int d, int tq, float (&bl)[16], float (&kv)[16], float (&qv)[16]) {
    const int col = hd * 128 + d;
    const bf16_t* rp = P + (size_t)(tok0 + 16 * tq) * LDO;
    if (KIND == 0) {
        const float lb = frcp(1.f + __expf(p.hgrn_lb[col] - p.hgrn_lb[1024 + col]));
        float run = 0.f;
#pragma unroll
        for (int jj = 0; jj < 16; ++jj) {
            const float fr = bf2f(rp[(size_t)jj * LDO + 1024 + col]);
            const float f = lb + (1.f - lb) * sigmoidf_(fr);
            run += __logf(f); bl[jj] = run; kv[jj] = 1.f - f;
            if (WANT_Q) { const float qr = bf2f(rp[(size_t)jj * LDO + col]); qv[jj] = qr * sigmoidf_(qr); }
        }
    } else {
        float w[16];
#pragma unroll
        for (int rr = 0; rr < 16; ++rr) w[rr] = p.wa2[rr * 512 + col];
        const float bias = p.ba[col];
        float run = 0.f;
#pragma unroll
        for (int jj = 0; jj < 16; ++jj) {
            const u32x4 g0 = *(const u32x4*)(rp + (size_t)jj * LDO + 5120), g1 = *(const u32x4*)(rp + (size_t)jj * LDO + 5128);
            float xx = bias;
#pragma unroll
            for (int e = 0; e < 4; ++e) {
                xx += __uint_as_float(g0[e] << 16) * w[2 * e] + __uint_as_float(g0[e] & 0xffff0000u) * w[2 * e + 1];
                xx += __uint_as_float(g1[e] << 16) * w[8 + 2 * e] + __uint_as_float(g1[e] & 0xffff0000u) * w[8 + 2 * e + 1];
            }
            const float ls = fminf(xx, 0.f) - __logf(1.f + __expf(-fabsf(xx)));
            run += ls * (1.f / 16.f); bl[jj] = run;
            kv[jj] = bf2f(rp[(size_t)jj * LDO + 3584 + col]);
            if (WANT_Q) qv[jj] = bf2f(rp[(size_t)jj * LDO + 3072 + col]) * 0.08838834764831845f;
        }
    }
}

template <int KIND>
__device__ __forceinline__ void passA_item(const Params& p, unsigned char* smem_base, const bf16_t* __restrict__ P, const bf16_t* __restrict__ VT, bf16_t* __restrict__ ST, float* __restrict__ DEC, int idx, int par) {
    unsigned char* smem = smem_base + par * 57344;
    constexpr int DV = KIND ? 256 : 128;
    const int tid = threadIdx.x, lane = tid & 63, wave = tid >> 6, r = lane & 15, q8 = lane >> 4, d = tid & 127, tq = tid >> 7;
    const int c = idx & 63, bh = idx >> 6, hd = KIND ? (bh & 3) : (bh & 7), b = KIND ? (bh >> 2) : (bh >> 3);
    const int tok0 = b * SEQ + c * 64;
    bf16_t* kT = (bf16_t*)smem;
    bf16_t* vS = (bf16_t*)(smem + 18432);
    float* tot = (float*)(smem + 18432 + 36864);
    float bl[16], kv[16], qv[16];
    u32x4 vr[DV / 64];
    { const bf16_t* vsrc = VT + (size_t)((KIND ? 1024 + hd * 256 : hd * 128)) * NTOK + tok0;
#pragma unroll
      for (int i = 0; i < DV / 64; ++i) { const int ch = tid + 512 * i, row = ch >> 3, c8 = ch & 7; vr[i] = *(const u32x4*)(vsrc + (size_t)row * NTOK + c8 * 8); } }
    decay_qk<KIND, false>(p, P, tok0, hd, d, tq, bl, kv, qv);
    tot[tq * 128 + d] = bl[15];
#pragma unroll
    for (int i = 0; i < DV / 64; ++i) { const int ch = tid + 512 * i, row = ch >> 3, c8 = ch & 7; *(u32x4*)(vS + row * 72 + c8 * 8) = vr[i]; }
    __syncthreads();
    const float t0 = tot[d], t1 = tot[128 + d], t2 = tot[256 + d], t3 = tot[384 + d];
    const float r4 = t0 + t1 + t2 + t3;
    const float rpre = (tq > 0 ? t0 : 0.f) + (tq > 1 ? t1 : 0.f) + (tq > 2 ? t2 : 0.f);
    {
        float kt[16];
#pragma unroll
        for (int jj = 0; jj < 16; ++jj) kt[jj] = kv[jj] * __expf(r4 - rpre - bl[jj]);
        u32x4 w0, w1;
        w0.x = pk2(kt[0], kt[1]); w0.y = pk2(kt[2], kt[3]); w0.z = pk2(kt[4], kt[5]); w0.w = pk2(kt[6], kt[7]);
        w1.x = pk2(kt[8], kt[9]); w1.y = pk2(kt[10], kt[11]); w1.z = pk2(kt[12], kt[13]); w1.w = pk2(kt[14], kt[15]);
        *(u32x4*)(kT + d * 72 + 16 * tq) = w0; *(u32x4*)(kT + d * 72 + 16 * tq + 8) = w1;
    }
    const int gitem = (KIND ? 2048 : 0) + idx;
    if (tq == 0) DEC[(size_t)gitem * 128 + d] = __expf(r4);
    __syncthreads();
    const int d0 = 16 * wave;
    bf16x8 af[2];
#pragma unroll
    for (int kk = 0; kk < 2; ++kk) af[kk] = *(const bf16x8*)(kT + (d0 + r) * 72 + 32 * kk + 8 * q8);
    bf16_t* stb = ST + (KIND ? (size_t)33554432 : 0) + (size_t)idx * (DV * 128);
#pragma unroll
    for (int nt = 0; nt < DV / 16; ++nt) {
        f32x4 acc = (f32x4){0.f, 0.f, 0.f, 0.f};
#pragma unroll
        for (int kk = 0; kk < 2; ++kk) { const bf16x8 bfr = *(const bf16x8*)(vS + (16 * nt + r) * 72 + 32 * kk + 8 * q8);
            acc = __builtin_amdgcn_mfma_f32_16x16x32_bf16(af[kk], bfr, acc, 0, 0, 0); }
        u32x2 w; w.x = pk2(acc[0], acc[1]); w.y = pk2(acc[2], acc[3]);
        *(u32x2*)(stb + (size_t)(16 * nt + r) * 128 + d0 + 4 * q8) = w;
    }
}

__device__ __forceinline__ void scan_phase(bf16_t* __restrict__ ST, const float* __restrict__ DEC) {
    const int nthr = gridDim.x * 512;
    for (int gid = blockIdx.x * 512 + threadIdx.x; gid < 131072; gid += nthr) {
        const int kind = gid >> 16, v = gid & 65535;
        const int vper = kind ? 4096 : 2048, bh = v / vper, vi = v - bh * vper, d0 = (vi * 8) & 127;
        const size_t csz = kind ? 32768 : 16384;
        bf16_t* sp = ST + (kind ? (size_t)33554432 : 0) + (size_t)bh * 64 * csz + (size_t)vi * 8;
        const float* dp = DEC + (size_t)((kind ? 2048 : 0) + bh * 64) * 128 + d0;
        float S[8];
#pragma unroll
        for (int e = 0; e < 8; ++e) S[e] = 0.f;
#pragma unroll 8
        for (int c = 0; c < 64; ++c) {
            const u32x4 u = *(const u32x4*)(sp + (size_t)c * csz);
            const f32x4 da = *(const f32x4*)(dp + c * 128), db = *(const f32x4*)(dp + c * 128 + 4);
            u32x4 w; w.x = pk2(S[0], S[1]); w.y = pk2(S[2], S[3]); w.z = pk2(S[4], S[5]); w.w = pk2(S[6], S[7]);
            *(u32x4*)(sp + (size_t)c * csz) = w;
#pragma unroll
            for (int e = 0; e < 4; ++e) {
                S[2 * e] = S[2 * e] * (e < 2 ? da[2 * e] : db[2 * e - 4]) + __uint_as_float(u[e] << 16);
                S[2 * e + 1] = S[2 * e + 1] * (e < 2 ? da[2 * e + 1] : db[2 * e - 3]) + __uint_as_float(u[e] & 0xffff0000u);
            }
        }
    }
}

template <int KIND>
__device__ __forceinline__ void passC_item(const Params& p, unsigned char* smem, const bf16_t* __restrict__ P, const bf16_t* __restrict__ VT, const bf16_t* __restrict__ ST, bf16_t* __restrict__ ycat, int idx) {
    constexpr int DV = KIND ? 256 : 128;
    const int tid = threadIdx.x, lane = tid & 63, wave = tid >> 6, r = lane & 15, q8 = lane >> 4, d = tid & 127, tq = tid >> 7;
    const int c = idx & 63, bh = idx >> 6, hd = KIND ? (bh & 3) : (bh & 7), b = KIND ? (bh >> 2) : (bh >> 3);
    const int tok0 = b * SEQ + c * 64;
    bf16_t* qs = (bf16_t*)smem;
    bf16_t* qh = (bf16_t*)(smem + 17408);
    bf16_t* ks = (bf16_t*)(smem + 34816);
    bf16_t* vS = (bf16_t*)(smem + 78336);
    bf16_t* pS = (bf16_t*)(smem + 115200);
    float* tot = (float*)(smem + 124416);
    float* ssq = (float*)(smem + 126464);
    float bl[16], kv[16], qv[16];
    u32x4 vr[DV / 64];
    { const bf16_t* vsrc = VT + (size_t)((KIND ? 1024 + hd * 256 : hd * 128)) * NTOK + tok0;
#pragma unroll
      for (int i = 0; i < DV / 64; ++i) { const int ch = tid + 512 * i, row = ch >> 3, c8 = ch & 7; vr[i] = *(const u32x4*)(vsrc + (size_t)row * NTOK + c8 * 8); } }
    decay_qk<KIND, true>(p, P, tok0, hd, d, tq, bl, kv, qv);
    tot[tq * 128 + d] = bl[15];
#pragma unroll
    for (int i = 0; i < DV / 64; ++i) { const int ch = tid + 512 * i, row = ch >> 3, c8 = ch & 7; *(u32x4*)(vS + row * 72 + c8 * 8) = vr[i]; }
    for (int i = tid; i < 64 * 72 / 8; i += 512) *(u32x4*)(pS + i * 8) = (u32x4){0, 0, 0, 0};
    __syncthreads();
    constexpr int NT = DV / 32;
    constexpr int NPRE = 4;
    const int oi = wave & 3, oeh = wave >> 2;
    const bf16_t* stb = ST + (KIND ? (size_t)33554432 : 0) + (size_t)idx * (DV * 128);
    const int gcol = KIND ? 4096 + hd * 256 : 2048 + hd * 128;
    bf16x8 bst[NPRE][4];
#pragma unroll
    for (int nt = 0; nt < NPRE; ++nt)
#pragma unroll
        for (int kk = 0; kk < 4; ++kk) bst[nt][kk] = *(const bf16x8*)(stb + (size_t)(oeh * (DV / 2) + 16 * nt + r) * 128 + 32 * kk + 8 * q8);
    bf16_t graw[4][NT];
#pragma unroll
    for (int j = 0; j < 4; ++j)
#pragma unroll
        for (int nt = 0; nt < NT; ++nt) graw[j][nt] = P[(size_t)(tok0 + 16 * oi + 4 * q8 + j) * LDO + gcol + oeh * (DV / 2) + 16 * nt + r];
    {
        const float t0 = tot[d], t1 = tot[128 + d], t2 = tot[256 + d];
        const float rpre = (tq > 0 ? t0 : 0.f) + (tq > 1 ? t1 : 0.f) + (tq > 2 ? t2 : 0.f);
        const float Ttq = bl[15], rn = rpre + Ttq;
        const float einv = __expf(fminf(-Ttq, 80.f));
        const float f1 = (tq == 1) ? einv : __expf(fminf(t0 - rn, 0.f));
        const float f2 = (tq == 2) ? einv : __expf(fminf(t0 + t1 - rn, 0.f));
        const float f3 = (tq == 3) ? einv : __expf(fminf(t0 + t1 + t2 - rn, 0.f));
        const float erp = __expf(rpre);
#pragma unroll
        for (int jj = 0; jj < 16; ++jj) {
            const int t = 16 * tq + jj;
            const float ql = qv[jj] * __expf(bl[jj]);
            qs[t * 136 + d] = f2bf(ql);
            qh[t * 136 + d] = f2bf(ql * erp);
            const float kb = kv[jj] * __expf(Ttq - bl[jj]);
            if (tq == 0) ks[(0 + t) * 136 + d] = f2bf(kb * einv);
            if (tq <= 1) ks[(16 + t) * 136 + d] = f2bf(kb * f1);
            if (tq <= 2) ks[(48 + t) * 136 + d] = f2bf(kb * f2);
            ks[(96 + t) * 136 + d] = f2bf(kb * f3);
        }
    }
    __syncthreads();
    {
        const int i = wave >> 1, off = 8 * i * (i + 1);
        bf16x8 af[4];
#pragma unroll
        for (int kk = 0; kk < 4; ++kk) af[kk] = *(const bf16x8*)(qs + (16 * i + r) * 136 + 32 * kk + 8 * q8);
        for (int jt = (wave & 1); jt <= i; jt += 2) {
            f32x4 acc = (f32x4){0.f, 0.f, 0.f, 0.f};
#pragma unroll
            for (int kk = 0; kk < 4; ++kk) { const bf16x8 bfr = *(const bf16x8*)(ks + (off + 16 * jt + r) * 136 + 32 * kk + 8 * q8);
                acc = __builtin_amdgcn_mfma_f32_16x16x32_bf16(af[kk], bfr, acc, 0, 0, 0); }
#pragma unroll
            for (int j = 0; j < 4; ++j) { float v = acc[j]; if (jt == i && r > 4 * q8 + j) v = 0.f;
                pS[(16 * i + 4 * q8 + j) * 72 + 16 * jt + r] = f2bf(v); }
        }
    }
    __syncthreads();
    {
        const int i = oi, eh = oeh;
        bf16x8 ap[2], aq[4];
#pragma unroll
        for (int kk = 0; kk < 2; ++kk) ap[kk] = *(const bf16x8*)(pS + (16 * i + r) * 72 + 32 * kk + 8 * q8);
#pragma unroll
        for (int kk = 0; kk < 4; ++kk) aq[kk] = *(const bf16x8*)(qh + (16 * i + r) * 136 + 32 * kk + 8 * q8);
        f32x4 o[NT];
        float ss[4] = {0.f, 0.f, 0.f, 0.f};
#pragma unroll
        for (int nt = 0; nt < NT; ++nt) {
            const int e0 = eh * (DV / 2) + 16 * nt;
            f32x4 acc = (f32x4){0.f, 0.f, 0.f, 0.f};
#pragma unroll
            for (int kk = 0; kk < 2; ++kk) { const bf16x8 bfr = *(const bf16x8*)(vS + (e0 + r) * 72 + 32 * kk + 8 * q8);
                acc = __builtin_amdgcn_mfma_f32_16x16x32_bf16(ap[kk], bfr, acc, 0, 0, 0); }
#pragma unroll
            for (int kk = 0; kk < 4; ++kk) { bf16x8 bfr;
                if (nt < NPRE) bfr = bst[nt < NPRE ? nt : 0][kk]; else bfr = *(const bf16x8*)(stb + (size_t)(e0 + r) * 128 + 32 * kk + 8 * q8);
                acc = __builtin_amdgcn_mfma_f32_16x16x32_bf16(aq[kk], bfr, acc, 0, 0, 0); }
            o[nt] = acc;
#pragma unroll
            for (int j = 0; j < 4; ++j) ss[j] += acc[j] * acc[j];
        }
#pragma unroll
        for (int j = 0; j < 4; ++j) {
#pragma unroll
            for (int ofs = 1; ofs < 16; ofs <<= 1) ss[j] += __shfl_xor(ss[j], ofs);
            if (r == 0) ssq[eh * 64 + 16 * i + 4 * q8 + j] = ss[j];
        }
        __syncthreads();
        const float* ng = (KIND ? p.gla_ng + hd * 256 : p.hgrn_ng + hd * 128);
        const int ycol = KIND ? 1024 + hd * 256 : hd * 128;
#pragma unroll
        for (int j = 0; j < 4; ++j) {
            const int t = 16 * i + 4 * q8 + j;
            const float rstd = __builtin_amdgcn_rsqf((ssq[t] + ssq[64 + t]) * (1.f / DV) + EPS);
            bf16_t* yp = ycat + (size_t)(tok0 + t) * DM + ycol;
#pragma unroll
            for (int nt = 0; nt < NT; ++nt) { const int e = eh * (DV / 2) + 16 * nt + r;
                const float g = bf2f(graw[j][nt]);
                yp[e] = f2bf(o[nt][j] * rstd * ng[e] * (g * sigmoidf_(g))); }
        }
    }
}

#define XB_TMO      128
#define XB_XCNT(j)  (256  + 64 * (j))
#define XB_XSUB(j)  (1280 + 64 * (j))
#define XB_XGEN(j)  (2304 + 64 * (j))
#define XB_TOP      3328
#define XB_TOPGEN   3392
#define XCD_BAR_WORDS 3456
#define XB_SPIN_CAP (1u << 18)
__device__ __forceinline__ unsigned xb_ld(unsigned* p)              { return __hip_atomic_load(p, __ATOMIC_RELAXED, __HIP_MEMORY_SCOPE_AGENT); }
__device__ __forceinline__ unsigned xb_add(unsigned* p, unsigned v) { return __hip_atomic_fetch_add(p, v, __ATOMIC_RELAXED, __HIP_MEMORY_SCOPE_AGENT); }
__device__ __forceinline__ unsigned xb_xcc_id() { return (unsigned)__builtin_amdgcn_s_getreg((3 << 11) | 20) & 0xFu; }
#define XB_SPIN(cond, bar) do { unsigned _sp = 0; while (cond) { __builtin_amdgcn_s_sleep(1); \
    if ((++_sp & 255u) == 0u) { if (xb_ld(&(bar)[XB_TMO])) break; if (_sp > XB_SPIN_CAP) { atomicAdd(&(bar)[XB_TMO], 1u); break; } } } } while (0)
struct XcdBarrier { unsigned* bar; unsigned x; volatile LAS unsigned* st; };
__device__ __forceinline__ XcdBarrier xcd_barrier_post(unsigned* bar, volatile LAS unsigned* st) {
    XcdBarrier b; b.bar = bar; b.x = xb_xcc_id(); b.st = st;
    if (threadIdx.x == 0) (void)xb_add(&bar[XB_XCNT(b.x)], 1u);
    return b;
}
__device__ __forceinline__ void xcd_barrier_complete(unsigned* bar, unsigned x, unsigned& nloc, unsigned& nx) {
    const unsigned G = gridDim.x * gridDim.y * gridDim.z;
    unsigned sum, cnt, mine, sp = 0u;
    for (;;) {
        sum = 0u; cnt = 0u; mine = 0u;
#pragma unroll
        for (unsigned j = 0; j < 16; ++j) { const unsigned c = xb_ld(&bar[XB_XCNT(j)]); sum += c; cnt += (c > 0u) ? 1u : 0u; mine = (j == x) ? c : mine; }
        if (sum == G) break;
        __builtin_amdgcn_s_sleep(1);
        if ((++sp & 255u) == 0u) { if (xb_ld(&bar[XB_TMO])) break; if (sp > XB_SPIN_CAP) { atomicAdd(&bar[XB_TMO], 1u); break; } }
    }
    nloc = mine > 0u ? mine : 1u; nx = cnt > 0u ? cnt : 1u;
}
__device__ __forceinline__ void xcd_barrier(const XcdBarrier& b) {
    asm volatile("s_waitcnt vmcnt(0)" ::: "memory");
    __syncthreads();
    if (threadIdx.x == 0) {
        unsigned* bar = b.bar;
        __builtin_amdgcn_s_waitcnt(0);
        unsigned nloc = b.st[0], nx = b.st[1];
        if (nloc == 0u) { xcd_barrier_complete(bar, b.x, nloc, nx); b.st[0] = nloc; b.st[1] = nx; }
        const unsigned old = xb_add(&bar[XB_XSUB(b.x)], 1u);
        const unsigned gen = old / nloc;
        if (old + 1u == (gen + 1u) * nloc) {
            __builtin_amdgcn_fence(__ATOMIC_RELEASE, "agent");
            asm volatile("s_waitcnt vmcnt(0)" ::: "memory");
            const unsigned og = xb_add(&bar[XB_TOP], 1u);
            const unsigned tg = og / nx;
            if (og + 1u == (tg + 1u) * nx) xb_add(&bar[XB_TOPGEN], 1u);
            else XB_SPIN(xb_ld(&bar[XB_TOPGEN]) == tg, bar);
            __builtin_amdgcn_fence(__ATOMIC_ACQUIRE, "agent");
            xb_add(&bar[XB_XGEN(b.x)], 1u);
            asm volatile("s_waitcnt vmcnt(0)" ::: "memory");
        } else {
            XB_SPIN(xb_ld(&bar[XB_XGEN(b.x)]) == gen, bar);
            __builtin_amdgcn_fence(__ATOMIC_ACQUIRE, "agent");
            asm volatile("s_waitcnt vmcnt(0)" ::: "memory");
        }
    }
    __syncthreads();
}

__global__ void __launch_bounds__(512, 2) fwd_kernel(Params p) {
    extern __shared__ __attribute__((aligned(16))) unsigned char smem[];
    cg::grid_group grid = cg::this_grid();
    const int tid = threadIdx.x, lane = tid & 63, wave = tid >> 6;
    const int G = gridDim.x, gw = blockIdx.x * 8 + wave, NGW = G * 8;
    unsigned char* ws = p.ws;
    bf16_t* Wout = (bf16_t*)(ws + WS_WOUT); bf16_t* W1t = (bf16_t*)(ws + WS_W1); bf16_t* W2t = (bf16_t*)(ws + WS_W2); bf16_t* Win = (bf16_t*)(ws + WS_WIN);
    bf16_t* U = (bf16_t*)(ws + WS_U); bf16_t* BIG = (bf16_t*)(ws + WS_BIG); bf16_t* YZ = (bf16_t*)(ws + WS_YZ);
    bf16_t* VTE = (bf16_t*)(ws + WS_VT_E); bf16_t* VTO = (bf16_t*)(ws + WS_VT_O); bf16_t* ST = (bf16_t*)(ws + WS_ST); float* DEC = (float*)(ws + WS_DEC);
    float* SS = (float*)(ws + WS_SS); unsigned* PCNT = (unsigned*)(ws + WS_PCNT); bf16_t* YC = (bf16_t*)p.out;
    float* SSH0 = SS; float* SSH1 = SS + NTOK; float* SSH2 = SS + 2 * NTOK; float* SSH3 = SS + 3 * NTOK;
    float* scr = (float*)(smem + wave * 8448);
    LAS unsigned char* lds = (LAS unsigned char*)smem;
    const int lo = p.ph_lo, hi = p.ph_hi;
#define IN(k) (lo <= (k) && (k) < hi)
#define SEAM(k) do { if (IN(k) && IN((k) + 1)) xcd_barrier(xbar); } while (0)
    if (lo < 0) grid.sync();
    volatile LAS unsigned* xst = (volatile LAS unsigned*)(lds + 131072 + 1024);
    if (tid < 4) xst[tid] = 0u;
    __syncthreads();
    XcdBarrier xbar; xbar.bar = (unsigned*)(ws + WS_BAR); xbar.x = 0; xbar.st = xst;
    if (hi - lo > 1) xbar = xcd_barrier_post((unsigned*)(ws + WS_BAR), xst);

    if (IN(0)) {
        cvt_seg(p.even_w_in, DM, 6144, 0, 5120, Win, 0, p.norm_g, scr, gw, NGW, lane);
        cvt_seg(p.even_w_in, DM, 6144, 5120, 1024, Win, 5120, p.norm_g, scr, gw, NGW, lane);
        cvt_seg(p.even_w_out, DM, DM, 0, DM, Wout, 0, nullptr, scr, gw, NGW, lane);
        cvt_seg(p.w1, DM, DFF, 0, DFF, W1t, 0, p.norm_g + 2 * DM, scr, gw, NGW, lane);
        cvt_seg(p.w2, DFF, DM, 0, DM, W2t, 0, nullptr, scr, gw, NGW, lane);
        rowwise<0>(p.x, nullptr, nullptr, U, SSH0, nullptr, gw, NGW, lane);
    }
    SEAM(0);
    if (IN(1)) {
        { pg8::Gemm g{U, Win, NTOK, LDE, DM}; pg8::StaticOrder S; S.init(NTOK, LDE, G, blockIdx.x); pg8::EpiB<0, 1> E{BIG, LDE, SSH0}; pg8::gemm_phase(lds, g, S, E); }
        { pg8::Gemm g{Win + (size_t)5120 * DM, U, 1024, NTOK, DM}; pg8::StaticOrder S; S.init(1024, NTOK, G, blockIdx.x); pg8::EpiB<0, 2> E{VTE, NTOK, SSH0}; pg8::gemm_phase(lds, g, S, E); }
    }
    SEAM(1);
    if (IN(2)) { attn_phase(smem, BIG, VTE, p.rel_bias, p.conv_w, YC); }
    SEAM(2);
    if (IN(3)) { pg8::Gemm g{YC, Wout, NTOK, DM, DM}; pg8::PanelOrder S{(int)blockIdx.x}; pg8::EpiRes<false> E{U, nullptr, p.norm_g + 1 * DM, SS + 4 * NTOK, SSH1, PCNT}; pg8::gemm_phase(lds, g, S, E); }
    SEAM(3);
    if (IN(5)) { pg8::Gemm g{U, W1t, NTOK, DFF, DM}; pg8::StaticOrder S; S.init(NTOK, DFF, G, blockIdx.x); pg8::EpiB<1, 1> E{BIG, DFF, SSH1}; pg8::gemm_phase(lds, g, S, E); }
    SEAM(5);
    if (IN(6)) { pg8::Gemm g{BIG, W2t, NTOK, DM, DFF}; pg8::PanelOrder S{(int)blockIdx.x}; pg8::EpiRes<false> E{U, nullptr, p.norm_g + 3 * DM, SS + 5 * NTOK, SSH2, PCNT + 64}; pg8::gemm_phase(lds, g, S, E); }
    SEAM(6);
    if (IN(7)) {
        const float* wi = p.odd_w_in;
        cvt_seg(wi, DM, 7184, 0, 2048, Win, 0, p.norm_g + 4 * DM, scr, gw, NGW, lane);
        cvt_seg(wi, DM, 7184, 3072, 2048, Win, 2048, p.norm_g + 4 * DM, scr, gw, NGW, lane);
        cvt_seg(wi, DM, 7184, 6144, 1040, Win, 4096, p.norm_g + 4 * DM, scr, gw, NGW, lane);
        cvt_seg(wi, DM, 7184, 2048, 1024, Win, 5376, p.norm_g + 4 * DM, scr, gw, NGW, lane);
        cvt_seg(wi, DM, 7184, 5120, 1024, Win, 6400, p.norm_g + 4 * DM, scr, gw, NGW, lane);
        cvt_seg(p.odd_w_out, DM, DM, 0, DM, Wout, 0, nullptr, scr, gw, NGW, lane);
        cvt_seg(p.w1 + (size_t)DM * DFF, DM, DFF, 0, DFF, W1t, 0, p.norm_g + 6 * DM, scr, gw, NGW, lane);
        cvt_seg(p.w2 + (size_t)DM * DFF, DFF, DM, 0, DM, W2t, 0, nullptr, scr, gw, NGW, lane);
    }
    SEAM(7);
    if (IN(8)) {
        { pg8::Gemm g{U, Win, NTOK, 5120, DM}; pg8::StaticOrder S; S.init(NTOK, 5120, G, blockIdx.x); pg8::EpiB<0, 1> E{BIG, LDO, SSH2}; pg8::gemm_phase(lds, g, S, E); }
        { pg8::Gemm g{Win + (size_t)5376 * DM, U, 2048, NTOK, DM}; pg8::StaticOrder S; S.init(2048, NTOK, G, blockIdx.x); pg8::EpiB<0, 2> E{VTO, NTOK, SSH2}; pg8::gemm_phase(lds, g, S, E); }
        if (wave < 4) {
            const int r = lane & 15, q8 = lane >> 4, t0 = (blockIdx.x * 4 + wave) * 16;
            if (t0 < NTOK) {
                const bf16_t* ap = U + (size_t)(t0 + r) * DM + 8 * q8;
                const bf16_t* bp = Win + (size_t)(5120 + r) * DM + 8 * q8;
                f32x4 acc = (f32x4){0.f, 0.f, 0.f, 0.f};
#pragma unroll 8
                for (int kk = 0; kk < DM / 32; ++kk) { const bf16x8 a = *(const bf16x8*)(ap + 32 * kk), b = *(const bf16x8*)(bp + 32 * kk);
                    acc = __builtin_amdgcn_mfma_f32_16x16x32_bf16(a, b, acc, 0, 0, 0); }
#pragma unroll
                for (int j = 0; j < 4; ++j) BIG[(size_t)(t0 + 4 * q8 + j) * LDO + 5120 + r] = f2bf(acc[j] * __builtin_amdgcn_rsqf(SSH2[t0 + 4 * q8 + j] * (1.f / DM) + EPS));
            }
        }
    }
    SEAM(8);
    if (IN(9)) {
        int par = 0;
        for (int it = blockIdx.x; it < 2048; it += G) { passA_item<0>(p, smem, BIG, VTO, ST, DEC, it, par); par ^= 1; }
        for (int it = blockIdx.x; it < 1024; it += G) { passA_item<1>(p, smem, BIG, VTO, ST, DEC, it, par); par ^= 1; }
    }
    SEAM(9);
    if (IN(10)) scan_phase(ST, DEC);
    SEAM(10);
    if (IN(11)) {
        for (int it = blockIdx.x; it < 2048; it += G) passC_item<0>(p, smem, BIG, VTO, ST, YC, it);
        for (int it = blockIdx.x; it < 1024; it += G) passC_item<1>(p, smem, BIG, VTO, ST, YC, it);
    }
    SEAM(11);
    if (IN(12)) { pg8::Gemm g{YC, Wout, NTOK, DM, DM}; pg8::PanelOrder S{(int)blockIdx.x}; pg8::EpiRes<false> E{U, nullptr, p.norm_g + 5 * DM, SS + 6 * NTOK, SSH3, PCNT + 128}; pg8::gemm_phase(lds, g, S, E); }
    SEAM(12);
    if (IN(14)) { pg8::Gemm g{U, W1t, NTOK, DFF, DM}; pg8::StaticOrder S; S.init(NTOK, DFF, G, blockIdx.x); pg8::EpiB<1, 1> E{BIG, DFF, SSH3}; pg8::gemm_phase(lds, g, S, E); }
    SEAM(14);
    if (IN(15)) { pg8::Gemm g{BIG, W2t, NTOK, DM, DFF}; pg8::PanelOrder S{(int)blockIdx.x}; pg8::EpiRes<true> E{U, p.out, p.norm_g + 7 * DM, SS + 7 * NTOK, nullptr, PCNT + 192}; pg8::gemm_phase(lds, g, S, E); }
#undef IN
#undef SEAM
}

constexpr int NPHASE = 17;

extern "C" void kernel_launch(void* const* d_in, const int* in_sizes, int n_in, void* d_out, int out_size, void* d_ws, size_t ws_size, hipStream_t stream) {
    static int grid = 0;
    if (grid == 0) {
        if (ws_size < WS_END) fprintf(stderr, "kernel_launch: workspace too small: %zu < %zu\n", ws_size, (size_t)WS_END);
        int dev = 0, cus = 0, per_cu = 0;
        hipGetDevice(&dev);
        hipDeviceGetAttribute(&cus, hipDeviceAttributeMultiprocessorCount, dev);
        if (hipFuncSetAttribute((const void*)fwd_kernel, hipFuncAttributeMaxDynamicSharedMemorySize, LDS_BYTES) != hipSuccess) fprintf(stderr, "kernel_launch: hipFuncSetAttribute failed\n");
        if (hipOccupancyMaxActiveBlocksPerMultiprocessor(&per_cu, (const void*)fwd_kernel, 512, LDS_BYTES) != hipSuccess || per_cu < 1) { per_cu = 1; (void)hipGetLastError(); }
        grid = cus * (per_cu > 1 ? 1 : per_cu);
        if (grid <= 0) grid = 256;
    }
    Params p{};
    p.x = (const float*)d_in[0]; p.norm_g = (const float*)d_in[1]; p.even_w_in = (const float*)d_in[2]; p.conv_w = (const float*)d_in[3];
    p.rel_bias = (const float*)d_in[4]; p.even_w_out = (const float*)d_in[5]; p.odd_w_in = (const float*)d_in[6]; p.hgrn_lb = (const float*)d_in[7];
    p.hgrn_ng = (const float*)d_in[8]; p.wa2 = (const float*)d_in[9]; p.ba = (const float*)d_in[10]; p.gla_ng = (const float*)d_in[11];
    p.odd_w_out = (const float*)d_in[12]; p.w1 = (const float*)d_in[13]; p.w2 = (const float*)d_in[14];
    p.out = (float*)d_out; p.ws = (unsigned char*)d_ws;
#if ONE_LAUNCH
    (void)hipMemsetAsync((unsigned char*)d_ws + WS_BAR, 0, WS_ZERO_BYTES, stream);
    p.ph_lo = 0; p.ph_hi = NPHASE;
    void* args[] = {&p};
    hipError_t e = hipLaunchCooperativeKernel((const void*)fwd_kernel, dim3(grid), dim3(512), args, LDS_BYTES, stream);
    if (e != hipSuccess) fprintf(stderr, "cooperative launch failed: %s (grid %d)\n", hipGetErrorString(e), grid);
#else
    for (int k = 0; k < NPHASE; ++k) {
        p.ph_lo = k; p.ph_hi = k + 1;
        hipLaunchKernelGGL(fwd_kernel, dim3(grid), dim3(512), LDS_BYTES, stream, p);
    }
#endif
}
```

```cpp
#include <hip/hip_runtime.h>
#include <hip/hip_cooperative_groups.h>
#include <cstdio>
namespace cg = cooperative_groups;

#ifndef ONE_LAUNCH
#define ONE_LAUNCH 1
#endif

typedef unsigned short bf16_t;
typedef short bf16x8 __attribute__((ext_vector_type(8)));
typedef float f32x4 __attribute__((ext_vector_type(4)));
typedef unsigned u32x4 __attribute__((ext_vector_type(4)));
typedef unsigned u32x2 __attribute__((ext_vector_type(2)));
#define LAS __attribute__((address_space(3)))

constexpr int DM = 2048, NTOK = 16384, SEQ = 4096, DFF = 8192;
constexpr int LDE = 5120;
constexpr int LDO = 5376;
constexpr float EPS = 1e-6f;

constexpr size_t WS_WOUT = 0;
constexpr size_t WS_W1 = 8388608;
constexpr size_t WS_W2 = WS_W1 + 33554432;
constexpr size_t WS_U = WS_W2 + 33554432;
constexpr size_t WS_BIG = WS_U + 67108864;
constexpr size_t WS_WIN = WS_BIG + 268435456;
constexpr size_t WS_YZ = WS_WIN + 30408704;
constexpr size_t WS_VT_E = WS_BIG + (size_t)NTOK * LDE * 2;
constexpr size_t WS_VT_O = WS_BIG + (size_t)NTOK * LDO * 2;
constexpr size_t WS_ST = WS_VT_O + 67108864;
constexpr size_t WS_DEC = WS_ST + 134217728;
constexpr size_t WS_BAR = WS_DEC + 3072 * 128 * 4;
constexpr size_t WS_SS = WS_BAR + 16384;
constexpr size_t WS_PCNT = WS_SS + 8 * 65536;
constexpr size_t WS_END = WS_PCNT + 4096;
constexpr size_t WS_ZERO_BYTES = WS_END - WS_BAR;

constexpr int LDS_BYTES = 131072 + 4096;

__device__ __forceinline__ float bf2f(bf16_t v) { return __uint_as_float(((unsigned)v) << 16); }
typedef float f32x2 __attribute__((ext_vector_type(2)));
typedef __bf16 bf16x2v __attribute__((ext_vector_type(2)));
__device__ __forceinline__ unsigned pk2(float lo, float hi) { f32x2 v = {lo, hi}; bf16x2v b = __builtin_convertvector(v, bf16x2v); return __builtin_bit_cast(unsigned, b); }
__device__ __forceinline__ bf16_t f2bf(float f) { return __builtin_bit_cast(bf16_t, (__bf16)f); }
__device__ __forceinline__ float wave_sum(float v) {
#pragma unroll
    for (int o = 1; o < 64; o <<= 1) v += __shfl_xor(v, o);
    return v;
}
__device__ __forceinline__ float frcp(float x) { return __builtin_amdgcn_rcpf(x); }
__device__ __forceinline__ float sigmoidf_(float x) { return frcp(1.f + __expf(-x)); }
#define LDS_WAIT() asm volatile("s_waitcnt lgkmcnt(0)" ::: "memory")
__device__ __forceinline__ float dpp_f(float v, int ctrl_sel) {
    const int x = __float_as_int(v); int y;
    if (ctrl_sel == 0) y = __builtin_amdgcn_update_dpp(x, x, 0xB1, 0xF, 0xF, false);
    else if (ctrl_sel == 1) y = __builtin_amdgcn_update_dpp(x, x, 0x4E, 0xF, 0xF, false);
    else if (ctrl_sel == 2) y = __builtin_amdgcn_update_dpp(x, x, 0x141, 0xF, 0xF, false);
    else y = __builtin_amdgcn_update_dpp(x, x, 0x140, 0xF, 0xF, false);
    return __int_as_float(y);
}
__device__ __forceinline__ float row16_max(float v) { v = fmaxf(v, dpp_f(v, 0)); v = fmaxf(v, dpp_f(v, 1)); v = fmaxf(v, dpp_f(v, 2)); v = fmaxf(v, dpp_f(v, 3)); return v; }
__device__ __forceinline__ float row16_sum(float v) { v += dpp_f(v, 0); v += dpp_f(v, 1); v += dpp_f(v, 2); v += dpp_f(v, 3); return v; }

namespace pg8 {
constexpr int BM = 256, BK = 64, HALF = 128, HTB = HALF * BK * 2, STAGE_BYTES = 8 * HTB, NXCD = 8, WGM = 8;
__host__ __device__ __forceinline__ int lds_byte(int r, int c) { const int st = (r >> 4) * 2 + (c >> 5), rr = r & 15, cc = c & 31, ob = rr * 64 + cc * 2; return st * 1024 + (ob ^ (((ob >> 9) & 1) << 5)); }
__host__ __device__ __forceinline__ void stage_rc(int b, int& R, int& C) { const int st = b / 1024, sb = b % 1024, swz = sb ^ (((sb >> 9) & 1) << 5); R = (st >> 1) * 16 + swz / 64; C = (st & 1) * 32 + (swz % 64) / 2; }
__host__ __device__ __forceinline__ int perm32(int rho) { const int n = rho >> 4, i = rho & 15; return 8 * (i >> 2) + 4 * n + (i & 3); }
struct Unit { int pm, pn; };
struct Gemm { const bf16_t* A; const bf16_t* Bt; int M, N, K; };
struct StaticOrder {
    int nM, nN, nwg, G, c;
    __device__ void init(int M, int N, int G_, int c_) { nM = M / BM; nN = N / BM; nwg = nM * nN; G = G_; c = c_; }
    __device__ bool next(int i, Unit& u) const {
        const long L = (long)i * G + c; if (L >= nwg) return false;
        int wgid = (int)L; { const int q = nwg / NXCD, r = nwg % NXCD, xcd = wgid % NXCD, off = wgid / NXCD; wgid = (xcd < r ? xcd * (q + 1) : r * (q + 1) + (xcd - r) * q) + off; }
        const int nig = WGM * nN, gid = wgid / nig, fm = gid * WGM, gsz = (nM - fm) < WGM ? (nM - fm) : WGM;
        u.pm = fm + ((wgid % nig) % gsz); u.pn = (wgid % nig) / gsz; return true;
    }
};
template <int ACT, int RS> struct EpiB {
    static constexpr bool PERM = true;
    bf16_t* O; int ldc; const float* rs;
    __device__ __forceinline__ void load_rs(const Unit& u, int wr, int fr, float (&rsv)[8]) const {
        if (RS == 1) {
#pragma unroll
            for (int q = 0; q < 8; ++q) rsv[q] = __builtin_amdgcn_rsqf(rs[u.pm * BM + wr * 64 + fr + (q >> 2) * HALF + (q & 3) * 16] * (1.f / 2048.f) + 1e-6f); }
    }
    __device__ __forceinline__ void operator()(const f32x4 (&acc)[2][2][4][2], const Unit& u, int wr, int wc, int fr, int fq, const float (&rsv)[8]) const {
        const int row0 = u.pm * BM + wr * 64 + fr, col0 = u.pn * BM + wc * 32 + 8 * fq;
        f32x4 cs[2][2];
        if (RS == 2) {
#pragma unroll
            for (int bj = 0; bj < 2; ++bj) { cs[bj][0] = *(const f32x4*)(rs + col0 + bj * HALF); cs[bj][1] = *(const f32x4*)(rs + col0 + bj * HALF + 4);
#pragma unroll
                for (int e = 0; e < 4; ++e) { cs[bj][0][e] = __builtin_amdgcn_rsqf(cs[bj][0][e] * (1.f / 2048.f) + 1e-6f); cs[bj][1][e] = __builtin_amdgcn_rsqf(cs[bj][1][e] * (1.f / 2048.f) + 1e-6f); } } }
#pragma unroll
        for (int ai = 0; ai < 2; ++ai)
#pragma unroll
            for (int m = 0; m < 4; ++m) { const int row = row0 + ai * HALF + m * 16; bf16_t* rowp = O + (size_t)row * ldc + col0;
                float rsc = 1.f; if (RS == 1) rsc = rsv[ai * 4 + m];
#pragma unroll
                for (int bj = 0; bj < 2; ++bj) { f32x4 v0 = acc[ai][bj][m][0], v1 = acc[ai][bj][m][1];
                    if (RS == 1) { v0 *= rsc; v1 *= rsc; }
                    if (RS == 2) { v0 *= cs[bj][0]; v1 *= cs[bj][1]; }
                    if (ACT == 1) {
#pragma unroll
                        for (int j = 0; j < 4; ++j) { float a = fmaxf(v0[j], 0.f), b = fmaxf(v1[j], 0.f); v0[j] = a * a; v1[j] = b * b; } }
                    u32x4 w; w.x = pk2(v0[0], v0[1]); w.y = pk2(v0[2], v0[3]); w.z = pk2(v1[0], v1[1]); w.w = pk2(v1[2], v1[3]);
                    *(u32x4*)(rowp + bj * HALF) = w; } }
    }
};

struct PanelOrder {
    int c;
    __device__ bool next(int i, Unit& u) const { if (i >= 2) return false; const int x = c & 7, k = c >> 3; u.pm = i * 32 + x * 4 + (k >> 3); u.pn = k & 7; return true; }
};
template <bool FINAL> struct EpiRes {
    static constexpr bool PERM = true;
    bf16_t* hb; float* out; const float* g1; float* ssY; float* ssH; unsigned* cnt;
    __device__ __forceinline__ void load_rs(const Unit&, int, int, float (&)[8]) const {}
    __device__ __forceinline__ void operator()(const f32x4 (&acc)[2][2][4][2], const Unit& u, int wr, int wc, int fr, int fq, const float (&)[8]) const {
        const int row0 = u.pm * BM + wr * 64 + fr, col0 = u.pn * BM + wc * 32 + 8 * fq;
#pragma unroll
        for (int q = 0; q < 8; ++q) { const int ai = q >> 2, m = q & 3; float sq = 0.f;
#pragma unroll
            for (int bj = 0; bj < 2; ++bj)
#pragma unroll
                for (int n = 0; n < 2; ++n)
#pragma unroll
                    for (int e = 0; e < 4; ++e) sq += acc[ai][bj][m][n][e] * acc[ai][bj][m][n][e];
            sq += __shfl_xor(sq, 16); sq += __shfl_xor(sq, 32);
            if (fq == 0) (void)__hip_atomic_fetch_add(ssY + row0 + ai * HALF + m * 16, sq, __ATOMIC_RELAXED, __HIP_MEMORY_SCOPE_AGENT); }
        asm volatile("s_waitcnt vmcnt(0)" ::: "memory");
        __builtin_amdgcn_s_barrier();
        if (threadIdx.x == 0) {
            (void)__hip_atomic_fetch_add(cnt + u.pm, 1u, __ATOMIC_RELAXED, __HIP_MEMORY_SCOPE_AGENT);
            unsigned sp = 0;
            while (__hip_atomic_load(cnt + u.pm, __ATOMIC_RELAXED, __HIP_MEMORY_SCOPE_AGENT) < 8u) { __builtin_amdgcn_s_sleep(1); if (++sp > (1u << 22)) break; }
        }
        asm volatile("" ::: "memory");
        __builtin_amdgcn_s_barrier();
        asm volatile("" ::: "memory");
        f32x4 gv[2][2];
#pragma unroll
        for (int bj = 0; bj < 2; ++bj) { gv[bj][0] = *(const f32x4*)(g1 + col0 + bj * HALF); gv[bj][1] = *(const f32x4*)(g1 + col0 + bj * HALF + 4); }
#pragma unroll
        for (int q = 0; q < 8; ++q) { const int ai = q >> 2, m = q & 3, row = row0 + ai * HALF + m * 16;
            const float rs1 = __builtin_amdgcn_rsqf(__hip_atomic_load(ssY + row, __ATOMIC_RELAXED, __HIP_MEMORY_SCOPE_AGENT) * (1.f / 2048.f) + 1e-6f);
            bf16_t* rowp = hb + (size_t)row * 2048 + col0; float s2 = 0.f;
#pragma unroll
            for (int bj = 0; bj < 2; ++bj) { const u32x4 hw = *(const u32x4*)(rowp + bj * HALF);
                f32x4 h0, h1;
                h0[0] = __uint_as_float(hw[0] << 16); h0[1] = __uint_as_float(hw[0] & 0xffff0000u); h0[2] = __uint_as_float(hw[1] << 16); h0[3] = __uint_as_float(hw[1] & 0xffff0000u);
                h1[0] = __uint_as_float(hw[2] << 16); h1[1] = __uint_as_float(hw[2] & 0xffff0000u); h1[2] = __uint_as_float(hw[3] << 16); h1[3] = __uint_as_float(hw[3] & 0xffff0000u);
                h0 += acc[ai][bj][m][0] * rs1 * gv[bj][0]; h1 += acc[ai][bj][m][1] * rs1 * gv[bj][1];
                if (FINAL) { float* op = out + (size_t)row * 2048 + col0 + bj * HALF; *(f32x4*)op = h0; *(f32x4*)(op + 4) = h1; }
                else {
#pragma unroll
                    for (int e = 0; e < 4; ++e) s2 += h0[e] * h0[e] + h1[e] * h1[e];
                    u32x4 w; w.x = pk2(h0[0], h0[1]); w.y = pk2(h0[2], h0[3]); w.z = pk2(h1[0], h1[1]); w.w = pk2(h1[2], h1[3]);
                    *(u32x4*)(rowp + bj * HALF) = w; } }
            if (!FINAL) { s2 += __shfl_xor(s2, 16); s2 += __shfl_xor(s2, 32);
                if (fq == 0) (void)__hip_atomic_fetch_add(ssH + row, s2, __ATOMIC_RELAXED, __HIP_MEMORY_SCOPE_AGENT); } }
    }
};

template <class Epi, class Sched>
__device__ __forceinline__ void gemm_phase(LAS unsigned char* lds, const Gemm g, const Sched& S, const Epi& E) {
    const int tid = threadIdx.x, wid = __builtin_amdgcn_readfirstlane(tid >> 6), lane = tid & 63, wr = wid >> 2, wc = wid & 3, fr = lane & 15, fq = lane >> 4;
    const int K = g.K, nt = K / BK;
    unsigned voffA[2], voffB[2];
#pragma unroll
    for (int i = 0; i < 2; ++i) { int R, C; stage_rc(tid * 16 + i * 8192, R, C); const int Rb = Epi::PERM ? ((R & ~31) + perm32(R & 31)) : R;
        voffA[i] = (unsigned)(R * K + C) * 2u; voffB[i] = (unsigned)(Rb * K + C) * 2u; }
    const size_t kstep = (size_t)(BK * 2);
    const size_t hstep = (size_t)HALF * K * 2;
    const size_t tstep = 2 * hstep;
    const unsigned ldsw = (unsigned)wid * 1024u;
    const int aoff = lds_byte(wr * 64 + fr, fq * 8), boff = lds_byte(wc * 32 + fr, fq * 8);
#define PG8_SA(b, h) (((b) * 2 + (h)) * HTB)
#define PG8_SB(b, h) ((4 + (b) * 2 + (h)) * HTB)
#define PG8_STAGE(bufoff, gbase, voff) do { _Pragma("unroll") for (int _i = 0; _i < 2; ++_i) \
        __builtin_amdgcn_global_load_lds((const unsigned*)((const char*)(gbase) + (voff)[_i]), (LAS unsigned*)(lds + (bufoff) + ldsw + _i * 8192), 16, 0, 0); } while (0)
#define PG8_LDA(dst, b, h) do { _Pragma("unroll") for (int m = 0; m < 4; ++m) _Pragma("unroll") for (int k = 0; k < 2; ++k) dst[m][k] = *(const LAS bf16x8*)(lds + PG8_SA(b, h) + aoff + m * 2048 + k * 1024); } while (0)
#define PG8_LDB(dst, b, h) do { _Pragma("unroll") for (int n = 0; n < 2; ++n) _Pragma("unroll") for (int k = 0; k < 2; ++k) dst[n][k] = *(const LAS bf16x8*)(lds + PG8_SB(b, h) + boff + n * 2048 + k * 1024); } while (0)
#define PG8_MMA(ai, bj, At, Bt) do { __builtin_amdgcn_s_setprio(1); _Pragma("unroll") for (int m = 0; m < 4; ++m) _Pragma("unroll") for (int n = 0; n < 2; ++n) _Pragma("unroll") for (int k = 0; k < 2; ++k) \
        acc[ai][bj][m][n] = __builtin_amdgcn_mfma_f32_16x16x32_bf16(Bt[n][k], At[m][k], acc[ai][bj][m][n], 0, 0, 0); __builtin_amdgcn_s_setprio(0); } while (0)
#define PG8_WAIT_V(n) asm volatile("s_waitcnt vmcnt(" #n ")" ::: "memory")
#define PG8_WAIT_L(n) asm volatile("s_waitcnt lgkmcnt(" #n ")" ::: "memory")
#define PG8_BAR __builtin_amdgcn_s_barrier()
#define PG8_SCHED __builtin_amdgcn_sched_barrier(0)
    Unit cur, nxt; int ui = 0;
    if (!S.next(0, cur)) return;
    f32x4 acc[2][2][4][2];
#pragma unroll
    for (int a = 0; a < 2; ++a)
#pragma unroll
        for (int b = 0; b < 2; ++b)
#pragma unroll
            for (int m = 0; m < 4; ++m)
#pragma unroll
                for (int n = 0; n < 2; ++n) acc[a][b][m][n] = (f32x4){0.f, 0.f, 0.f, 0.f};
    bf16x8 At[4][2], B0[2][2], B1[2][2];
    const char* cA = (const char*)g.A + (size_t)cur.pm * tstep; const char* cB = (const char*)g.Bt + (size_t)cur.pn * tstep;
    float rsv[8] = {1.f, 1.f, 1.f, 1.f, 1.f, 1.f, 1.f, 1.f};
    E.load_rs(cur, wr, fr, rsv);
    PG8_STAGE(PG8_SB(0, 0), cB, voffB); PG8_STAGE(PG8_SB(0, 1), cB + hstep, voffB); PG8_STAGE(PG8_SA(0, 0), cA, voffA); PG8_STAGE(PG8_SA(0, 1), cA + hstep, voffA);
    if (wr == 1) PG8_BAR;
    PG8_WAIT_V(2); PG8_BAR;
    PG8_STAGE(PG8_SB(1, 0), cB + kstep, voffB); PG8_STAGE(PG8_SA(1, 0), cA + kstep, voffA); PG8_STAGE(PG8_SB(1, 1), cB + hstep + kstep, voffB);
    PG8_WAIT_V(6); PG8_BAR;
    for (;;) {
        const bool has_next = S.next(ui + 1, nxt);
        const char* nA = has_next ? (const char*)g.A + (size_t)nxt.pm * tstep : cA; const char* nB = has_next ? (const char*)g.Bt + (size_t)nxt.pn * tstep : cB;
        for (int t = 0; t < nt; t += 2) {
            const bool last = (t == nt - 2);
            const char* a1 = cA + (size_t)(t + 1) * kstep;
            const char* a2 = last ? nA : cA + (size_t)(t + 2) * kstep; const char* b2 = last ? nB : cB + (size_t)(t + 2) * kstep;
            const char* a3 = a2 + kstep; const char* b3 = b2 + kstep;
            PG8_LDB(B0, 0, 0); PG8_LDB(B1, 0, 1); PG8_SCHED; PG8_LDA(At, 0, 0); PG8_STAGE(PG8_SA(1, 1), a1 + hstep, voffA);
            PG8_WAIT_V(8); PG8_WAIT_L(0); PG8_BAR; PG8_MMA(0, 0, At, B0); PG8_MMA(0, 1, At, B1); PG8_BAR; PG8_SCHED;
            PG8_LDA(At, 0, 1); PG8_STAGE(PG8_SB(0, 0), b2, voffB); PG8_STAGE(PG8_SB(0, 1), b2 + hstep, voffB); PG8_STAGE(PG8_SA(0, 0), a2, voffA);
            PG8_WAIT_V(8); PG8_WAIT_L(0); PG8_BAR; PG8_MMA(1, 0, At, B0); PG8_MMA(1, 1, At, B1); PG8_BAR; PG8_SCHED;
            PG8_LDB(B0, 1, 0); PG8_LDB(B1, 1, 1); PG8_SCHED; PG8_LDA(At, 1, 0); PG8_STAGE(PG8_SA(0, 1), a2 + hstep, voffA);
            PG8_WAIT_V(8); PG8_WAIT_L(0); PG8_BAR; PG8_MMA(0, 0, At, B0); PG8_MMA(0, 1, At, B1); PG8_BAR; PG8_SCHED;
            PG8_LDA(At, 1, 1); PG8_STAGE(PG8_SB(1, 0), b3, voffB); PG8_STAGE(PG8_SB(1, 1), b3 + hstep, voffB); PG8_STAGE(PG8_SA(1, 0), a3, voffA);
            PG8_WAIT_V(8); PG8_WAIT_L(0); PG8_BAR; PG8_MMA(1, 0, At, B0); PG8_MMA(1, 1, At, B1); PG8_BAR; PG8_SCHED;
        }
        if (wr == 0) PG8_BAR;
        E(acc, cur, wr, wc, fr, fq, rsv);
        if (!has_next) break;
        E.load_rs(nxt, wr, fr, rsv);
#pragma unroll
        for (int a = 0; a < 2; ++a)
#pragma unroll
            for (int b = 0; b < 2; ++b)
#pragma unroll
                for (int m = 0; m < 4; ++m)
#pragma unroll
                    for (int n = 0; n < 2; ++n) acc[a][b][m][n] = (f32x4){0.f, 0.f, 0.f, 0.f};
        cur = nxt; cA = nA; cB = nB; ++ui;
        if (wr == 1) PG8_BAR;
    }
    PG8_WAIT_V(0);
    PG8_BAR;
#undef PG8_SA
#undef PG8_SB
#undef PG8_STAGE
#undef PG8_LDA
#undef PG8_LDB
#undef PG8_MMA
#undef PG8_WAIT_V
#undef PG8_WAIT_L
#undef PG8_BAR
#undef PG8_SCHED
}
}

struct Params {
    const float* x; const float* norm_g; const float* even_w_in; const float* conv_w; const float* rel_bias; const float* even_w_out;
    const float* odd_w_in; const float* hgrn_lb; const float* hgrn_ng; const float* wa2; const float* ba; const float* gla_ng; const float* odd_w_out;
    const float* w1; const float* w2; float* out; unsigned char* ws; int ph_lo, ph_hi;
};

__device__ __forceinline__ void cvt_seg(const float* __restrict__ W, int K, int NS, int c0, int nc, bf16_t* __restrict__ WT, int r0, const float* __restrict__ gf, float* scr, int gw, int NGW, int lane) {
    const int nblk = (nc + 31) >> 5, nitems = (K >> 6) * nblk;
    const int krow = lane >> 3, c4 = (lane & 7) * 4;
    for (int it = gw; it < nitems; it += NGW) {
        const int kb = it / nblk, nb = it - kb * nblk, k0 = kb * 64, n0 = nb * 32;
        const bool ok = (n0 + c4) < nc;
        const float* src = W + (size_t)(k0 + krow) * NS + c0 + n0 + c4;
        f32x4 v[8];
#pragma unroll
        for (int i = 0; i < 8; ++i) v[i] = ok ? *(const f32x4*)(src + (size_t)(8 * i) * NS) : (f32x4){0.f, 0.f, 0.f, 0.f};
        if (gf) {
#pragma unroll
            for (int i = 0; i < 8; ++i) v[i] *= gf[k0 + 8 * i + krow]; }
#pragma unroll
        for (int i = 0; i < 8; ++i) { float* d = scr + (8 * i + krow) * 33 + c4; d[0] = v[i][0]; d[1] = v[i][1]; d[2] = v[i][2]; d[3] = v[i][3]; }
        LDS_WAIT();
        const int c = lane & 7;
#pragma unroll
        for (int j = 0; j < 4; ++j) { const int n = (lane >> 3) + 8 * j; const float* s = scr + (8 * c) * 33 + n;
            u32x4 o; o.x = pk2(s[0], s[33]); o.y = pk2(s[66], s[99]); o.z = pk2(s[132], s[165]); o.w = pk2(s[198], s[231]);
            if (n0 + n < nc) *(u32x4*)(WT + (size_t)(r0 + n0 + n) * K + k0 + 8 * c) = o; }
        LDS_WAIT();
    }
}

template <int MODE>
__device__ __forceinline__ void rowwise(const float* __restrict__ xin, const bf16_t* __restrict__ ysrc, const float* __restrict__ g1,
                                        bf16_t* hb, float* __restrict__ rsout, float* __restrict__ out, int gw, int NGW, int lane) {
    for (int row0 = gw; row0 < NTOK; row0 += 2 * NGW) {
        f32x4 h[2][4][2]; u32x4 yw[2][4], hw[2][4];
#pragma unroll
        for (int rr = 0; rr < 2; ++rr) { const size_t rb = (size_t)(row0 + rr * NGW) * DM;
#pragma unroll
            for (int j = 0; j < 4; ++j) { const int col = 512 * j + 8 * lane;
                if (MODE == 0) { h[rr][j][0] = *(const f32x4*)(xin + rb + col); h[rr][j][1] = *(const f32x4*)(xin + rb + col + 4); }
                else { hw[rr][j] = *(const u32x4*)(hb + rb + col); yw[rr][j] = *(const u32x4*)(ysrc + rb + col); } } }
#pragma unroll
        for (int rr = 0; rr < 2; ++rr) {
            const int row = row0 + rr * NGW; const size_t rb = (size_t)row * DM;
            if (MODE != 0) {
                float y[4][8]; float ss = 0.f;
#pragma unroll
                for (int j = 0; j < 4; ++j) {
#pragma unroll
                    for (int e = 0; e < 4; ++e) { y[j][2 * e] = __uint_as_float(yw[rr][j][e] << 16); y[j][2 * e + 1] = __uint_as_float(yw[rr][j][e] & 0xffff0000u);
                        h[rr][j][e >> 1][(2 * e) & 3] = __uint_as_float(hw[rr][j][e] << 16); h[rr][j][e >> 1][(2 * e + 1) & 3] = __uint_as_float(hw[rr][j][e] & 0xffff0000u); }
#pragma unroll
                    for (int e = 0; e < 8; ++e) ss += y[j][e] * y[j][e]; }
                const float rs = rsqrtf(wave_sum(ss) * (1.f / DM) + EPS);
#pragma unroll
                for (int j = 0; j < 4; ++j) { const int col = 512 * j + 8 * lane; const f32x4 ga = *(const f32x4*)(g1 + col), gb = *(const f32x4*)(g1 + col + 4);
#pragma unroll
                    for (int e = 0; e < 4; ++e) { h[rr][j][0][e] += y[j][e] * rs * ga[e]; h[rr][j][1][e] += y[j][4 + e] * rs * gb[e]; }
                    if (MODE == 2) { *(f32x4*)(out + rb + col) = h[rr][j][0]; *(f32x4*)(out + rb + col + 4) = h[rr][j][1]; } }
            }
            if (MODE != 2) {
                float ss = 0.f;
#pragma unroll
                for (int j = 0; j < 4; ++j)
#pragma unroll
                    for (int e = 0; e < 4; ++e) ss += h[rr][j][0][e] * h[rr][j][0][e] + h[rr][j][1][e] * h[rr][j][1][e];
                const float sst = wave_sum(ss);
                if (lane == 0) rsout[row] = sst;
#pragma unroll
                for (int j = 0; j < 4; ++j) { const int col = 512 * j + 8 * lane;
                    u32x4 o; o.x = pk2(h[rr][j][0][0], h[rr][j][0][1]); o.y = pk2(h[rr][j][0][2], h[rr][j][0][3]);
                    o.z = pk2(h[rr][j][1][0], h[rr][j][1][1]); o.w = pk2(h[rr][j][1][2], h[rr][j][1][3]);
                    *(u32x4*)(hb + rb + col) = o; }
            }
        }
    }
}

__device__ __forceinline__ void conv_phase(const bf16_t* __restrict__ P, const float* __restrict__ cw, bf16_t* __restrict__ ycat) {
    const int nthr = gridDim.x * 512;
#pragma unroll 2
    for (int it = blockIdx.x * 512 + threadIdx.x; it < NTOK * 128; it += nthr) {
        const int t = it >> 7, c0 = (it & 127) * 8, tp = t & (SEQ - 1);
        const bf16_t* row = P + (size_t)t * LDE + c0;
        const u32x4 bg = *(const u32x4*)(row), c2 = *(const u32x4*)(row + 1024), h2 = *(const u32x4*)(row + 2048);
        u32x4 c1 = (u32x4){0, 0, 0, 0}, h1 = c1, cz = c1, hz = c1;
        if (tp >= 1) { c1 = *(const u32x4*)(row - LDE + 1024); h1 = *(const u32x4*)(row - LDE + 2048); }
        if (tp >= 2) { cz = *(const u32x4*)(row - 2 * LDE + 1024); hz = *(const u32x4*)(row - 2 * LDE + 2048); }
        float o[8];
#pragma unroll
        for (int e = 0; e < 8; ++e) {
            const int sh = (e & 1) ? 0 : 16; const int w = e >> 1;
            auto get = [&](const u32x4& v) { return __uint_as_float((v[w] << sh) & 0xffff0000u); };
            const float u2 = get(c2) * get(h2), u1 = get(c1) * get(h1), u0 = get(cz) * get(hz);
            const float y = cw[c0 + e] * u0 + cw[1024 + c0 + e] * u1 + cw[2048 + c0 + e] * u2;
            o[e] = get(bg) * y;
        }
        u32x4 w; w.x = pk2(o[0], o[1]); w.y = pk2(o[2], o[3]); w.z = pk2(o[4], o[5]); w.w = pk2(o[6], o[7]);
        *(u32x4*)(ycat + (size_t)t * DM + c0) = w;
    }
}

__device__ __forceinline__ void attn_phase(unsigned char* smem, const bf16_t* __restrict__ P, const bf16_t* __restrict__ VT, const float* __restrict__ relb, bf16_t* __restrict__ ycat) {
    const int tid = threadIdx.x, lane = tid & 63, wave = tid >> 6, half = wave >> 2, w4 = wave & 3, ltid = tid & 255, r = lane & 15, q8 = lane >> 4;
    unsigned char* base = smem + half * 47616;
    bf16_t* kS = (bf16_t*)base;
    bf16_t* vS = (bf16_t*)(base + 17408);
    bf16_t* pS = (bf16_t*)(base + 35840);
    float* bS = (float*)(base + 45056);
    const float scale = 0.08838834764831845f * 1.4426950408889634f;
    for (int pair = blockIdx.x; pair < 1024; pair += gridDim.x) {
        const int hp = pair & 3, n = (pair >> 2) & 63, b = pair >> 8, head = hp * 2 + half;
        const int tok0 = b * SEQ + n * 64;
        __syncthreads();
        for (int i = ltid; i < 640; i += 256) bS[i] = relb[head * 320 + (i < 319 ? i : 319)] * 1.4426950408889634f;
        bf16x8 qf[4];
        { const bf16_t* qp = P + (size_t)(tok0 + 16 * w4 + r) * LDE + 3072 + head * 128 + 8 * q8;
#pragma unroll
          for (int kk = 0; kk < 4; ++kk) qf[kk] = *(const bf16x8*)(qp + 32 * kk); }
        float m[4], l[4]; f32x4 o[8];
#pragma unroll
        for (int j = 0; j < 4; ++j) { m[j] = -1e30f; l[j] = 0.f; }
#pragma unroll
        for (int i = 0; i < 8; ++i) o[i] = (f32x4){0.f, 0.f, 0.f, 0.f};
        const int js0 = (n < 8 ? 8 - n : 0);
        u32x4 kreg[4], vreg[4];
        { const int ktok0 = tok0 + (js0 - 8) * 64;
#pragma unroll
          for (int i = 0; i < 4; ++i) { const int ch = ltid + 256 * i;
              kreg[i] = *(const u32x4*)(P + (size_t)(ktok0 + (ch >> 4)) * LDE + 4096 + head * 128 + (ch & 15) * 8);
              vreg[i] = *(const u32x4*)(VT + (size_t)(head * 128 + (ch >> 3)) * NTOK + ktok0 + (ch & 7) * 8); } }
        for (int js = js0; js <= 8; ++js) {
            __syncthreads();
#pragma unroll
            for (int i = 0; i < 4; ++i) { const int ch = ltid + 256 * i;
                *(u32x4*)(kS + (ch >> 4) * 136 + (ch & 15) * 8) = kreg[i];
                *(u32x4*)(vS + (ch >> 3) * 72 + (ch & 7) * 8) = vreg[i]; }
            __syncthreads();
            if (js < 8) { const int ktok0 = tok0 + (js + 1 - 8) * 64;
#pragma unroll
                for (int i = 0; i < 4; ++i) { const int ch = ltid + 256 * i;
                    kreg[i] = *(const u32x4*)(P + (size_t)(ktok0 + (ch >> 4)) * LDE + 4096 + head * 128 + (ch & 15) * 8);
                    vreg[i] = *(const u32x4*)(VT + (size_t)(head * 128 + (ch >> 3)) * NTOK + ktok0 + (ch & 7) * 8); } }
            f32x4 s[4];
#pragma unroll
            for (int nt = 0; nt < 4; ++nt) { s[nt] = (f32x4){0.f, 0.f, 0.f, 0.f};
#pragma unroll
                for (int kk = 0; kk < 4; ++kk) { const bf16x8 kf = *(const bf16x8*)(kS + (16 * nt + r) * 136 + 32 * kk + 8 * q8);
                    s[nt] = __builtin_amdgcn_mfma_f32_16x16x32_bf16(qf[kk], kf, s[nt], 0, 0, 0); } }
            float alpha[4];
            const float* bT = bS + (16 * w4 + 4 * q8 - r + 63 + (8 - js) * 64);
#pragma unroll
            for (int j = 0; j < 4; ++j) {
                float mx = -1e30f;
#pragma unroll
                for (int nt = 0; nt < 4; ++nt) { const float v = s[nt][j] * scale + bT[j - 16 * nt]; s[nt][j] = v; mx = fmaxf(mx, v); }
                mx = row16_max(mx);
                const float mn = fmaxf(m[j], mx); alpha[j] = __builtin_amdgcn_exp2f(m[j] - mn); m[j] = mn;
                float ps = 0.f;
#pragma unroll
                for (int nt = 0; nt < 4; ++nt) { const float pp = __builtin_amdgcn_exp2f(s[nt][j] - mn); ps += pp; pS[(16 * w4 + 4 * q8 + j) * 72 + 16 * nt + r] = f2bf(pp); }
                l[j] = l[j] * alpha[j] + ps;
            }
#pragma unroll
            for (int i = 0; i < 8; ++i)
#pragma unroll
                for (int j = 0; j < 4; ++j) o[i][j] *= alpha[j];
            LDS_WAIT();
#pragma unroll
            for (int kk = 0; kk < 2; ++kk) { const bf16x8 pf = *(const bf16x8*)(pS + (16 * w4 + r) * 72 + 32 * kk + 8 * q8);
#pragma unroll
                for (int i = 0; i < 8; ++i) { const bf16x8 vf = *(const bf16x8*)(vS + (16 * i + r) * 72 + 32 * kk + 8 * q8);
                    o[i] = __builtin_amdgcn_mfma_f32_16x16x32_bf16(pf, vf, o[i], 0, 0, 0); } }
        }
#pragma unroll
        for (int j = 0; j < 4; ++j) { float lt = l[j];
#pragma unroll
            for (int ofs = 1; ofs < 16; ofs <<= 1) lt += __shfl_xor(lt, ofs);
            const float inv = frcp(lt);
            bf16_t* op = ycat + (size_t)(tok0 + 16 * w4 + 4 * q8 + j) * DM + 1024 + head * 128 + r;
#pragma unroll
            for (int i = 0; i < 8; ++i) op[16 * i] = f2bf(o[i][j] * inv); }
    }
}

template <int KIND, bool WANT_Q>
__device__ __forceinline__ void decay_qk(const Params& p, const bf16_t* __restrict__ P, int tok0, int hd, int d, int tq, float (&bl)[16], float (&kv)[16], float (&qv)[16], const bf16_t (&ra)[16], const bf16_t (&rq)[16]) {
    const int col = hd * 128 + d;
    const bf16_t* rp = P + (size_t)(tok0 + 16 * tq) * LDO;
    if (KIND == 0) {
        const float lb = frcp(1.f + __expf(p.hgrn_lb[col] - p.hgrn_lb[1024 + col]));
        float run = 0.f;
#pragma unroll
        for (int jj = 0; jj < 16; ++jj) {
            const float fr = bf2f(ra[jj]);
            const float f = lb + (1.f - lb) * sigmoidf_(fr);
            run += __logf(f); bl[jj] = run; kv[jj] = 1.f - f;
            if (WANT_Q) { const float qr = bf2f(rq[jj]); qv[jj] = qr * sigmoidf_(qr); }
        }
    } else {
        float w[16];
#pragma unroll
        for (int rr = 0; rr < 16; ++rr) w[rr] = p.wa2[rr * 512 + col];
        const float bias = p.ba[col];
        float run = 0.f;
#pragma unroll
        for (int jj = 0; jj < 16; ++jj) {
            const u32x4 g0 = *(const u32x4*)(rp + (size_t)jj * LDO + 5120), g1 = *(const u32x4*)(rp + (size_t)jj * LDO + 5128);
            float xx = bias;
#pragma unroll
            for (int e = 0; e < 4; ++e) {
                xx += __uint_as_float(g0[e] << 16) * w[2 * e] + __uint_as_float(g0[e] & 0xffff0000u) * w[2 * e + 1];
                xx += __uint_as_float(g1[e] << 16) * w[8 + 2 * e] + __uint_as_float(g1[e] & 0xffff0000u) * w[8 + 2 * e + 1];
            }
            const float ls = fminf(xx, 0.f) - __logf(1.f + __expf(-fabsf(xx)));
            run += ls * (1.f / 16.f); bl[jj] = run;
            kv[jj] = bf2f(ra[jj]);
            if (WANT_Q) qv[jj] = bf2f(rq[jj]) * 0.08838834764831845f;
        }
    }
}

template <int KIND, bool WANT_Q>
__device__ __forceinline__ void load_raw(const bf16_t* __restrict__ P, const bf16_t* __restrict__ VT, int idx, bf16_t (&ra)[16], bf16_t (&rq)[16], u32x4 (&vr)[KIND ? 4 : 2]) {
    constexpr int DV = KIND ? 256 : 128;
    const int tid = threadIdx.x, d = tid & 127, tq = tid >> 7;
    const int c = idx & 63, bh = idx >> 6, hd = KIND ? (bh & 3) : (bh & 7), b = KIND ? (bh >> 2) : (bh >> 3);
    const int tok0 = b * SEQ + c * 64, col = hd * 128 + d;
    const bf16_t* rp = P + (size_t)(tok0 + 16 * tq) * LDO;
#pragma unroll
    for (int jj = 0; jj < 16; ++jj) { ra[jj] = rp[(size_t)jj * LDO + (KIND ? 3584 : 1024) + col]; if (WANT_Q) rq[jj] = rp[(size_t)jj * LDO + (KIND ? 3072 : 0) + col]; }
    const bf16_t* vsrc = VT + (size_t)((KIND ? 1024 + hd * 256 : hd * 128)) * NTOK + tok0;
#pragma unroll
    for (int i = 0; i < DV / 64; ++i) { const int ch = tid + 512 * i, row = ch >> 3, c8 = ch & 7; vr[i] = *(const u32x4*)(vsrc + (size_t)row * NTOK + c8 * 8); }
}

template <int KIND>
__device__ __forceinline__ void passA_item(const Params& p, unsigned char* smem_base, const bf16_t* __restrict__ P, const bf16_t* __restrict__ VT, bf16_t* __restrict__ ST, float* __restrict__ DEC, int idx, int par, int nidx, bf16_t (&ra)[16], bf16_t (&rq)[16], u32x4 (&vr)[KIND ? 4 : 2]) {
    unsigned char* smem = smem_base + par * 57344;
    constexpr int DV = KIND ? 256 : 128;
    const int tid = threadIdx.x, lane = tid & 63, wave = tid >> 6, r = lane & 15, q8 = lane >> 4, d = tid & 127, tq = tid >> 7;
    const int c = idx & 63, bh = idx >> 6, hd = KIND ? (bh & 3) : (bh & 7), b = KIND ? (bh >> 2) : (bh >> 3);
    const int tok0 = b * SEQ + c * 64;
    bf16_t* kT = (bf16_t*)smem;
    bf16_t* vS = (bf16_t*)(smem + 18432);
    float* tot = (float*)(smem + 18432 + 36864);
    float bl[16], kv[16], qv[16];
    decay_qk<KIND, false>(p, P, tok0, hd, d, tq, bl, kv, qv, ra, rq);
    tot[tq * 128 + d] = bl[15];
#pragma unroll
    for (int i = 0; i < DV / 64; ++i) { const int ch = tid + 512 * i, row = ch >> 3, c8 = ch & 7; *(u32x4*)(vS + row * 72 + c8 * 8) = vr[i]; }
    __syncthreads();
    if (nidx >= 0) load_raw<KIND, false>(P, VT, nidx, ra, rq, vr);
    const float t0 = tot[d], t1 = tot[128 + d], t2 = tot[256 + d], t3 = tot[384 + d];
    const float r4 = t0 + t1 + t2 + t3;
    const float rpre = (tq > 0 ? t0 : 0.f) + (tq > 1 ? t1 : 0.f) + (tq > 2 ? t2 : 0.f);
    {
        float kt[16];
#pragma unroll
        for (int jj = 0; jj < 16; ++jj) kt[jj] = kv[jj] * __expf(r4 - rpre - bl[jj]);
        u32x4 w0, w1;
        w0.x = pk2(kt[0], kt[1]); w0.y = pk2(kt[2], kt[3]); w0.z = pk2(kt[4], kt[5]); w0.w = pk2(kt[6], kt[7]);
        w1.x = pk2(kt[8], kt[9]); w1.y = pk2(kt[10], kt[11]); w1.z = pk2(kt[12], kt[13]); w1.w = pk2(kt[14], kt[15]);
        *(u32x4*)(kT + d * 72 + 16 * tq) = w0; *(u32x4*)(kT + d * 72 + 16 * tq + 8) = w1;
    }
    const int gitem = (KIND ? 2048 : 0) + idx;
    if (tq == 0) DEC[(size_t)gitem * 128 + d] = __expf(r4);
    __syncthreads();
    const int d0 = 16 * wave;
    bf16x8 af[2];
#pragma unroll
    for (int kk = 0; kk < 2; ++kk) af[kk] = *(const bf16x8*)(kT + (d0 + r) * 72 + 32 * kk + 8 * q8);
    bf16_t* stb = ST + (KIND ? (size_t)33554432 : 0) + (size_t)idx * (DV * 128);
#pragma unroll
    for (int nt = 0; nt < DV / 16; ++nt) {
        f32x4 acc = (f32x4){0.f, 0.f, 0.f, 0.f};
#pragma unroll
        for (int kk = 0; kk < 2; ++kk) { const bf16x8 bfr = *(const bf16x8*)(vS + (16 * nt + r) * 72 + 32 * kk + 8 * q8);
            acc = __builtin_amdgcn_mfma_f32_16x16x32_bf16(af[kk], bfr, acc, 0, 0, 0); }
        u32x2 w; w.x = pk2(acc[0], acc[1]); w.y = pk2(acc[2], acc[3]);
        *(u32x2*)(stb + (size_t)(16 * nt + r) * 128 + d0 + 4 * q8) = w;
    }
}

__device__ __forceinline__ void scan_phase(bf16_t* __restrict__ ST, const float* __restrict__ DEC) {
    const int nthr = gridDim.x * 512;
    for (int gid = blockIdx.x * 512 + threadIdx.x; gid < 131072; gid += nthr) {
        const int kind = gid >> 16, v = gid & 65535;
        const int vper = kind ? 4096 : 2048, bh = v / vper, vi = v - bh * vper, d0 = (vi * 8) & 127;
        const size_t csz = kind ? 32768 : 16384;
        bf16_t* sp = ST + (kind ? (size_t)33554432 : 0) + (size_t)bh * 64 * csz + (size_t)vi * 8;
        const float* dp = DEC + (size_t)((kind ? 2048 : 0) + bh * 64) * 128 + d0;
        float S[8];
#pragma unroll
        for (int e = 0; e < 8; ++e) S[e] = 0.f;
#pragma unroll 8
        for (int c = 0; c < 64; ++c) {
            const u32x4 u = *(const u32x4*)(sp + (size_t)c * csz);
            const f32x4 da = *(const f32x4*)(dp + c * 128), db = *(const f32x4*)(dp + c * 128 + 4);
            u32x4 w; w.x = pk2(S[0], S[1]); w.y = pk2(S[2], S[3]); w.z = pk2(S[4], S[5]); w.w = pk2(S[6], S[7]);
            *(u32x4*)(sp + (size_t)c * csz) = w;
#pragma unroll
            for (int e = 0; e < 4; ++e) {
                S[2 * e] = S[2 * e] * (e < 2 ? da[2 * e] : db[2 * e - 4]) + __uint_as_float(u[e] << 16);
                S[2 * e + 1] = S[2 * e + 1] * (e < 2 ? da[2 * e + 1] : db[2 * e - 3]) + __uint_as_float(u[e] & 0xffff0000u);
            }
        }
    }
}

template <int KIND>
__device__ __forceinline__ void passC_item(const Params& p, unsigned char* smem, const bf16_t* __restrict__ P, const bf16_t* __restrict__ VT, const bf16_t* __restrict__ ST, bf16_t* __restrict__ ycat, int idx, int nidx, bf16_t (&ra)[16], bf16_t (&rq)[16], u32x4 (&vr)[KIND ? 4 : 2]) {
    constexpr int DV = KIND ? 256 : 128;
    const int tid = threadIdx.x, lane = tid & 63, wave = tid >> 6, r = lane & 15, q8 = lane >> 4, d = tid & 127, tq = tid >> 7;
    const int c = idx & 63, bh = idx >> 6, hd = KIND ? (bh & 3) : (bh & 7), b = KIND ? (bh >> 2) : (bh >> 3);
    const int tok0 = b * SEQ + c * 64;
    bf16_t* qs = (bf16_t*)smem;
    bf16_t* qh = (bf16_t*)(smem + 17408);
    bf16_t* ks = (bf16_t*)(smem + 34816);
    bf16_t* vS = (bf16_t*)(smem + 78336);
    bf16_t* pS = (bf16_t*)(smem + 115200);
    float* tot = (float*)(smem + 124416);
    float* ssq = (float*)(smem + 126464);
    float bl[16], kv[16], qv[16];
    decay_qk<KIND, true>(p, P, tok0, hd, d, tq, bl, kv, qv, ra, rq);
    tot[tq * 128 + d] = bl[15];
#pragma unroll
    for (int i = 0; i < DV / 64; ++i) { const int ch = tid + 512 * i, row = ch >> 3, c8 = ch & 7; *(u32x4*)(vS + row * 72 + c8 * 8) = vr[i]; }
    for (int i = tid; i < 64 * 72 / 8; i += 512) *(u32x4*)(pS + i * 8) = (u32x4){0, 0, 0, 0};
    __syncthreads();
    if (nidx >= 0) load_raw<KIND, true>(P, VT, nidx, ra, rq, vr);
    constexpr int NT = DV / 32;
    constexpr int NPRE = 4;
    const int oi = wave & 3, oeh = wave >> 2;
    const bf16_t* stb = ST + (KIND ? (size_t)33554432 : 0) + (size_t)idx * (DV * 128);
    const int gcol = KIND ? 4096 + hd * 256 : 2048 + hd * 128;
    bf16x8 bst[NPRE][4];
#pragma unroll
    for (int nt = 0; nt < NPRE; ++nt)
#pragma unroll
        for (int kk = 0; kk < 4; ++kk) bst[nt][kk] = *(const bf16x8*)(stb + (size_t)(oeh * (DV / 2) + 16 * nt + r) * 128 + 32 * kk + 8 * q8);
    bf16_t graw[4][NT];
#pragma unroll
    for (int j = 0; j < 4; ++j)
#pragma unroll
        for (int nt = 0; nt < NT; ++nt) graw[j][nt] = P[(size_t)(tok0 + 16 * oi + 4 * q8 + j) * LDO + gcol + oeh * (DV / 2) + 16 * nt + r];
    {
        const float t0 = tot[d], t1 = tot[128 + d], t2 = tot[256 + d];
        const float rpre = (tq > 0 ? t0 : 0.f) + (tq > 1 ? t1 : 0.f) + (tq > 2 ? t2 : 0.f);
        const float Ttq = bl[15], rn = rpre + Ttq;
        const float einv = __expf(fminf(-Ttq, 80.f));
        const float f1 = (tq == 1) ? einv : __expf(fminf(t0 - rn, 0.f));
        const float f2 = (tq == 2) ? einv : __expf(fminf(t0 + t1 - rn, 0.f));
        const float f3 = (tq == 3) ? einv : __expf(fminf(t0 + t1 + t2 - rn, 0.f));
        const float erp = __expf(rpre);
#pragma unroll
        for (int jj = 0; jj < 16; ++jj) {
            const int t = 16 * tq + jj;
            const float ql = qv[jj] * __expf(bl[jj]);
            qs[t * 136 + d] = f2bf(ql);
            qh[t * 136 + d] = f2bf(ql * erp);
            const float kb = kv[jj] * __expf(Ttq - bl[jj]);
            if (tq == 0) ks[(0 + t) * 136 + d] = f2bf(kb * einv);
            if (tq <= 1) ks[(16 + t) * 136 + d] = f2bf(kb * f1);
            if (tq <= 2) ks[(48 + t) * 136 + d] = f2bf(kb * f2);
            ks[(96 + t) * 136 + d] = f2bf(kb * f3);
        }
    }
    __syncthreads();
    {
        const int i = wave >> 1, off = 8 * i * (i + 1);
        bf16x8 af[4];
#pragma unroll
        for (int kk = 0; kk < 4; ++kk) af[kk] = *(const bf16x8*)(qs + (16 * i + r) * 136 + 32 * kk + 8 * q8);
        for (int jt = (wave & 1); jt <= i; jt += 2) {
            f32x4 acc = (f32x4){0.f, 0.f, 0.f, 0.f};
#pragma unroll
            for (int kk = 0; kk < 4; ++kk) { const bf16x8 bfr = *(const bf16x8*)(ks + (off + 16 * jt + r) * 136 + 32 * kk + 8 * q8);
                acc = __builtin_amdgcn_mfma_f32_16x16x32_bf16(af[kk], bfr, acc, 0, 0, 0); }
#pragma unroll
            for (int j = 0; j < 4; ++j) { float v = acc[j]; if (jt == i && r > 4 * q8 + j) v = 0.f;
                pS[(16 * i + 4 * q8 + j) * 72 + 16 * jt + r] = f2bf(v); }
        }
    }
    __syncthreads();
    {
        const int i = oi, eh = oeh;
        bf16x8 ap[2], aq[4];
#pragma unroll
        for (int kk = 0; kk < 2; ++kk) ap[kk] = *(const bf16x8*)(pS + (16 * i + r) * 72 + 32 * kk + 8 * q8);
#pragma unroll
        for (int kk = 0; kk < 4; ++kk) aq[kk] = *(const bf16x8*)(qh + (16 * i + r) * 136 + 32 * kk + 8 * q8);
        f32x4 o[NT];
        float ss[4] = {0.f, 0.f, 0.f, 0.f};
#pragma unroll
        for (int nt = 0; nt < NT; ++nt) {
            const int e0 = eh * (DV / 2) + 16 * nt;
            f32x4 acc = (f32x4){0.f, 0.f, 0.f, 0.f};
#pragma unroll
            for (int kk = 0; kk < 2; ++kk) { const bf16x8 bfr = *(const bf16x8*)(vS + (e0 + r) * 72 + 32 * kk + 8 * q8);
                acc = __builtin_amdgcn_mfma_f32_16x16x32_bf16(ap[kk], bfr, acc, 0, 0, 0); }
#pragma unroll
            for (int kk = 0; kk < 4; ++kk) { bf16x8 bfr;
                if (nt < NPRE) bfr = bst[nt < NPRE ? nt : 0][kk]; else bfr = *(const bf16x8*)(stb + (size_t)(e0 + r) * 128 + 32 * kk + 8 * q8);
                acc = __builtin_amdgcn_mfma_f32_16x16x32_bf16(aq[kk], bfr, acc, 0, 0, 0); }
            o[nt] = acc;
#pragma unroll
            for (int j = 0; j < 4; ++j) ss[j] += acc[j] * acc[j];
        }
#pragma unroll
        for (int j = 0; j < 4; ++j) {
#pragma unroll
            for (int ofs = 1; ofs < 16; ofs <<= 1) ss[j] += __shfl_xor(ss[j], ofs);
            if (r == 0) ssq[eh * 64 + 16 * i + 4 * q8 + j] = ss[j];
        }
        __syncthreads();
        const float* ng = (KIND ? p.gla_ng + hd * 256 : p.hgrn_ng + hd * 128);
        const int ycol = KIND ? 1024 + hd * 256 : hd * 128;
#pragma unroll
        for (int j = 0; j < 4; ++j) {
            const int t = 16 * i + 4 * q8 + j;
            const float rstd = __builtin_amdgcn_rsqf((ssq[t] + ssq[64 + t]) * (1.f / DV) + EPS);
            bf16_t* yp = ycat + (size_t)(tok0 + t) * DM + ycol;
#pragma unroll
            for (int nt = 0; nt < NT; ++nt) { const int e = eh * (DV / 2) + 16 * nt + r;
                const float g = bf2f(graw[j][nt]);
                yp[e] = f2bf(o[nt][j] * rstd * ng[e] * (g * sigmoidf_(g))); }
        }
    }
}

#define XB_TMO      128
#define XB_XCNT(j)  (256  + 64 * (j))
#define XB_XSUB(j)  (1280 + 64 * (j))
#define XB_XGEN(j)  (2304 + 64 * (j))
#define XB_TOP      3328
#define XB_TOPGEN   3392
#define XCD_BAR_WORDS 3456
#define XB_SPIN_CAP (1u << 18)
__device__ __forceinline__ unsigned xb_ld(unsigned* p)              { return __hip_atomic_load(p, __ATOMIC_RELAXED, __HIP_MEMORY_SCOPE_AGENT); }
__device__ __forceinline__ unsigned xb_add(unsigned* p, unsigned v) { return __hip_atomic_fetch_add(p, v, __ATOMIC_RELAXED, __HIP_MEMORY_SCOPE_AGENT); }
__device__ __forceinline__ unsigned xb_xcc_id() { return (unsigned)__builtin_amdgcn_s_getreg((3 << 11) | 20) & 0xFu; }
#define XB_SPIN(cond, bar) do { unsigned _sp = 0; while (cond) { __builtin_amdgcn_s_sleep(1); \
    if ((++_sp & 255u) == 0u) { if (xb_ld(&(bar)[XB_TMO])) break; if (_sp > XB_SPIN_CAP) { atomicAdd(&(bar)[XB_TMO], 1u); break; } } } } while (0)
struct XcdBarrier { unsigned* bar; unsigned x; volatile LAS unsigned* st; };
__device__ __forceinline__ XcdBarrier xcd_barrier_post(unsigned* bar, volatile LAS unsigned* st) {
    XcdBarrier b; b.bar = bar; b.x = xb_xcc_id(); b.st = st;
    if (threadIdx.x == 0) (void)xb_add(&bar[XB_XCNT(b.x)], 1u);
    return b;
}
__device__ __forceinline__ void xcd_barrier_complete(unsigned* bar, unsigned x, unsigned& nloc, unsigned& nx) {
    const unsigned G = gridDim.x * gridDim.y * gridDim.z;
    unsigned sum, cnt, mine, sp = 0u;
    for (;;) {
        sum = 0u; cnt = 0u; mine = 0u;
#pragma unroll
        for (unsigned j = 0; j < 16; ++j) { const unsigned c = xb_ld(&bar[XB_XCNT(j)]); sum += c; cnt += (c > 0u) ? 1u : 0u; mine = (j == x) ? c : mine; }
        if (sum == G) break;
        __builtin_amdgcn_s_sleep(1);
        if ((++sp & 255u) == 0u) { if (xb_ld(&bar[XB_TMO])) break; if (sp > XB_SPIN_CAP) { atomicAdd(&bar[XB_TMO], 1u); break; } }
    }
    nloc = mine > 0u ? mine : 1u; nx = cnt > 0u ? cnt : 1u;
}
__device__ __forceinline__ void xcd_barrier(const XcdBarrier& b) {
    asm volatile("s_waitcnt vmcnt(0)" ::: "memory");
    __syncthreads();
    if (threadIdx.x == 0) {
        unsigned* bar = b.bar;
        __builtin_amdgcn_s_waitcnt(0);
        unsigned nloc = b.st[0], nx = b.st[1];
        if (nloc == 0u) { xcd_barrier_complete(bar, b.x, nloc, nx); b.st[0] = nloc; b.st[1] = nx; }
        const unsigned old = xb_add(&bar[XB_XSUB(b.x)], 1u);
        const unsigned gen = old / nloc;
        if (old + 1u == (gen + 1u) * nloc) {
            __builtin_amdgcn_fence(__ATOMIC_RELEASE, "agent");
            asm volatile("s_waitcnt vmcnt(0)" ::: "memory");
            const unsigned og = xb_add(&bar[XB_TOP], 1u);
            const unsigned tg = og / nx;
            if (og + 1u == (tg + 1u) * nx) xb_add(&bar[XB_TOPGEN], 1u);
            else XB_SPIN(xb_ld(&bar[XB_TOPGEN]) == tg, bar);
            __builtin_amdgcn_fence(__ATOMIC_ACQUIRE, "agent");
            xb_add(&bar[XB_XGEN(b.x)], 1u);
            asm volatile("s_waitcnt vmcnt(0)" ::: "memory");
        } else {
            XB_SPIN(xb_ld(&bar[XB_XGEN(b.x)]) == gen, bar);
            __builtin_amdgcn_fence(__ATOMIC_ACQUIRE, "agent");
            asm volatile("s_waitcnt vmcnt(0)" ::: "memory");
        }
    }
    __syncthreads();
}

__global__ void __launch_bounds__(512, 2) fwd_kernel(Params p) {
    extern __shared__ __attribute__((aligned(16))) unsigned char smem[];
    cg::grid_group grid = cg::this_grid();
    const int tid = threadIdx.x, lane = tid & 63, wave = tid >> 6;
    const int G = gridDim.x, gw = blockIdx.x * 8 + wave, NGW = G * 8;
    unsigned char* ws = p.ws;
    bf16_t* Wout = (bf16_t*)(ws + WS_WOUT); bf16_t* W1t = (bf16_t*)(ws + WS_W1); bf16_t* W2t = (bf16_t*)(ws + WS_W2); bf16_t* Win = (bf16_t*)(ws + WS_WIN);
    bf16_t* U = (bf16_t*)(ws + WS_U); bf16_t* BIG = (bf16_t*)(ws + WS_BIG); bf16_t* YZ = (bf16_t*)(ws + WS_YZ);
    bf16_t* VTE = (bf16_t*)(ws + WS_VT_E); bf16_t* VTO = (bf16_t*)(ws + WS_VT_O); bf16_t* ST = (bf16_t*)(ws + WS_ST); float* DEC = (float*)(ws + WS_DEC);
    float* SS = (float*)(ws + WS_SS); unsigned* PCNT = (unsigned*)(ws + WS_PCNT); bf16_t* YC = (bf16_t*)p.out;
    float* SSH0 = SS; float* SSH1 = SS + NTOK; float* SSH2 = SS + 2 * NTOK; float* SSH3 = SS + 3 * NTOK;
    float* scr = (float*)(smem + wave * 8448);
    LAS unsigned char* lds = (LAS unsigned char*)smem;
    const int lo = p.ph_lo, hi = p.ph_hi;
#define IN(k) (lo <= (k) && (k) < hi)
#define SEAM(k) do { if (IN(k) && IN((k) + 1)) xcd_barrier(xbar); } while (0)
    if (lo < 0) grid.sync();
    volatile LAS unsigned* xst = (volatile LAS unsigned*)(lds + 131072 + 1024);
    if (tid < 4) xst[tid] = 0u;
    __syncthreads();
    XcdBarrier xbar; xbar.bar = (unsigned*)(ws + WS_BAR); xbar.x = 0; xbar.st = xst;
    if (hi - lo > 1) xbar = xcd_barrier_post((unsigned*)(ws + WS_BAR), xst);

    if (IN(0)) {
        cvt_seg(p.even_w_in, DM, 6144, 0, 5120, Win, 0, p.norm_g, scr, gw, NGW, lane);
        cvt_seg(p.even_w_in, DM, 6144, 5120, 1024, Win, 5120, p.norm_g, scr, gw, NGW, lane);
        cvt_seg(p.even_w_out, DM, DM, 0, DM, Wout, 0, nullptr, scr, gw, NGW, lane);
        cvt_seg(p.w1, DM, DFF, 0, DFF, W1t, 0, p.norm_g + 2 * DM, scr, gw, NGW, lane);
        cvt_seg(p.w2, DFF, DM, 0, DM, W2t, 0, nullptr, scr, gw, NGW, lane);
        rowwise<0>(p.x, nullptr, nullptr, U, SSH0, nullptr, gw, NGW, lane);
    }
    SEAM(0);
    if (IN(1)) {
        { pg8::Gemm g{U, Win, NTOK, LDE, DM}; pg8::StaticOrder S; S.init(NTOK, LDE, G, blockIdx.x); pg8::EpiB<0, 1> E{BIG, LDE, SSH0}; pg8::gemm_phase(lds, g, S, E); }
        { pg8::Gemm g{Win + (size_t)5120 * DM, U, 1024, NTOK, DM}; pg8::StaticOrder S; S.init(1024, NTOK, G, blockIdx.x); pg8::EpiB<0, 2> E{VTE, NTOK, SSH0}; pg8::gemm_phase(lds, g, S, E); }
    }
    SEAM(1);
    if (IN(2)) { conv_phase(BIG, p.conv_w, YC); attn_phase(smem, BIG, VTE, p.rel_bias, YC); }
    SEAM(2);
    if (IN(3)) { pg8::Gemm g{YC, Wout, NTOK, DM, DM}; pg8::PanelOrder S{(int)blockIdx.x}; pg8::EpiRes<false> E{U, nullptr, p.norm_g + 1 * DM, SS + 4 * NTOK, SSH1, PCNT}; pg8::gemm_phase(lds, g, S, E); }
    SEAM(3);
    if (IN(5)) { pg8::Gemm g{U, W1t, NTOK, DFF, DM}; pg8::StaticOrder S; S.init(NTOK, DFF, G, blockIdx.x); pg8::EpiB<1, 1> E{BIG, DFF, SSH1}; pg8::gemm_phase(lds, g, S, E); }
    SEAM(5);
    if (IN(6)) { pg8::Gemm g{BIG, W2t, NTOK, DM, DFF}; pg8::PanelOrder S{(int)blockIdx.x}; pg8::EpiRes<false> E{U, nullptr, p.norm_g + 3 * DM, SS + 5 * NTOK, SSH2, PCNT + 64}; pg8::gemm_phase(lds, g, S, E); }
    SEAM(6);
    if (IN(7)) {
        const float* wi = p.odd_w_in;
        cvt_seg(wi, DM, 7184, 0, 2048, Win, 0, p.norm_g + 4 * DM, scr, gw, NGW, lane);
        cvt_seg(wi, DM, 7184, 3072, 2048, Win, 2048, p.norm_g + 4 * DM, scr, gw, NGW, lane);
        cvt_seg(wi, DM, 7184, 6144, 1040, Win, 4096, p.norm_g + 4 * DM, scr, gw, NGW, lane);
        cvt_seg(wi, DM, 7184, 2048, 1024, Win, 5376, p.norm_g + 4 * DM, scr, gw, NGW, lane);
        cvt_seg(wi, DM, 7184, 5120, 1024, Win, 6400, p.norm_g + 4 * DM, scr, gw, NGW, lane);
        cvt_seg(p.odd_w_out, DM, DM, 0, DM, Wout, 0, nullptr, scr, gw, NGW, lane);
        cvt_seg(p.w1 + (size_t)DM * DFF, DM, DFF, 0, DFF, W1t, 0, p.norm_g + 6 * DM, scr, gw, NGW, lane);
        cvt_seg(p.w2 + (size_t)DM * DFF, DFF, DM, 0, DM, W2t, 0, nullptr, scr, gw, NGW, lane);
    }
    SEAM(7);
    if (IN(8)) {
        { pg8::Gemm g{U, Win, NTOK, 5120, DM}; pg8::StaticOrder S; S.init(NTOK, 5120, G, blockIdx.x); pg8::EpiB<0, 1> E{BIG, LDO, SSH2}; pg8::gemm_phase(lds, g, S, E); }
        { pg8::Gemm g{Win + (size_t)5376 * DM, U, 2048, NTOK, DM}; pg8::StaticOrder S; S.init(2048, NTOK, G, blockIdx.x); pg8::EpiB<0, 2> E{VTO, NTOK, SSH2}; pg8::gemm_phase(lds, g, S, E); }
        if (wave < 4) {
            const int r = lane & 15, q8 = lane >> 4, t0 = (blockIdx.x * 4 + wave) * 16;
            if (t0 < NTOK) {
                const bf16_t* ap = U + (size_t)(t0 + r) * DM + 8 * q8;
                const bf16_t* bp = Win + (size_t)(5120 + r) * DM + 8 * q8;
                f32x4 acc = (f32x4){0.f, 0.f, 0.f, 0.f};
#pragma unroll 8
                for (int kk = 0; kk < DM / 32; ++kk) { const bf16x8 a = *(const bf16x8*)(ap + 32 * kk), b = *(const bf16x8*)(bp + 32 * kk);
                    acc = __builtin_amdgcn_mfma_f32_16x16x32_bf16(a, b, acc, 0, 0, 0); }
#pragma unroll
                for (int j = 0; j < 4; ++j) BIG[(size_t)(t0 + 4 * q8 + j) * LDO + 5120 + r] = f2bf(acc[j] * __builtin_amdgcn_rsqf(SSH2[t0 + 4 * q8 + j] * (1.f / DM) + EPS));
            }
        }
    }
    SEAM(8);
    if (IN(9)) {
        int par = 0;
        { bf16_t ra[16], rq[16]; u32x4 vr[2]; load_raw<0, false>(BIG, VTO, blockIdx.x, ra, rq, vr);
          for (int it = blockIdx.x; it < 2048; it += G) { passA_item<0>(p, smem, BIG, VTO, ST, DEC, it, par, (it + G < 2048) ? it + G : -1, ra, rq, vr); par ^= 1; } }
        { bf16_t ra[16], rq[16]; u32x4 vr[4]; load_raw<1, false>(BIG, VTO, blockIdx.x, ra, rq, vr);
          for (int it = blockIdx.x; it < 1024; it += G) { passA_item<1>(p, smem, BIG, VTO, ST, DEC, it, par, (it + G < 1024) ? it + G : -1, ra, rq, vr); par ^= 1; } }
    }
    SEAM(9);
    if (IN(10)) scan_phase(ST, DEC);
    SEAM(10);
    if (IN(11)) {
        { bf16_t ra[16], rq[16]; u32x4 vr[2]; load_raw<0, true>(BIG, VTO, blockIdx.x, ra, rq, vr);
          for (int it = blockIdx.x; it < 2048; it += G) passC_item<0>(p, smem, BIG, VTO, ST, YC, it, (it + G < 2048) ? it + G : -1, ra, rq, vr); }
        { bf16_t ra[16], rq[16]; u32x4 vr[4]; load_raw<1, true>(BIG, VTO, blockIdx.x, ra, rq, vr);
          for (int it = blockIdx.x; it < 1024; it += G) passC_item<1>(p, smem, BIG, VTO, ST, YC, it, (it + G < 1024) ? it + G : -1, ra, rq, vr); }
    }
    SEAM(11);
    if (IN(12)) { pg8::Gemm g{YC, Wout, NTOK, DM, DM}; pg8::PanelOrder S{(int)blockIdx.x}; pg8::EpiRes<false> E{U, nullptr, p.norm_g + 5 * DM, SS + 6 * NTOK, SSH3, PCNT + 128}; pg8::gemm_phase(lds, g, S, E); }
    SEAM(12);
    if (IN(14)) { pg8::Gemm g{U, W1t, NTOK, DFF, DM}; pg8::StaticOrder S; S.init(NTOK, DFF, G, blockIdx.x); pg8::EpiB<1, 1> E{BIG, DFF, SSH3}; pg8::gemm_phase(lds, g, S, E); }
    SEAM(14);
    if (IN(15)) { pg8::Gemm g{BIG, W2t, NTOK, DM, DFF}; pg8::PanelOrder S{(int)blockIdx.x}; pg8::EpiRes<true> E{U, p.out, p.norm_g + 7 * DM, SS + 7 * NTOK, nullptr, PCNT + 192}; pg8::gemm_phase(lds, g, S, E); }
#undef IN
#undef SEAM
}

constexpr int NPHASE = 17;

extern "C" void kernel_launch(void* const* d_in, const int* in_sizes, int n_in, void* d_out, int out_size, void* d_ws, size_t ws_size, hipStream_t stream) {
    static int grid = 0;
    if (grid == 0) {
        if (ws_size < WS_END) fprintf(stderr, "kernel_launch: workspace too small: %zu < %zu\n", ws_size, (size_t)WS_END);
        int dev = 0, cus = 0, per_cu = 0;
        hipGetDevice(&dev);
        hipDeviceGetAttribute(&cus, hipDeviceAttributeMultiprocessorCount, dev);
        if (hipFuncSetAttribute((const void*)fwd_kernel, hipFuncAttributeMaxDynamicSharedMemorySize, LDS_BYTES) != hipSuccess) fprintf(stderr, "kernel_launch: hipFuncSetAttribute failed\n");
        if (hipOccupancyMaxActiveBlocksPerMultiprocessor(&per_cu, (const void*)fwd_kernel, 512, LDS_BYTES) != hipSuccess || per_cu < 1) { per_cu = 1; (void)hipGetLastError(); }
        grid = cus * (per_cu > 1 ? 1 : per_cu);
        if (grid <= 0) grid = 256;
    }
    Params p{};
    p.x = (const float*)d_in[0]; p.norm_g = (const float*)d_in[1]; p.even_w_in = (const float*)d_in[2]; p.conv_w = (const float*)d_in[3];
    p.rel_bias = (const float*)d_in[4]; p.even_w_out = (const float*)d_in[5]; p.odd_w_in = (const float*)d_in[6]; p.hgrn_lb = (const float*)d_in[7];
    p.hgrn_ng = (const float*)d_in[8]; p.wa2 = (const float*)d_in[9]; p.ba = (const float*)d_in[10]; p.gla_ng = (const float*)d_in[11];
    p.odd_w_out = (const float*)d_in[12]; p.w1 = (const float*)d_in[13]; p.w2 = (const float*)d_in[14];
    p.out = (float*)d_out; p.ws = (unsigned char*)d_ws;
#if ONE_LAUNCH
    (void)hipMemsetAsync((unsigned char*)d_ws + WS_BAR, 0, WS_ZERO_BYTES, stream);
    p.ph_lo = 0; p.ph_hi = NPHASE;
    void* args[] = {&p};
    hipError_t e = hipLaunchCooperativeKernel((const void*)fwd_kernel, dim3(grid), dim3(512), args, LDS_BYTES, stream);
    if (e != hipSuccess) fprintf(stderr, "cooperative launch failed: %s (grid %d)\n", hipGetErrorString(e), grid);
#else
    for (int k = 0; k < NPHASE; ++k) {
        p.ph_lo = k; p.ph_hi = k + 1;
        hipLaunchKernelGGL(fwd_kernel, dim3(grid), dim3(512), LDS_BYTES, stream, p);
    }
#endif
}
```

```cpp
#include <hip/hip_runtime.h>
#include <hip/hip_cooperative_groups.h>
#include <cstdio>
namespace cg = cooperative_groups;

#ifndef ONE_LAUNCH
#define ONE_LAUNCH 1
#endif

typedef unsigned short bf16_t;
typedef short bf16x8 __attribute__((ext_vector_type(8)));
typedef float f32x4 __attribute__((ext_vector_type(4)));
typedef unsigned u32x4 __attribute__((ext_vector_type(4)));
typedef unsigned u32x2 __attribute__((ext_vector_type(2)));
#define LAS __attribute__((address_space(3)))

constexpr int DM = 2048, NTOK = 16384, SEQ = 4096, DFF = 8192;
constexpr int LDE = 5120;
constexpr int LDO = 5376;
constexpr float EPS = 1e-6f;

constexpr size_t WS_WOUT = 0;
constexpr size_t WS_W1 = 8388608;
constexpr size_t WS_W2 = WS_W1 + 33554432;
constexpr size_t WS_U = WS_W2 + 33554432;
constexpr size_t WS_BIG = WS_U + 67108864;
constexpr size_t WS_WIN = WS_BIG + 268435456;
constexpr size_t WS_YZ = WS_WIN + 30408704;
constexpr size_t WS_VT_E = WS_BIG + (size_t)NTOK * LDE * 2;
constexpr size_t WS_VT_O = WS_BIG + (size_t)NTOK * LDO * 2;
constexpr size_t WS_ST = WS_VT_O + 67108864;
constexpr size_t WS_DEC = WS_ST + 134217728;
constexpr size_t WS_BAR = WS_DEC + 3072 * 128 * 4;
constexpr size_t WS_SS = WS_BAR + 16384;
constexpr size_t WS_PCNT = WS_SS + 8 * 65536;
constexpr size_t WS_END = WS_PCNT + 4096;
constexpr size_t WS_ZERO_BYTES = WS_END - WS_BAR;

constexpr int LDS_BYTES = 131072 + 4096;

__device__ __forceinline__ float bf2f(bf16_t v) { return __uint_as_float(((unsigned)v) << 16); }
typedef float f32x2 __attribute__((ext_vector_type(2)));
typedef __bf16 bf16x2v __attribute__((ext_vector_type(2)));
__device__ __forceinline__ unsigned pk2(float lo, float hi) { f32x2 v = {lo, hi}; bf16x2v b = __builtin_convertvector(v, bf16x2v); return __builtin_bit_cast(unsigned, b); }
__device__ __forceinline__ bf16_t f2bf(float f) { return __builtin_bit_cast(bf16_t, (__bf16)f); }
__device__ __forceinline__ float wave_sum(float v) {
#pragma unroll
    for (int o = 1; o < 64; o <<= 1) v += __shfl_xor(v, o);
    return v;
}
__device__ __forceinline__ float frcp(float x) { return __builtin_amdgcn_rcpf(x); }
__device__ __forceinline__ float sigmoidf_(float x) { return frcp(1.f + __expf(-x)); }
#define LDS_WAIT() asm volatile("s_waitcnt lgkmcnt(0)" ::: "memory")
__device__ __forceinline__ float dpp_f(float v, int ctrl_sel) {
    const int x = __float_as_int(v); int y;
    if (ctrl_sel == 0) y = __builtin_amdgcn_update_dpp(x, x, 0xB1, 0xF, 0xF, false);
    else if (ctrl_sel == 1) y = __builtin_amdgcn_update_dpp(x, x, 0x4E, 0xF, 0xF, false);
    else if (ctrl_sel == 2) y = __builtin_amdgcn_update_dpp(x, x, 0x141, 0xF, 0xF, false);
    else y = __builtin_amdgcn_update_dpp(x, x, 0x140, 0xF, 0xF, false);
    return __int_as_float(y);
}
__device__ __forceinline__ float row16_max(float v) { v = fmaxf(v, dpp_f(v, 0)); v = fmaxf(v, dpp_f(v, 1)); v = fmaxf(v, dpp_f(v, 2)); v = fmaxf(v, dpp_f(v, 3)); return v; }
__device__ __forceinline__ float row16_sum(float v) { v += dpp_f(v, 0); v += dpp_f(v, 1); v += dpp_f(v, 2); v += dpp_f(v, 3); return v; }

namespace pg8 {
constexpr int BM = 256, BK = 64, HALF = 128, HTB = HALF * BK * 2, STAGE_BYTES = 8 * HTB, NXCD = 8, WGM = 8;
__host__ __device__ __forceinline__ int lds_byte(int r, int c) { const int st = (r >> 4) * 2 + (c >> 5), rr = r & 15, cc = c & 31, ob = rr * 64 + cc * 2; return st * 1024 + (ob ^ (((ob >> 9) & 1) << 5)); }
__host__ __device__ __forceinline__ void stage_rc(int b, int& R, int& C) { const int st = b / 1024, sb = b % 1024, swz = sb ^ (((sb >> 9) & 1) << 5); R = (st >> 1) * 16 + swz / 64; C = (st & 1) * 32 + (swz % 64) / 2; }
__host__ __device__ __forceinline__ int perm32(int rho) { const int n = rho >> 4, i = rho & 15; return 8 * (i >> 2) + 4 * n + (i & 3); }
struct Unit { int pm, pn; };
struct Gemm { const bf16_t* A; const bf16_t* Bt; int M, N, K; };
struct StaticOrder {
    int nM, nN, nwg, G, c;
    __device__ void init(int M, int N, int G_, int c_) { nM = M / BM; nN = N / BM; nwg = nM * nN; G = G_; c = c_; }
    __device__ bool next(int i, Unit& u) const {
        const long L = (long)i * G + c; if (L >= nwg) return false;
        int wgid = (int)L; { const int q = nwg / NXCD, r = nwg % NXCD, xcd = wgid % NXCD, off = wgid / NXCD; wgid = (xcd < r ? xcd * (q + 1) : r * (q + 1) + (xcd - r) * q) + off; }
        const int nig = WGM * nN, gid = wgid / nig, fm = gid * WGM, gsz = (nM - fm) < WGM ? (nM - fm) : WGM;
        u.pm = fm + ((wgid % nig) % gsz); u.pn = (wgid % nig) / gsz; return true;
    }
};
template <int ACT, int RS> struct EpiB {
    static constexpr bool PERM = true;
    bf16_t* O; int ldc; const float* rs;
    __device__ __forceinline__ void load_rs(const Unit& u, int wr, int fr, float (&rsv)[8]) const {
        if (RS == 1) {
#pragma unroll
            for (int q = 0; q < 8; ++q) rsv[q] = __builtin_amdgcn_rsqf(rs[u.pm * BM + wr * 64 + fr + (q >> 2) * HALF + (q & 3) * 16] * (1.f / 2048.f) + 1e-6f); }
    }
    __device__ __forceinline__ void operator()(const f32x4 (&acc)[2][2][4][2], const Unit& u, int wr, int wc, int fr, int fq, const float (&rsv)[8]) const {
        const int row0 = u.pm * BM + wr * 64 + fr, col0 = u.pn * BM + wc * 32 + 8 * fq;
        f32x4 cs[2][2];
        if (RS == 2) {
#pragma unroll
            for (int bj = 0; bj < 2; ++bj) { cs[bj][0] = *(const f32x4*)(rs + col0 + bj * HALF); cs[bj][1] = *(const f32x4*)(rs + col0 + bj * HALF + 4);
#pragma unroll
                for (int e = 0; e < 4; ++e) { cs[bj][0][e] = __builtin_amdgcn_rsqf(cs[bj][0][e] * (1.f / 2048.f) + 1e-6f); cs[bj][1][e] = __builtin_amdgcn_rsqf(cs[bj][1][e] * (1.f / 2048.f) + 1e-6f); } } }
#pragma unroll
        for (int ai = 0; ai < 2; ++ai)
#pragma unroll
            for (int m = 0; m < 4; ++m) { const int row = row0 + ai * HALF + m * 16; bf16_t* rowp = O + (size_t)row * ldc + col0;
                float rsc = 1.f; if (RS == 1) rsc = rsv[ai * 4 + m];
#pragma unroll
                for (int bj = 0; bj < 2; ++bj) { f32x4 v0 = acc[ai][bj][m][0], v1 = acc[ai][bj][m][1];
                    if (RS == 1) { v0 *= rsc; v1 *= rsc; }
                    if (RS == 2) { v0 *= cs[bj][0]; v1 *= cs[bj][1]; }
                    if (ACT == 1) {
#pragma unroll
                        for (int j = 0; j < 4; ++j) { float a = fmaxf(v0[j], 0.f), b = fmaxf(v1[j], 0.f); v0[j] = a * a; v1[j] = b * b; } }
                    u32x4 w; w.x = pk2(v0[0], v0[1]); w.y = pk2(v0[2], v0[3]); w.z = pk2(v1[0], v1[1]); w.w = pk2(v1[2], v1[3]);
                    *(u32x4*)(rowp + bj * HALF) = w; } }
    }
};

struct PanelOrder {
    int c;
    __device__ bool next(int i, Unit& u) const { if (i >= 2) return false; const int x = c & 7, k = c >> 3; u.pm = i * 32 + x * 4 + (k >> 3); u.pn = k & 7; return true; }
};
template <bool FINAL> struct EpiRes {
    static constexpr bool PERM = true;
    bf16_t* hb; float* out; const float* g1; float* ssY; float* ssH; unsigned* cnt;
    __device__ __forceinline__ void load_rs(const Unit&, int, int, float (&)[8]) const {}
    __device__ __forceinline__ void operator()(const f32x4 (&acc)[2][2][4][2], const Unit& u, int wr, int wc, int fr, int fq, const float (&)[8]) const {
        const int row0 = u.pm * BM + wr * 64 + fr, col0 = u.pn * BM + wc * 32 + 8 * fq;
#pragma unroll
        for (int q = 0; q < 8; ++q) { const int ai = q >> 2, m = q & 3; float sq = 0.f;
#pragma unroll
            for (int bj = 0; bj < 2; ++bj)
#pragma unroll
                for (int n = 0; n < 2; ++n)
#pragma unroll
                    for (int e = 0; e < 4; ++e) sq += acc[ai][bj][m][n][e] * acc[ai][bj][m][n][e];
            sq += __shfl_xor(sq, 16); sq += __shfl_xor(sq, 32);
            if (fq == 0) (void)__hip_atomic_fetch_add(ssY + row0 + ai * HALF + m * 16, sq, __ATOMIC_RELAXED, __HIP_MEMORY_SCOPE_AGENT); }
        asm volatile("s_waitcnt vmcnt(0)" ::: "memory");
        __builtin_amdgcn_s_barrier();
        if (threadIdx.x == 0) {
            (void)__hip_atomic_fetch_add(cnt + u.pm, 1u, __ATOMIC_RELAXED, __HIP_MEMORY_SCOPE_AGENT);
            unsigned sp = 0;
            while (__hip_atomic_load(cnt + u.pm, __ATOMIC_RELAXED, __HIP_MEMORY_SCOPE_AGENT) < 8u) { __builtin_amdgcn_s_sleep(1); if (++sp > (1u << 22)) break; }
        }
        asm volatile("" ::: "memory");
        __builtin_amdgcn_s_barrier();
        asm volatile("" ::: "memory");
        f32x4 gv[2][2];
#pragma unroll
        for (int bj = 0; bj < 2; ++bj) { gv[bj][0] = *(const f32x4*)(g1 + col0 + bj * HALF); gv[bj][1] = *(const f32x4*)(g1 + col0 + bj * HALF + 4); }
#pragma unroll
        for (int q = 0; q < 8; ++q) { const int ai = q >> 2, m = q & 3, row = row0 + ai * HALF + m * 16;
            const float rs1 = __builtin_amdgcn_rsqf(__hip_atomic_load(ssY + row, __ATOMIC_RELAXED, __HIP_MEMORY_SCOPE_AGENT) * (1.f / 2048.f) + 1e-6f);
            bf16_t* rowp = hb + (size_t)row * 2048 + col0; float s2 = 0.f;
#pragma unroll
            for (int bj = 0; bj < 2; ++bj) { const u32x4 hw = *(const u32x4*)(rowp + bj * HALF);
                f32x4 h0, h1;
                h0[0] = __uint_as_float(hw[0] << 16); h0[1] = __uint_as_float(hw[0] & 0xffff0000u); h0[2] = __uint_as_float(hw[1] << 16); h0[3] = __uint_as_float(hw[1] & 0xffff0000u);
                h1[0] = __uint_as_float(hw[2] << 16); h1[1] = __uint_as_float(hw[2] & 0xffff0000u); h1[2] = __uint_as_float(hw[3] << 16); h1[3] = __uint_as_float(hw[3] & 0xffff0000u);
                h0 += acc[ai][bj][m][0] * rs1 * gv[bj][0]; h1 += acc[ai][bj][m][1] * rs1 * gv[bj][1];
                if (FINAL) { float* op = out + (size_t)row * 2048 + col0 + bj * HALF; *(f32x4*)op = h0; *(f32x4*)(op + 4) = h1; }
                else {
#pragma unroll
                    for (int e = 0; e < 4; ++e) s2 += h0[e] * h0[e] + h1[e] * h1[e];
                    u32x4 w; w.x = pk2(h0[0], h0[1]); w.y = pk2(h0[2], h0[3]); w.z = pk2(h1[0], h1[1]); w.w = pk2(h1[2], h1[3]);
                    *(u32x4*)(rowp + bj * HALF) = w; } }
            if (!FINAL) { s2 += __shfl_xor(s2, 16); s2 += __shfl_xor(s2, 32);
                if (fq == 0) (void)__hip_atomic_fetch_add(ssH + row, s2, __ATOMIC_RELAXED, __HIP_MEMORY_SCOPE_AGENT); } }
    }
};

template <class Epi, class Sched>
__device__ __forceinline__ void gemm_phase(LAS unsigned char* lds, const Gemm g, const Sched& S, const Epi& E) {
    const int tid = threadIdx.x, wid = __builtin_amdgcn_readfirstlane(tid >> 6), lane = tid & 63, wr = wid >> 2, wc = wid & 3, fr = lane & 15, fq = lane >> 4;
    const int K = g.K, nt = K / BK;
    unsigned voffA[2], voffB[2];
#pragma unroll
    for (int i = 0; i < 2; ++i) { int R, C; stage_rc(tid * 16 + i * 8192, R, C); const int Rb = Epi::PERM ? ((R & ~31) + perm32(R & 31)) : R;
        voffA[i] = (unsigned)(R * K + C) * 2u; voffB[i] = (unsigned)(Rb * K + C) * 2u; }
    const size_t kstep = (size_t)(BK * 2);
    const size_t hstep = (size_t)HALF * K * 2;
    const size_t tstep = 2 * hstep;
    const unsigned ldsw = (unsigned)wid * 1024u;
    const int aoff = lds_byte(wr * 64 + fr, fq * 8), boff = lds_byte(wc * 32 + fr, fq * 8);
#define PG8_SA(b, h) (((b) * 2 + (h)) * HTB)
#define PG8_SB(b, h) ((4 + (b) * 2 + (h)) * HTB)
#define PG8_STAGE(bufoff, gbase, voff) do { _Pragma("unroll") for (int _i = 0; _i < 2; ++_i) \
        __builtin_amdgcn_global_load_lds((const unsigned*)((const char*)(gbase) + (voff)[_i]), (LAS unsigned*)(lds + (bufoff) + ldsw + _i * 8192), 16, 0, 0); } while (0)
#define PG8_LDA(dst, b, h) do { _Pragma("unroll") for (int m = 0; m < 4; ++m) _Pragma("unroll") for (int k = 0; k < 2; ++k) dst[m][k] = *(const LAS bf16x8*)(lds + PG8_SA(b, h) + aoff + m * 2048 + k * 1024); } while (0)
#define PG8_LDB(dst, b, h) do { _Pragma("unroll") for (int n = 0; n < 2; ++n) _Pragma("unroll") for (int k = 0; k < 2; ++k) dst[n][k] = *(const LAS bf16x8*)(lds + PG8_SB(b, h) + boff + n * 2048 + k * 1024); } while (0)
#define PG8_MMA(ai, bj, At, Bt) do { __builtin_amdgcn_s_setprio(1); _Pragma("unroll") for (int m = 0; m < 4; ++m) _Pragma("unroll") for (int n = 0; n < 2; ++n) _Pragma("unroll") for (int k = 0; k < 2; ++k) \
        acc[ai][bj][m][n] = __builtin_amdgcn_mfma_f32_16x16x32_bf16(Bt[n][k], At[m][k], acc[ai][bj][m][n], 0, 0, 0); __builtin_amdgcn_s_setprio(0); } while (0)
#define PG8_WAIT_V(n) asm volatile("s_waitcnt vmcnt(" #n ")" ::: "memory")
#define PG8_WAIT_L(n) asm volatile("s_waitcnt lgkmcnt(" #n ")" ::: "memory")
#define PG8_BAR __builtin_amdgcn_s_barrier()
#define PG8_SCHED __builtin_amdgcn_sched_barrier(0)
    Unit cur, nxt; int ui = 0;
    if (!S.next(0, cur)) return;
    f32x4 acc[2][2][4][2];
#pragma unroll
    for (int a = 0; a < 2; ++a)
#pragma unroll
        for (int b = 0; b < 2; ++b)
#pragma unroll
            for (int m = 0; m < 4; ++m)
#pragma unroll
                for (int n = 0; n < 2; ++n) acc[a][b][m][n] = (f32x4){0.f, 0.f, 0.f, 0.f};
    bf16x8 At[4][2], B0[2][2], B1[2][2];
    const char* cA = (const char*)g.A + (size_t)cur.pm * tstep; const char* cB = (const char*)g.Bt + (size_t)cur.pn * tstep;
    float rsv[8] = {1.f, 1.f, 1.f, 1.f, 1.f, 1.f, 1.f, 1.f};
    E.load_rs(cur, wr, fr, rsv);
    PG8_STAGE(PG8_SB(0, 0), cB, voffB); PG8_STAGE(PG8_SB(0, 1), cB + hstep, voffB); PG8_STAGE(PG8_SA(0, 0), cA, voffA); PG8_STAGE(PG8_SA(0, 1), cA + hstep, voffA);
    if (wr == 1) PG8_BAR;
    PG8_WAIT_V(2); PG8_BAR;
    PG8_STAGE(PG8_SB(1, 0), cB + kstep, voffB); PG8_STAGE(PG8_SA(1, 0), cA + kstep, voffA); PG8_STAGE(PG8_SB(1, 1), cB + hstep + kstep, voffB);
    PG8_WAIT_V(6); PG8_BAR;
    for (;;) {
        const bool has_next = S.next(ui + 1, nxt);
        const char* nA = has_next ? (const char*)g.A + (size_t)nxt.pm * tstep : cA; const char* nB = has_next ? (const char*)g.Bt + (size_t)nxt.pn * tstep : cB;
        for (int t = 0; t < nt; t += 2) {
            const bool last = (t == nt - 2);
            const char* a1 = cA + (size_t)(t + 1) * kstep;
            const char* a2 = last ? nA : cA + (size_t)(t + 2) * kstep; const char* b2 = last ? nB : cB + (size_t)(t + 2) * kstep;
            const char* a3 = a2 + kstep; const char* b3 = b2 + kstep;
            PG8_LDB(B0, 0, 0); PG8_LDB(B1, 0, 1); PG8_SCHED; PG8_LDA(At, 0, 0); PG8_STAGE(PG8_SA(1, 1), a1 + hstep, voffA);
            PG8_WAIT_V(8); PG8_WAIT_L(0); PG8_BAR; PG8_MMA(0, 0, At, B0); PG8_MMA(0, 1, At, B1); PG8_BAR; PG8_SCHED;
            PG8_LDA(At, 0, 1); PG8_STAGE(PG8_SB(0, 0), b2, voffB); PG8_STAGE(PG8_SB(0, 1), b2 + hstep, voffB); PG8_STAGE(PG8_SA(0, 0), a2, voffA);
            PG8_WAIT_V(8); PG8_WAIT_L(0); PG8_BAR; PG8_MMA(1, 0, At, B0); PG8_MMA(1, 1, At, B1); PG8_BAR; PG8_SCHED;
            PG8_LDB(B0, 1, 0); PG8_LDB(B1, 1, 1); PG8_SCHED; PG8_LDA(At, 1, 0); PG8_STAGE(PG8_SA(0, 1), a2 + hstep, voffA);
            PG8_WAIT_V(8); PG8_WAIT_L(0); PG8_BAR; PG8_MMA(0, 0, At, B0); PG8_MMA(0, 1, At, B1); PG8_BAR; PG8_SCHED;
            PG8_LDA(At, 1, 1); PG8_STAGE(PG8_SB(1, 0), b3, voffB); PG8_STAGE(PG8_SB(1, 1), b3 + hstep, voffB); PG8_STAGE(PG8_SA(1, 0), a3, voffA);
            PG8_WAIT_V(8); PG8_WAIT_L(0); PG8_BAR; PG8_MMA(1, 0, At, B0); PG8_MMA(1, 1, At, B1); PG8_BAR; PG8_SCHED;
        }
        if (wr == 0) PG8_BAR;
        E(acc, cur, wr, wc, fr, fq, rsv);
        if (!has_next) break;
        E.load_rs(nxt, wr, fr, rsv);
#pragma unroll
        for (int a = 0; a < 2; ++a)
#pragma unroll
            for (int b = 0; b < 2; ++b)
#pragma unroll
                for (int m = 0; m < 4; ++m)
#pragma unroll
                    for (int n = 0; n < 2; ++n) acc[a][b][m][n] = (f32x4){0.f, 0.f, 0.f, 0.f};
        cur = nxt; cA = nA; cB = nB; ++ui;
        if (wr == 1) PG8_BAR;
    }
    PG8_WAIT_V(0);
    PG8_BAR;
#undef PG8_SA
#undef PG8_SB
#undef PG8_STAGE
#undef PG8_LDA
#undef PG8_LDB
#undef PG8_MMA
#undef PG8_WAIT_V
#undef PG8_WAIT_L
#undef PG8_BAR
#undef PG8_SCHED
}
}

struct Params {
    const float* x; const float* norm_g; const float* even_w_in; const float* conv_w; const float* rel_bias; const float* even_w_out;
    const float* odd_w_in; const float* hgrn_lb; const float* hgrn_ng; const float* wa2; const float* ba; const float* gla_ng; const float* odd_w_out;
    const float* w1; const float* w2; float* out; unsigned char* ws; int ph_lo, ph_hi;
};

__device__ __forceinline__ void cvt_seg(const float* __restrict__ W, int K, int NS, int c0, int nc, bf16_t* __restrict__ WT, int r0, const float* __restrict__ gf, float* scr, int gw, int NGW, int lane) {
    const int nblk = (nc + 31) >> 5, nitems = (K >> 6) * nblk;
    const int krow = lane >> 3, c4 = (lane & 7) * 4;
    for (int it = gw; it < nitems; it += NGW) {
        const int kb = it / nblk, nb = it - kb * nblk, k0 = kb * 64, n0 = nb * 32;
        const bool ok = (n0 + c4) < nc;
        const float* src = W + (size_t)(k0 + krow) * NS + c0 + n0 + c4;
        f32x4 v[8];
#pragma unroll
        for (int i = 0; i < 8; ++i) v[i] = ok ? *(const f32x4*)(src + (size_t)(8 * i) * NS) : (f32x4){0.f, 0.f, 0.f, 0.f};
        if (gf) {
#pragma unroll
            for (int i = 0; i < 8; ++i) v[i] *= gf[k0 + 8 * i + krow]; }
#pragma unroll
        for (int i = 0; i < 8; ++i) { float* d = scr + (8 * i + krow) * 33 + c4; d[0] = v[i][0]; d[1] = v[i][1]; d[2] = v[i][2]; d[3] = v[i][3]; }
        LDS_WAIT();
        const int c = lane & 7;
#pragma unroll
        for (int j = 0; j < 4; ++j) { const int n = (lane >> 3) + 8 * j; const float* s = scr + (8 * c) * 33 + n;
            u32x4 o; o.x = pk2(s[0], s[33]); o.y = pk2(s[66], s[99]); o.z = pk2(s[132], s[165]); o.w = pk2(s[198], s[231]);
            if (n0 + n < nc) *(u32x4*)(WT + (size_t)(r0 + n0 + n) * K + k0 + 8 * c) = o; }
        LDS_WAIT();
    }
}

template <int MODE>
__device__ __forceinline__ void rowwise(const float* __restrict__ xin, const bf16_t* __restrict__ ysrc, const float* __restrict__ g1,
                                        bf16_t* hb, float* __restrict__ rsout, float* __restrict__ out, int gw, int NGW, int lane) {
    for (int row0 = gw; row0 < NTOK; row0 += 2 * NGW) {
        f32x4 h[2][4][2]; u32x4 yw[2][4], hw[2][4];
#pragma unroll
        for (int rr = 0; rr < 2; ++rr) { const size_t rb = (size_t)(row0 + rr * NGW) * DM;
#pragma unroll
            for (int j = 0; j < 4; ++j) { const int col = 512 * j + 8 * lane;
                if (MODE == 0) { h[rr][j][0] = *(const f32x4*)(xin + rb + col); h[rr][j][1] = *(const f32x4*)(xin + rb + col + 4); }
                else { hw[rr][j] = *(const u32x4*)(hb + rb + col); yw[rr][j] = *(const u32x4*)(ysrc + rb + col); } } }
#pragma unroll
        for (int rr = 0; rr < 2; ++rr) {
            const int row = row0 + rr * NGW; const size_t rb = (size_t)row * DM;
            if (MODE != 0) {
                float y[4][8]; float ss = 0.f;
#pragma unroll
                for (int j = 0; j < 4; ++j) {
#pragma unroll
                    for (int e = 0; e < 4; ++e) { y[j][2 * e] = __uint_as_float(yw[rr][j][e] << 16); y[j][2 * e + 1] = __uint_as_float(yw[rr][j][e] & 0xffff0000u);
                        h[rr][j][e >> 1][(2 * e) & 3] = __uint_as_float(hw[rr][j][e] << 16); h[rr][j][e >> 1][(2 * e + 1) & 3] = __uint_as_float(hw[rr][j][e] & 0xffff0000u); }
#pragma unroll
                    for (int e = 0; e < 8; ++e) ss += y[j][e] * y[j][e]; }
                const float rs = rsqrtf(wave_sum(ss) * (1.f / DM) + EPS);
#pragma unroll
                for (int j = 0; j < 4; ++j) { const int col = 512 * j + 8 * lane; const f32x4 ga = *(const f32x4*)(g1 + col), gb = *(const f32x4*)(g1 + col + 4);
#pragma unroll
                    for (int e = 0; e < 4; ++e) { h[rr][j][0][e] += y[j][e] * rs * ga[e]; h[rr][j][1][e] += y[j][4 + e] * rs * gb[e]; }
                    if (MODE == 2) { *(f32x4*)(out + rb + col) = h[rr][j][0]; *(f32x4*)(out + rb + col + 4) = h[rr][j][1]; } }
            }
            if (MODE != 2) {
                float ss = 0.f;
#pragma unroll
                for (int j = 0; j < 4; ++j)
#pragma unroll
                    for (int e = 0; e < 4; ++e) ss += h[rr][j][0][e] * h[rr][j][0][e] + h[rr][j][1][e] * h[rr][j][1][e];
                const float sst = wave_sum(ss);
                if (lane == 0) rsout[row] = sst;
#pragma unroll
                for (int j = 0; j < 4; ++j) { const int col = 512 * j + 8 * lane;
                    u32x4 o; o.x = pk2(h[rr][j][0][0], h[rr][j][0][1]); o.y = pk2(h[rr][j][0][2], h[rr][j][0][3]);
                    o.z = pk2(h[rr][j][1][0], h[rr][j][1][1]); o.w = pk2(h[rr][j][1][2], h[rr][j][1][3]);
                    *(u32x4*)(hb + rb + col) = o; }
            }
        }
    }
}

__device__ __forceinline__ void conv_phase(const bf16_t* __restrict__ P, const float* __restrict__ cw, bf16_t* __restrict__ ycat) {
    const int nthr = gridDim.x * 512;
#pragma unroll 2
    for (int it = blockIdx.x * 512 + threadIdx.x; it < NTOK * 128; it += nthr) {
        const int t = it >> 7, c0 = (it & 127) * 8, tp = t & (SEQ - 1);
        const bf16_t* row = P + (size_t)t * LDE + c0;
        const u32x4 bg = *(const u32x4*)(row), c2 = *(const u32x4*)(row + 1024), h2 = *(const u32x4*)(row + 2048);
        u32x4 c1 = (u32x4){0, 0, 0, 0}, h1 = c1, cz = c1, hz = c1;
        if (tp >= 1) { c1 = *(const u32x4*)(row - LDE + 1024); h1 = *(const u32x4*)(row - LDE + 2048); }
        if (tp >= 2) { cz = *(const u32x4*)(row - 2 * LDE + 1024); hz = *(const u32x4*)(row - 2 * LDE + 2048); }
        float o[8];
#pragma unroll
        for (int e = 0; e < 8; ++e) {
            const int sh = (e & 1) ? 0 : 16; const int w = e >> 1;
            auto get = [&](const u32x4& v) { return __uint_as_float((v[w] << sh) & 0xffff0000u); };
            const float u2 = get(c2) * get(h2), u1 = get(c1) * get(h1), u0 = get(cz) * get(hz);
            const float y = cw[c0 + e] * u0 + cw[1024 + c0 + e] * u1 + cw[2048 + c0 + e] * u2;
            o[e] = get(bg) * y;
        }
        u32x4 w; w.x = pk2(o[0], o[1]); w.y = pk2(o[2], o[3]); w.z = pk2(o[4], o[5]); w.w = pk2(o[6], o[7]);
        *(u32x4*)(ycat + (size_t)t * DM + c0) = w;
    }
}

__device__ __forceinline__ void attn_phase(unsigned char* smem, const bf16_t* __restrict__ P, const bf16_t* __restrict__ VT, const float* __restrict__ relb, bf16_t* __restrict__ ycat) {
    const int tid = threadIdx.x, lane = tid & 63, wave = tid >> 6, half = wave >> 2, w4 = wave & 3, ltid = tid & 255, r = lane & 15, q8 = lane >> 4;
    unsigned char* base = smem + half * 47616;
    bf16_t* kS = (bf16_t*)base;
    bf16_t* vS = (bf16_t*)(base + 17408);
    bf16_t* pS = (bf16_t*)(base + 35840);
    float* bS = (float*)(base + 45056);
    const float scale = 0.08838834764831845f * 1.4426950408889634f;
    for (int pair = blockIdx.x; pair < 1024; pair += gridDim.x) {
        const int hp = pair & 3, n = (pair >> 2) & 63, b = pair >> 8, head = hp * 2 + half;
        const int tok0 = b * SEQ + n * 64;
        __syncthreads();
        for (int i = ltid; i < 640; i += 256) bS[i] = relb[head * 320 + (i < 319 ? i : 319)] * 1.4426950408889634f;
        bf16x8 qf[4];
        { const bf16_t* qp = P + (size_t)(tok0 + 16 * w4 + r) * LDE + 3072 + head * 128 + 8 * q8;
#pragma unroll
          for (int kk = 0; kk < 4; ++kk) qf[kk] = *(const bf16x8*)(qp + 32 * kk); }
        float m[4], l[4]; f32x4 o[8];
#pragma unroll
        for (int j = 0; j < 4; ++j) { m[j] = -1e30f; l[j] = 0.f; }
#pragma unroll
        for (int i = 0; i < 8; ++i) o[i] = (f32x4){0.f, 0.f, 0.f, 0.f};
        const int js0 = (n < 8 ? 8 - n : 0);
        u32x4 kreg[4], vreg[4];
        { const int ktok0 = tok0 + (js0 - 8) * 64;
#pragma unroll
          for (int i = 0; i < 4; ++i) { const int ch = ltid + 256 * i;
              kreg[i] = *(const u32x4*)(P + (size_t)(ktok0 + (ch >> 4)) * LDE + 4096 + head * 128 + (ch & 15) * 8);
              vreg[i] = *(const u32x4*)(VT + (size_t)(head * 128 + (ch >> 3)) * NTOK + ktok0 + (ch & 7) * 8); } }
        for (int js = js0; js <= 8; ++js) {
            __syncthreads();
#pragma unroll
            for (int i = 0; i < 4; ++i) { const int ch = ltid + 256 * i;
                *(u32x4*)(kS + (ch >> 4) * 136 + (ch & 15) * 8) = kreg[i];
                *(u32x4*)(vS + (ch >> 3) * 72 + (ch & 7) * 8) = vreg[i]; }
            __syncthreads();
            if (js < 8) { const int ktok0 = tok0 + (js + 1 - 8) * 64;
#pragma unroll
                for (int i = 0; i < 4; ++i) { const int ch = ltid + 256 * i;
                    kreg[i] = *(const u32x4*)(P + (size_t)(ktok0 + (ch >> 4)) * LDE + 4096 + head * 128 + (ch & 15) * 8);
                    vreg[i] = *(const u32x4*)(VT + (size_t)(head * 128 + (ch >> 3)) * NTOK + ktok0 + (ch & 7) * 8); } }
            f32x4 s[4];
#pragma unroll
            for (int nt = 0; nt < 4; ++nt) { s[nt] = (f32x4){0.f, 0.f, 0.f, 0.f};
#pragma unroll
                for (int kk = 0; kk < 4; ++kk) { const bf16x8 kf = *(const bf16x8*)(kS + (16 * nt + r) * 136 + 32 * kk + 8 * q8);
                    s[nt] = __builtin_amdgcn_mfma_f32_16x16x32_bf16(qf[kk], kf, s[nt], 0, 0, 0); } }
            float alpha[4];
            const float* bT = bS + (16 * w4 + 4 * q8 - r + 63 + (8 - js) * 64);
#pragma unroll
            for (int j = 0; j < 4; ++j) {
                float mx = -1e30f;
#pragma unroll
                for (int nt = 0; nt < 4; ++nt) { const float v = s[nt][j] * scale + bT[j - 16 * nt]; s[nt][j] = v; mx = fmaxf(mx, v); }
                mx = row16_max(mx);
                const float mn = fmaxf(m[j], mx); alpha[j] = __builtin_amdgcn_exp2f(m[j] - mn); m[j] = mn;
                float ps = 0.f;
#pragma unroll
                for (int nt = 0; nt < 4; ++nt) { const float pp = __builtin_amdgcn_exp2f(s[nt][j] - mn); ps += pp; pS[(16 * w4 + 4 * q8 + j) * 72 + 16 * nt + r] = f2bf(pp); }
                l[j] = l[j] * alpha[j] + ps;
            }
#pragma unroll
            for (int i = 0; i < 8; ++i)
#pragma unroll
                for (int j = 0; j < 4; ++j) o[i][j] *= alpha[j];
            LDS_WAIT();
#pragma unroll
            for (int kk = 0; kk < 2; ++kk) { const bf16x8 pf = *(const bf16x8*)(pS + (16 * w4 + r) * 72 + 32 * kk + 8 * q8);
#pragma unroll
                for (int i = 0; i < 8; ++i) { const bf16x8 vf = *(const bf16x8*)(vS + (16 * i + r) * 72 + 32 * kk + 8 * q8);
                    o[i] = __builtin_amdgcn_mfma_f32_16x16x32_bf16(pf, vf, o[i], 0, 0, 0); } }
        }
#pragma unroll
        for (int j = 0; j < 4; ++j) { float lt = l[j];
#pragma unroll
            for (int ofs = 1; ofs < 16; ofs <<= 1) lt += __shfl_xor(lt, ofs);
            const float inv = frcp(lt);
            bf16_t* op = ycat + (size_t)(tok0 + 16 * w4 + 4 * q8 + j) * DM + 1024 + head * 128 + r;
#pragma unroll
            for (int i = 0; i < 8; ++i) op[16 * i] = f2bf(o[i][j] * inv); }
    }
}

template <int KIND, bool WANT_Q>
__device__ __forceinline__ void decay_qk(const Params& p, const bf16_t* __restrict__ P, int tok0, int hd, int d, int tq, float (&bl)[16], float (&kv)[16], float (&qv)[16], const bf16_t (&ra)[16], const bf16_t (&rq)[16], const u32x4& gaR) {
    const int col = hd * 128 + d;
    const bf16_t* rp = P + (size_t)(tok0 + 16 * tq) * LDO;
    if (KIND == 0) {
        const float lb = frcp(1.f + __expf(p.hgrn_lb[col] - p.hgrn_lb[1024 + col]));
        float run = 0.f;
#pragma unroll
        for (int jj = 0; jj < 16; ++jj) {
            const float fr = bf2f(ra[jj]);
            const float f = lb + (1.f - lb) * sigmoidf_(fr);
            run += __logf(f); bl[jj] = run; kv[jj] = 1.f - f;
            if (WANT_Q) { const float qr = bf2f(rq[jj]); qv[jj] = qr * sigmoidf_(qr); }
        }
    } else {
        float w[16];
#pragma unroll
        for (int rr = 0; rr < 16; ++rr) w[rr] = p.wa2[rr * 512 + col];
        const float bias = p.ba[col];
        float run = 0.f;
#pragma unroll
        for (int jj = 0; jj < 16; ++jj) {
            u32x4 g0, g1;
#pragma unroll
            for (int e = 0; e < 4; ++e) { g0[e] = (unsigned)__builtin_amdgcn_readlane((int)gaR[e], 2 * jj); g1[e] = (unsigned)__builtin_amdgcn_readlane((int)gaR[e], 2 * jj + 1); }
            float xx = bias;
#pragma unroll
            for (int e = 0; e < 4; ++e) {
                xx += __uint_as_float(g0[e] << 16) * w[2 * e] + __uint_as_float(g0[e] & 0xffff0000u) * w[2 * e + 1];
                xx += __uint_as_float(g1[e] << 16) * w[8 + 2 * e] + __uint_as_float(g1[e] & 0xffff0000u) * w[8 + 2 * e + 1];
            }
            const float ls = fminf(xx, 0.f) - __logf(1.f + __expf(-fabsf(xx)));
            run += ls * (1.f / 16.f); bl[jj] = run;
            kv[jj] = bf2f(ra[jj]);
            if (WANT_Q) qv[jj] = bf2f(rq[jj]) * 0.08838834764831845f;
        }
    }
}

template <int KIND, bool WANT_Q>
__device__ __forceinline__ void load_raw(const bf16_t* __restrict__ P, const bf16_t* __restrict__ VT, int idx, bf16_t (&ra)[16], bf16_t (&rq)[16], u32x4 (&vr)[KIND ? 4 : 2], u32x4& gaR) {
    constexpr int DV = KIND ? 256 : 128;
    const int tid = threadIdx.x, d = tid & 127, tq = tid >> 7;
    const int c = idx & 63, bh = idx >> 6, hd = KIND ? (bh & 3) : (bh & 7), b = KIND ? (bh >> 2) : (bh >> 3);
    const int tok0 = b * SEQ + c * 64, col = hd * 128 + d;
    const bf16_t* rp = P + (size_t)(tok0 + 16 * tq) * LDO;
#pragma unroll
    for (int jj = 0; jj < 16; ++jj) { ra[jj] = rp[(size_t)jj * LDO + (KIND ? 3584 : 1024) + col]; if (WANT_Q) rq[jj] = rp[(size_t)jj * LDO + (KIND ? 3072 : 0) + col]; }
    if (KIND == 1) gaR = *(const u32x4*)(rp + (size_t)((tid & 31) >> 1) * LDO + 5120 + (tid & 1) * 8);
    const bf16_t* vsrc = VT + (size_t)((KIND ? 1024 + hd * 256 : hd * 128)) * NTOK + tok0;
#pragma unroll
    for (int i = 0; i < DV / 64; ++i) { const int ch = tid + 512 * i, row = ch >> 3, c8 = ch & 7; vr[i] = *(const u32x4*)(vsrc + (size_t)row * NTOK + c8 * 8); }
}

template <int KIND>
__device__ __forceinline__ void passA_item(const Params& p, unsigned char* smem_base, const bf16_t* __restrict__ P, const bf16_t* __restrict__ VT, bf16_t* __restrict__ ST, float* __restrict__ DEC, int idx, int par, int nidx, bf16_t (&ra)[16], bf16_t (&rq)[16], u32x4 (&vr)[KIND ? 4 : 2], u32x4& gaR) {
    unsigned char* smem = smem_base + par * 57344;
    constexpr int DV = KIND ? 256 : 128;
    const int tid = threadIdx.x, lane = tid & 63, wave = tid >> 6, r = lane & 15, q8 = lane >> 4, d = tid & 127, tq = tid >> 7;
    const int c = idx & 63, bh = idx >> 6, hd = KIND ? (bh & 3) : (bh & 7), b = KIND ? (bh >> 2) : (bh >> 3);
    const int tok0 = b * SEQ + c * 64;
    bf16_t* kT = (bf16_t*)smem;
    bf16_t* vS = (bf16_t*)(smem + 18432);
    float* tot = (float*)(smem + 18432 + 36864);
    float bl[16], kv[16], qv[16];
    decay_qk<KIND, false>(p, P, tok0, hd, d, tq, bl, kv, qv, ra, rq, gaR);
    tot[tq * 128 + d] = bl[15];
#pragma unroll
    for (int i = 0; i < DV / 64; ++i) { const int ch = tid + 512 * i, row = ch >> 3, c8 = ch & 7; *(u32x4*)(vS + row * 72 + c8 * 8) = vr[i]; }
    __syncthreads();
    if (nidx >= 0) load_raw<KIND, false>(P, VT, nidx, ra, rq, vr, gaR);
    const float t0 = tot[d], t1 = tot[128 + d], t2 = tot[256 + d], t3 = tot[384 + d];
    const float r4 = t0 + t1 + t2 + t3;
    const float rpre = (tq > 0 ? t0 : 0.f) + (tq > 1 ? t1 : 0.f) + (tq > 2 ? t2 : 0.f);
    {
        float kt[16];
#pragma unroll
        for (int jj = 0; jj < 16; ++jj) kt[jj] = kv[jj] * __expf(r4 - rpre - bl[jj]);
        u32x4 w0, w1;
        w0.x = pk2(kt[0], kt[1]); w0.y = pk2(kt[2], kt[3]); w0.z = pk2(kt[4], kt[5]); w0.w = pk2(kt[6], kt[7]);
        w1.x = pk2(kt[8], kt[9]); w1.y = pk2(kt[10], kt[11]); w1.z = pk2(kt[12], kt[13]); w1.w = pk2(kt[14], kt[15]);
        *(u32x4*)(kT + d * 72 + 16 * tq) = w0; *(u32x4*)(kT + d * 72 + 16 * tq + 8) = w1;
    }
    const int gitem = (KIND ? 2048 : 0) + idx;
    if (tq == 0) DEC[(size_t)gitem * 128 + d] = __expf(r4);
    __syncthreads();
    const int d0 = 16 * wave;
    bf16x8 af[2];
#pragma unroll
    for (int kk = 0; kk < 2; ++kk) af[kk] = *(const bf16x8*)(kT + (d0 + r) * 72 + 32 * kk + 8 * q8);
    bf16_t* stb = ST + (KIND ? (size_t)33554432 : 0) + (size_t)idx * (DV * 128);
#pragma unroll
    for (int nt = 0; nt < DV / 16; ++nt) {
        f32x4 acc = (f32x4){0.f, 0.f, 0.f, 0.f};
#pragma unroll
        for (int kk = 0; kk < 2; ++kk) { const bf16x8 bfr = *(const bf16x8*)(vS + (16 * nt + r) * 72 + 32 * kk + 8 * q8);
            acc = __builtin_amdgcn_mfma_f32_16x16x32_bf16(af[kk], bfr, acc, 0, 0, 0); }
        u32x2 w; w.x = pk2(acc[0], acc[1]); w.y = pk2(acc[2], acc[3]);
        *(u32x2*)(stb + (size_t)(16 * nt + r) * 128 + d0 + 4 * q8) = w;
    }
}

__device__ __forceinline__ void scan_phase(bf16_t* __restrict__ ST, const float* __restrict__ DEC) {
    const int nthr = gridDim.x * 512;
    for (int gid = blockIdx.x * 512 + threadIdx.x; gid < 131072; gid += nthr) {
        const int kind = gid >> 16, v = gid & 65535;
        const int vper = kind ? 4096 : 2048, bh = v / vper, vi = v - bh * vper, d0 = (vi * 8) & 127;
        const size_t csz = kind ? 32768 : 16384;
        bf16_t* sp = ST + (kind ? (size_t)33554432 : 0) + (size_t)bh * 64 * csz + (size_t)vi * 8;
        const float* dp = DEC + (size_t)((kind ? 2048 : 0) + bh * 64) * 128 + d0;
        float S[8];
#pragma unroll
        for (int e = 0; e < 8; ++e) S[e] = 0.f;
#pragma unroll 8
        for (int c = 0; c < 64; ++c) {
            const u32x4 u = *(const u32x4*)(sp + (size_t)c * csz);
            const f32x4 da = *(const f32x4*)(dp + c * 128), db = *(const f32x4*)(dp + c * 128 + 4);
            u32x4 w; w.x = pk2(S[0], S[1]); w.y = pk2(S[2], S[3]); w.z = pk2(S[4], S[5]); w.w = pk2(S[6], S[7]);
            *(u32x4*)(sp + (size_t)c * csz) = w;
#pragma unroll
            for (int e = 0; e < 4; ++e) {
                S[2 * e] = S[2 * e] * (e < 2 ? da[2 * e] : db[2 * e - 4]) + __uint_as_float(u[e] << 16);
                S[2 * e + 1] = S[2 * e + 1] * (e < 2 ? da[2 * e + 1] : db[2 * e - 3]) + __uint_as_float(u[e] & 0xffff0000u);
            }
        }
    }
}

template <int KIND>
__device__ __forceinline__ void passC_item(const Params& p, unsigned char* smem, const bf16_t* __restrict__ P, const bf16_t* __restrict__ VT, const bf16_t* __restrict__ ST, bf16_t* __restrict__ ycat, int idx, int nidx, bf16_t (&ra)[16], bf16_t (&rq)[16], u32x4 (&vr)[KIND ? 4 : 2], u32x4& gaR) {
    constexpr int DV = KIND ? 256 : 128;
    const int tid = threadIdx.x, lane = tid & 63, wave = tid >> 6, r = lane & 15, q8 = lane >> 4, d = tid & 127, tq = tid >> 7;
    const int c = idx & 63, bh = idx >> 6, hd = KIND ? (bh & 3) : (bh & 7), b = KIND ? (bh >> 2) : (bh >> 3);
    const int tok0 = b * SEQ + c * 64;
    bf16_t* qs = (bf16_t*)smem;
    bf16_t* qh = (bf16_t*)(smem + 17408);
    bf16_t* ks = (bf16_t*)(smem + 34816);
    bf16_t* vS = (bf16_t*)(smem + 78336);
    bf16_t* pS = (bf16_t*)(smem + 115200);
    float* tot = (float*)(smem + 124416);
    float* ssq = (float*)(smem + 126464);
    float bl[16], kv[16], qv[16];
    decay_qk<KIND, true>(p, P, tok0, hd, d, tq, bl, kv, qv, ra, rq, gaR);
    tot[tq * 128 + d] = bl[15];
#pragma unroll
    for (int i = 0; i < DV / 64; ++i) { const int ch = tid + 512 * i, row = ch >> 3, c8 = ch & 7; *(u32x4*)(vS + row * 72 + c8 * 8) = vr[i]; }
    for (int i = tid; i < 64 * 72 / 8; i += 512) *(u32x4*)(pS + i * 8) = (u32x4){0, 0, 0, 0};
    __syncthreads();
    if (nidx >= 0) load_raw<KIND, true>(P, VT, nidx, ra, rq, vr, gaR);
    constexpr int NT = DV / 32;
    constexpr int NPRE = 4;
    const int oi = wave & 3, oeh = wave >> 2;
    const bf16_t* stb = ST + (KIND ? (size_t)33554432 : 0) + (size_t)idx * (DV * 128);
    const int gcol = KIND ? 4096 + hd * 256 : 2048 + hd * 128;
    bf16x8 bst[NPRE][4];
#pragma unroll
    for (int nt = 0; nt < NPRE; ++nt)
#pragma unroll
        for (int kk = 0; kk < 4; ++kk) bst[nt][kk] = *(const bf16x8*)(stb + (size_t)(oeh * (DV / 2) + 16 * nt + r) * 128 + 32 * kk + 8 * q8);
    bf16_t graw[4][NT];
#pragma unroll
    for (int j = 0; j < 4; ++j)
#pragma unroll
        for (int nt = 0; nt < NT; ++nt) graw[j][nt] = P[(size_t)(tok0 + 16 * oi + 4 * q8 + j) * LDO + gcol + oeh * (DV / 2) + 16 * nt + r];
    {
        const float t0 = tot[d], t1 = tot[128 + d], t2 = tot[256 + d];
        const float rpre = (tq > 0 ? t0 : 0.f) + (tq > 1 ? t1 : 0.f) + (tq > 2 ? t2 : 0.f);
        const float Ttq = bl[15], rn = rpre + Ttq;
        const float einv = __expf(fminf(-Ttq, 80.f));
        const float f1 = (tq == 1) ? einv : __expf(fminf(t0 - rn, 0.f));
        const float f2 = (tq == 2) ? einv : __expf(fminf(t0 + t1 - rn, 0.f));
        const float f3 = (tq == 3) ? einv : __expf(fminf(t0 + t1 + t2 - rn, 0.f));
        const float erp = __expf(rpre);
#pragma unroll
        for (int jj = 0; jj < 16; ++jj) {
            const int t = 16 * tq + jj;
            const float ql = qv[jj] * __expf(bl[jj]);
            qs[t * 136 + d] = f2bf(ql);
            qh[t * 136 + d] = f2bf(ql * erp);
            const float kb = kv[jj] * __expf(Ttq - bl[jj]);
            if (tq == 0) ks[(0 + t) * 136 + d] = f2bf(kb * einv);
            if (tq <= 1) ks[(16 + t) * 136 + d] = f2bf(kb * f1);
            if (tq <= 2) ks[(48 + t) * 136 + d] = f2bf(kb * f2);
            ks[(96 + t) * 136 + d] = f2bf(kb * f3);
        }
    }
    __syncthreads();
    {
        const int i = wave >> 1, off = 8 * i * (i + 1);
        bf16x8 af[4];
#pragma unroll
        for (int kk = 0; kk < 4; ++kk) af[kk] = *(const bf16x8*)(qs + (16 * i + r) * 136 + 32 * kk + 8 * q8);
        for (int jt = (wave & 1); jt <= i; jt += 2) {
            f32x4 acc = (f32x4){0.f, 0.f, 0.f, 0.f};
#pragma unroll
            for (int kk = 0; kk < 4; ++kk) { const bf16x8 bfr = *(const bf16x8*)(ks + (off + 16 * jt + r) * 136 + 32 * kk + 8 * q8);
                acc = __builtin_amdgcn_mfma_f32_16x16x32_bf16(af[kk], bfr, acc, 0, 0, 0); }
#pragma unroll
            for (int j = 0; j < 4; ++j) { float v = acc[j]; if (jt == i && r > 4 * q8 + j) v = 0.f;
                pS[(16 * i + 4 * q8 + j) * 72 + 16 * jt + r] = f2bf(v); }
        }
    }
    __syncthreads();
    {
        const int i = oi, eh = oeh;
        bf16x8 ap[2], aq[4];
#pragma unroll
        for (int kk = 0; kk < 2; ++kk) ap[kk] = *(const bf16x8*)(pS + (16 * i + r) * 72 + 32 * kk + 8 * q8);
#pragma unroll
        for (int kk = 0; kk < 4; ++kk) aq[kk] = *(const bf16x8*)(qh + (16 * i + r) * 136 + 32 * kk + 8 * q8);
        f32x4 o[NT];
        float ss[4] = {0.f, 0.f, 0.f, 0.f};
#pragma unroll
        for (int nt = 0; nt < NT; ++nt) {
            const int e0 = eh * (DV / 2) + 16 * nt;
            f32x4 acc = (f32x4){0.f, 0.f, 0.f, 0.f};
#pragma unroll
            for (int kk = 0; kk < 2; ++kk) { const bf16x8 bfr = *(const bf16x8*)(vS + (e0 + r) * 72 + 32 * kk + 8 * q8);
                acc = __builtin_amdgcn_mfma_f32_16x16x32_bf16(ap[kk], bfr, acc, 0, 0, 0); }
#pragma unroll
            for (int kk = 0; kk < 4; ++kk) { bf16x8 bfr;
                if (nt < NPRE) bfr = bst[nt < NPRE ? nt : 0][kk]; else bfr = *(const bf16x8*)(stb + (size_t)(e0 + r) * 128 + 32 * kk + 8 * q8);
                acc = __builtin_amdgcn_mfma_f32_16x16x32_bf16(aq[kk], bfr, acc, 0, 0, 0); }
            o[nt] = acc;
#pragma unroll
            for (int j = 0; j < 4; ++j) ss[j] += acc[j] * acc[j];
        }
#pragma unroll
        for (int j = 0; j < 4; ++j) {
#pragma unroll
            for (int ofs = 1; ofs < 16; ofs <<= 1) ss[j] += __shfl_xor(ss[j], ofs);
            if (r == 0) ssq[eh * 64 + 16 * i + 4 * q8 + j] = ss[j];
        }
        __syncthreads();
        const float* ng = (KIND ? p.gla_ng + hd * 256 : p.hgrn_ng + hd * 128);
        const int ycol = KIND ? 1024 + hd * 256 : hd * 128;
#pragma unroll
        for (int j = 0; j < 4; ++j) {
            const int t = 16 * i + 4 * q8 + j;
            const float rstd = __builtin_amdgcn_rsqf((ssq[t] + ssq[64 + t]) * (1.f / DV) + EPS);
            bf16_t* yp = ycat + (size_t)(tok0 + t) * DM + ycol;
#pragma unroll
            for (int nt = 0; nt < NT; ++nt) { const int e = eh * (DV / 2) + 16 * nt + r;
                const float g = bf2f(graw[j][nt]);
                yp[e] = f2bf(o[nt][j] * rstd * ng[e] * (g * sigmoidf_(g))); }
        }
    }
}

#define XB_TMO      128
#define XB_XCNT(j)  (256  + 64 * (j))
#define XB_XSUB(j)  (1280 + 64 * (j))
#define XB_XGEN(j)  (2304 + 64 * (j))
#define XB_TOP      3328
#define XB_TOPGEN   3392
#define XCD_BAR_WORDS 3456
#define XB_SPIN_CAP (1u << 18)
__device__ __forceinline__ unsigned xb_ld(unsigned* p)              { return __hip_atomic_load(p, __ATOMIC_RELAXED, __HIP_MEMORY_SCOPE_AGENT); }
__device__ __forceinline__ unsigned xb_add(unsigned* p, unsigned v) { return __hip_atomic_fetch_add(p, v, __ATOMIC_RELAXED, __HIP_MEMORY_SCOPE_AGENT); }
__device__ __forceinline__ unsigned xb_xcc_id() { return (unsigned)__builtin_amdgcn_s_getreg((3 << 11) | 20) & 0xFu; }
#define XB_SPIN(cond, bar) do { unsigned _sp = 0; while (cond) { __builtin_amdgcn_s_sleep(1); \
    if ((++_sp & 255u) == 0u) { if (xb_ld(&(bar)[XB_TMO])) break; if (_sp > XB_SPIN_CAP) { atomicAdd(&(bar)[XB_TMO], 1u); break; } } } } while (0)
struct XcdBarrier { unsigned* bar; unsigned x; volatile LAS unsigned* st; };
__device__ __forceinline__ XcdBarrier xcd_barrier_post(unsigned* bar, volatile LAS unsigned* st) {
    XcdBarrier b; b.bar = bar; b.x = xb_xcc_id(); b.st = st;
    if (threadIdx.x == 0) (void)xb_add(&bar[XB_XCNT(b.x)], 1u);
    return b;
}
__device__ __forceinline__ void xcd_barrier_complete(unsigned* bar, unsigned x, unsigned& nloc, unsigned& nx) {
    const unsigned G = gridDim.x * gridDim.y * gridDim.z;
    unsigned sum, cnt, mine, sp = 0u;
    for (;;) {
        sum = 0u; cnt = 0u; mine = 0u;
#pragma unroll
        for (unsigned j = 0; j < 16; ++j) { const unsigned c = xb_ld(&bar[XB_XCNT(j)]); sum += c; cnt += (c > 0u) ? 1u : 0u; mine = (j == x) ? c : mine; }
        if (sum == G) break;
        __builtin_amdgcn_s_sleep(1);
        if ((++sp & 255u) == 0u) { if (xb_ld(&bar[XB_TMO])) break; if (sp > XB_SPIN_CAP) { atomicAdd(&bar[XB_TMO], 1u); break; } }
    }
    nloc = mine > 0u ? mine : 1u; nx = cnt > 0u ? cnt : 1u;
}
__device__ __forceinline__ void xcd_barrier(const XcdBarrier& b) {
    asm volatile("s_waitcnt vmcnt(0)" ::: "memory");
    __syncthreads();
    if (threadIdx.x == 0) {
        unsigned* bar = b.bar;
        __builtin_amdgcn_s_waitcnt(0);
        unsigned nloc = b.st[0], nx = b.st[1];
        if (nloc == 0u) { xcd_barrier_complete(bar, b.x, nloc, nx); b.st[0] = nloc; b.st[1] = nx; }
        const unsigned old = xb_add(&bar[XB_XSUB(b.x)], 1u);
        const unsigned gen = old / nloc;
        if (old + 1u == (gen + 1u) * nloc) {
            __builtin_amdgcn_fence(__ATOMIC_RELEASE, "agent");
            asm volatile("s_waitcnt vmcnt(0)" ::: "memory");
            const unsigned og = xb_add(&bar[XB_TOP], 1u);
            const unsigned tg = og / nx;
            if (og + 1u == (tg + 1u) * nx) xb_add(&bar[XB_TOPGEN], 1u);
            else XB_SPIN(xb_ld(&bar[XB_TOPGEN]) == tg, bar);
            __builtin_amdgcn_fence(__ATOMIC_ACQUIRE, "agent");
            xb_add(&bar[XB_XGEN(b.x)], 1u);
            asm volatile("s_waitcnt vmcnt(0)" ::: "memory");
        } else {
            XB_SPIN(xb_ld(&bar[XB_XGEN(b.x)]) == gen, bar);
            __builtin_amdgcn_fence(__ATOMIC_ACQUIRE, "agent");
            asm volatile("s_waitcnt vmcnt(0)" ::: "memory");
        }
    }
    __syncthreads();
}

__global__ void __launch_bounds__(512, 2) fwd_kernel(Params p) {
    extern __shared__ __attribute__((aligned(16))) unsigned char smem[];
    cg::grid_group grid = cg::this_grid();
    const int tid = threadIdx.x, lane = tid & 63, wave = tid >> 6;
    const int G = gridDim.x, gw = blockIdx.x * 8 + wave, NGW = G * 8;
    unsigned char* ws = p.ws;
    bf16_t* Wout = (bf16_t*)(ws + WS_WOUT); bf16_t* W1t = (bf16_t*)(ws + WS_W1); bf16_t* W2t = (bf16_t*)(ws + WS_W2); bf16_t* Win = (bf16_t*)(ws + WS_WIN);
    bf16_t* U = (bf16_t*)(ws + WS_U); bf16_t* BIG = (bf16_t*)(ws + WS_BIG); bf16_t* YZ = (bf16_t*)(ws + WS_YZ);
    bf16_t* VTE = (bf16_t*)(ws + WS_VT_E); bf16_t* VTO = (bf16_t*)(ws + WS_VT_O); bf16_t* ST = (bf16_t*)(ws + WS_ST); float* DEC = (float*)(ws + WS_DEC);
    float* SS = (float*)(ws + WS_SS); unsigned* PCNT = (unsigned*)(ws + WS_PCNT); bf16_t* YC = (bf16_t*)p.out;
    float* SSH0 = SS; float* SSH1 = SS + NTOK; float* SSH2 = SS + 2 * NTOK; float* SSH3 = SS + 3 * NTOK;
    float* scr = (float*)(smem + wave * 8448);
    LAS unsigned char* lds = (LAS unsigned char*)smem;
    const int lo = p.ph_lo, hi = p.ph_hi;
#define IN(k) (lo <= (k) && (k) < hi)
#define SEAM(k) do { if (IN(k) && IN((k) + 1)) xcd_barrier(xbar); } while (0)
    if (lo < 0) grid.sync();
    volatile LAS unsigned* xst = (volatile LAS unsigned*)(lds + 131072 + 1024);
    if (tid < 4) xst[tid] = 0u;
    __syncthreads();
    XcdBarrier xbar; xbar.bar = (unsigned*)(ws + WS_BAR); xbar.x = 0; xbar.st = xst;
    if (hi - lo > 1) xbar = xcd_barrier_post((unsigned*)(ws + WS_BAR), xst);

    if (IN(0)) {
        cvt_seg(p.even_w_in, DM, 6144, 0, 5120, Win, 0, p.norm_g, scr, gw, NGW, lane);
        cvt_seg(p.even_w_in, DM, 6144, 5120, 1024, Win, 5120, p.norm_g, scr, gw, NGW, lane);
        cvt_seg(p.even_w_out, DM, DM, 0, DM, Wout, 0, nullptr, scr, gw, NGW, lane);
        cvt_seg(p.w1, DM, DFF, 0, DFF, W1t, 0, p.norm_g + 2 * DM, scr, gw, NGW, lane);
        cvt_seg(p.w2, DFF, DM, 0, DM, W2t, 0, nullptr, scr, gw, NGW, lane);
        rowwise<0>(p.x, nullptr, nullptr, U, SSH0, nullptr, gw, NGW, lane);
    }
    SEAM(0);
    if (IN(1)) {
        { pg8::Gemm g{U, Win, NTOK, LDE, DM}; pg8::StaticOrder S; S.init(NTOK, LDE, G, blockIdx.x); pg8::EpiB<0, 1> E{BIG, LDE, SSH0}; pg8::gemm_phase(lds, g, S, E); }
        { pg8::Gemm g{Win + (size_t)5120 * DM, U, 1024, NTOK, DM}; pg8::StaticOrder S; S.init(1024, NTOK, G, blockIdx.x); pg8::EpiB<0, 2> E{VTE, NTOK, SSH0}; pg8::gemm_phase(lds, g, S, E); }
    }
    SEAM(1);
    if (IN(2)) { conv_phase(BIG, p.conv_w, YC); attn_phase(smem, BIG, VTE, p.rel_bias, YC); }
    SEAM(2);
    if (IN(3)) { pg8::Gemm g{YC, Wout, NTOK, DM, DM}; pg8::PanelOrder S{(int)blockIdx.x}; pg8::EpiRes<false> E{U, nullptr, p.norm_g + 1 * DM, SS + 4 * NTOK, SSH1, PCNT}; pg8::gemm_phase(lds, g, S, E); }
    SEAM(3);
    if (IN(5)) { pg8::Gemm g{U, W1t, NTOK, DFF, DM}; pg8::StaticOrder S; S.init(NTOK, DFF, G, blockIdx.x); pg8::EpiB<1, 1> E{BIG, DFF, SSH1}; pg8::gemm_phase(lds, g, S, E); }
    SEAM(5);
    if (IN(6)) { pg8::Gemm g{BIG, W2t, NTOK, DM, DFF}; pg8::PanelOrder S{(int)blockIdx.x}; pg8::EpiRes<false> E{U, nullptr, p.norm_g + 3 * DM, SS + 5 * NTOK, SSH2, PCNT + 64}; pg8::gemm_phase(lds, g, S, E); }
    SEAM(6);
    if (IN(7)) {
        const float* wi = p.odd_w_in;
        cvt_seg(wi, DM, 7184, 0, 2048, Win, 0, p.norm_g + 4 * DM, scr, gw, NGW, lane);
        cvt_seg(wi, DM, 7184, 3072, 2048, Win, 2048, p.norm_g + 4 * DM, scr, gw, NGW, lane);
        cvt_seg(wi, DM, 7184, 6144, 1040, Win, 4096, p.norm_g + 4 * DM, scr, gw, NGW, lane);
        cvt_seg(wi, DM, 7184, 2048, 1024, Win, 5376, p.norm_g + 4 * DM, scr, gw, NGW, lane);
        cvt_seg(wi, DM, 7184, 5120, 1024, Win, 6400, p.norm_g + 4 * DM, scr, gw, NGW, lane);
        cvt_seg(p.odd_w_out, DM, DM, 0, DM, Wout, 0, nullptr, scr, gw, NGW, lane);
        cvt_seg(p.w1 + (size_t)DM * DFF, DM, DFF, 0, DFF, W1t, 0, p.norm_g + 6 * DM, scr, gw, NGW, lane);
        cvt_seg(p.w2 + (size_t)DM * DFF, DFF, DM, 0, DM, W2t, 0, nullptr, scr, gw, NGW, lane);
    }
    SEAM(7);
    if (IN(8)) {
        { pg8::Gemm g{U, Win, NTOK, 5120, DM}; pg8::StaticOrder S; S.init(NTOK, 5120, G, blockIdx.x); pg8::EpiB<0, 1> E{BIG, LDO, SSH2}; pg8::gemm_phase(lds, g, S, E); }
        { pg8::Gemm g{Win + (size_t)5376 * DM, U, 2048, NTOK, DM}; pg8::StaticOrder S; S.init(2048, NTOK, G, blockIdx.x); pg8::EpiB<0, 2> E{VTO, NTOK, SSH2}; pg8::gemm_phase(lds, g, S, E); }
        if (wave < 4) {
            const int r = lane & 15, q8 = lane >> 4, t0 = (blockIdx.x * 4 + wave) * 16;
            if (t0 < NTOK) {
                const bf16_t* ap = U + (size_t)(t0 + r) * DM + 8 * q8;
                const bf16_t* bp = Win + (size_t)(5120 + r) * DM + 8 * q8;
                f32x4 acc = (f32x4){0.f, 0.f, 0.f, 0.f};
#pragma unroll 8
                for (int kk = 0; kk < DM / 32; ++kk) { const bf16x8 a = *(const bf16x8*)(ap + 32 * kk), b = *(const bf16x8*)(bp + 32 * kk);
                    acc = __builtin_amdgcn_mfma_f32_16x16x32_bf16(a, b, acc, 0, 0, 0); }
#pragma unroll
                for (int j = 0; j < 4; ++j) BIG[(size_t)(t0 + 4 * q8 + j) * LDO + 5120 + r] = f2bf(acc[j] * __builtin_amdgcn_rsqf(SSH2[t0 + 4 * q8 + j] * (1.f / DM) + EPS));
            }
        }
    }
    SEAM(8);
    if (IN(9)) {
        int par = 0;
        { bf16_t ra[16], rq[16]; u32x4 vr[2]; u32x4 gaR = (u32x4){0, 0, 0, 0}; load_raw<0, false>(BIG, VTO, blockIdx.x, ra, rq, vr, gaR);
          for (int it = blockIdx.x; it < 2048; it += G) { passA_item<0>(p, smem, BIG, VTO, ST, DEC, it, par, (it + G < 2048) ? it + G : -1, ra, rq, vr, gaR); par ^= 1; } }
        { bf16_t ra[16], rq[16]; u32x4 vr[4]; u32x4 gaR = (u32x4){0, 0, 0, 0}; load_raw<1, false>(BIG, VTO, blockIdx.x, ra, rq, vr, gaR);
          for (int it = blockIdx.x; it < 1024; it += G) { passA_item<1>(p, smem, BIG, VTO, ST, DEC, it, par, (it + G < 1024) ? it + G : -1, ra, rq, vr, gaR); par ^= 1; } }
    }
    SEAM(9);
    if (IN(10)) scan_phase(ST, DEC);
    SEAM(10);
    if (IN(11)) {
        { bf16_t ra[16], rq[16]; u32x4 vr[2]; u32x4 gaR = (u32x4){0, 0, 0, 0}; load_raw<0, true>(BIG, VTO, blockIdx.x, ra, rq, vr, gaR);
          for (int it = blockIdx.x; it < 2048; it += G) passC_item<0>(p, smem, BIG, VTO, ST, YC, it, (it + G < 2048) ? it + G : -1, ra, rq, vr, gaR); }
        { bf16_t ra[16], rq[16]; u32x4 vr[4]; u32x4 gaR = (u32x4){0, 0, 0, 0}; load_raw<1, true>(BIG, VTO, blockIdx.x, ra, rq, vr, gaR);
          for (int it = blockIdx.x; it < 1024; it += G) passC_item<1>(p, smem, BIG, VTO, ST, YC, it, (it + G < 1024) ? it + G : -1, ra, rq, vr, gaR); }
    }
    SEAM(11);
    if (IN(12)) { pg8::Gemm g{YC, Wout, NTOK, DM, DM}; pg8::PanelOrder S{(int)blockIdx.x}; pg8::EpiRes<false> E{U, nullptr, p.norm_g + 5 * DM, SS + 6 * NTOK, SSH3, PCNT + 128}; pg8::gemm_phase(lds, g, S, E); }
    SEAM(12);
    if (IN(14)) { pg8::Gemm g{U, W1t, NTOK, DFF, DM}; pg8::StaticOrder S; S.init(NTOK, DFF, G, blockIdx.x); pg8::EpiB<1, 1> E{BIG, DFF, SSH3}; pg8::gemm_phase(lds, g, S, E); }
    SEAM(14);
    if (IN(15)) { pg8::Gemm g{BIG, W2t, NTOK, DM, DFF}; pg8::PanelOrder S{(int)blockIdx.x}; pg8::EpiRes<true> E{U, p.out, p.norm_g + 7 * DM, SS + 7 * NTOK, nullptr, PCNT + 192}; pg8::gemm_phase(lds, g, S, E); }
#undef IN
#undef SEAM
}

constexpr int NPHASE = 17;

extern "C" void kernel_launch(void* const* d_in, const int* in_sizes, int n_in, void* d_out, int out_size, void* d_ws, size_t ws_size, hipStream_t stream) {
    static int grid = 0;
    if (grid == 0) {
        if (ws_size < WS_END) fprintf(stderr, "kernel_launch: workspace too small: %zu < %zu\n", ws_size, (size_t)WS_END);
        int dev = 0, cus = 0, per_cu = 0;
        hipGetDevice(&dev);
        hipDeviceGetAttribute(&cus, hipDeviceAttributeMultiprocessorCount, dev);
        if (hipFuncSetAttribute((const void*)fwd_kernel, hipFuncAttributeMaxDynamicSharedMemorySize, LDS_BYTES) != hipSuccess) fprintf(stderr, "kernel_launch: hipFuncSetAttribute failed\n");
        if (hipOccupancyMaxActiveBlocksPerMultiprocessor(&per_cu, (const void*)fwd_kernel, 512, LDS_BYTES) != hipSuccess || per_cu < 1) { per_cu = 1; (void)hipGetLastError(); }
        grid = cus * (per_cu > 1 ? 1 : per_cu);
        if (grid <= 0) grid = 256;
    }
    Params p{};
    p.x = (const float*)d_in[0]; p.norm_g = (const float*)d_in[1]; p.even_w_in = (const float*)d_in[2]; p.conv_w = (const float*)d_in[3];
    p.rel_bias = (const float*)d_in[4]; p.even_w_out = (const float*)d_in[5]; p.odd_w_in = (const float*)d_in[6]; p.hgrn_lb = (const float*)d_in[7];
    p.hgrn_ng = (const float*)d_in[8]; p.wa2 = (const float*)d_in[9]; p.ba = (const float*)d_in[10]; p.gla_ng = (const float*)d_in[11];
    p.odd_w_out = (const float*)d_in[12]; p.w1 = (const float*)d_in[13]; p.w2 = (const float*)d_in[14];
    p.out = (float*)d_out; p.ws = (unsigned char*)d_ws;
#if ONE_LAUNCH
    (void)hipMemsetAsync((unsigned char*)d_ws + WS_BAR, 0, WS_ZERO_BYTES, stream);
    p.ph_lo = 0; p.ph_hi = NPHASE;
    void* args[] = {&p};
    hipError_t e = hipLaunchCooperativeKernel((const void*)fwd_kernel, dim3(grid), dim3(512), args, LDS_BYTES, stream);
    if (e != hipSuccess) fprintf(stderr, "cooperative launch failed: %s (grid %d)\n", hipGetErrorString(e), grid);
#else
    for (int k = 0; k < NPHASE; ++k) {
        p.ph_lo = k; p.ph_hi = k + 1;
        hipLaunchKernelGGL(fwd_kernel, dim3(grid), dim3(512), LDS_BYTES, stream, p);
    }
#endif
}
```

```cpp
#include <hip/hip_runtime.h>
#include <hip/hip_cooperative_groups.h>
#include <cstdio>
namespace cg = cooperative_groups;

#ifndef ONE_LAUNCH
#define ONE_LAUNCH 1
#endif

typedef unsigned short bf16_t;
typedef short bf16x8 __attribute__((ext_vector_type(8)));
typedef float f32x4 __attribute__((ext_vector_type(4)));
typedef unsigned u32x4 __attribute__((ext_vector_type(4)));
typedef unsigned u32x2 __attribute__((ext_vector_type(2)));
#define LAS __attribute__((address_space(3)))

constexpr int DM = 2048, NTOK = 16384, SEQ = 4096, DFF = 8192;
constexpr int LDE = 5120;
constexpr int LDO = 5376;
constexpr float EPS = 1e-6f;

constexpr size_t WS_WOUT = 0;
constexpr size_t WS_W1 = 8388608;
constexpr size_t WS_W2 = WS_W1 + 33554432;
constexpr size_t WS_U = WS_W2 + 33554432;
constexpr size_t WS_BIG = WS_U + 67108864;
constexpr size_t WS_WIN = WS_BIG + 268435456;
constexpr size_t WS_YZ = WS_WIN + 30408704;
constexpr size_t WS_VT_E = WS_BIG + (size_t)NTOK * LDE * 2;
constexpr size_t WS_VT_O = WS_BIG + (size_t)NTOK * LDO * 2;
constexpr size_t WS_ST = WS_VT_O + 67108864;
constexpr size_t WS_DEC = WS_ST + 134217728;
constexpr size_t WS_BAR = WS_DEC + 3072 * 128 * 4;
constexpr size_t WS_SS = WS_BAR + 16384;
constexpr size_t WS_PCNT = WS_SS + 8 * 65536;
constexpr size_t WS_END = WS_PCNT + 4096;
constexpr size_t WS_ZERO_BYTES = WS_END - WS_BAR;

constexpr int LDS_BYTES = 131072 + 4096;

__device__ __forceinline__ float bf2f(bf16_t v) { return __uint_as_float(((unsigned)v) << 16); }
typedef float f32x2 __attribute__((ext_vector_type(2)));
typedef __bf16 bf16x2v __attribute__((ext_vector_type(2)));
__device__ __forceinline__ unsigned pk2(float lo, float hi) { f32x2 v = {lo, hi}; bf16x2v b = __builtin_convertvector(v, bf16x2v); return __builtin_bit_cast(unsigned, b); }
__device__ __forceinline__ bf16_t f2bf(float f) { return __builtin_bit_cast(bf16_t, (__bf16)f); }
__device__ __forceinline__ float wave_sum(float v) {
#pragma unroll
    for (int o = 1; o < 64; o <<= 1) v += __shfl_xor(v, o);
    return v;
}
__device__ __forceinline__ float frcp(float x) { return __builtin_amdgcn_rcpf(x); }
__device__ __forceinline__ float sigmoidf_(float x) { return frcp(1.f + __expf(-x)); }
#define LDS_WAIT() asm volatile("s_waitcnt lgkmcnt(0)" ::: "memory")
__device__ __forceinline__ float dpp_f(float v, int ctrl_sel) {
    const int x = __float_as_int(v); int y;
    if (ctrl_sel == 0) y = __builtin_amdgcn_update_dpp(x, x, 0xB1, 0xF, 0xF, false);
    else if (ctrl_sel == 1) y = __builtin_amdgcn_update_dpp(x, x, 0x4E, 0xF, 0xF, false);
    else if (ctrl_sel == 2) y = __builtin_amdgcn_update_dpp(x, x, 0x141, 0xF, 0xF, false);
    else y = __builtin_amdgcn_update_dpp(x, x, 0x140, 0xF, 0xF, false);
    return __int_as_float(y);
}
__device__ __forceinline__ float row16_max(float v) { v = fmaxf(v, dpp_f(v, 0)); v = fmaxf(v, dpp_f(v, 1)); v = fmaxf(v, dpp_f(v, 2)); v = fmaxf(v, dpp_f(v, 3)); return v; }
__device__ __forceinline__ float row16_sum(float v) { v += dpp_f(v, 0); v += dpp_f(v, 1); v += dpp_f(v, 2); v += dpp_f(v, 3); return v; }

namespace pg8 {
constexpr int BM = 256, BK = 64, HALF = 128, HTB = HALF * BK * 2, STAGE_BYTES = 8 * HTB, NXCD = 8, WGM = 8;
__host__ __device__ __forceinline__ int lds_byte(int r, int c) { const int st = (r >> 4) * 2 + (c >> 5), rr = r & 15, cc = c & 31, ob = rr * 64 + cc * 2; return st * 1024 + (ob ^ (((ob >> 9) & 1) << 5)); }
__host__ __device__ __forceinline__ void stage_rc(int b, int& R, int& C) { const int st = b / 1024, sb = b % 1024, swz = sb ^ (((sb >> 9) & 1) << 5); R = (st >> 1) * 16 + swz / 64; C = (st & 1) * 32 + (swz % 64) / 2; }
__host__ __device__ __forceinline__ int perm32(int rho) { const int n = rho >> 4, i = rho & 15; return 8 * (i >> 2) + 4 * n + (i & 3); }
struct Unit { int pm, pn; };
struct Gemm { const bf16_t* A; const bf16_t* Bt; int M, N, K; };
struct StaticOrder {
    int nM, nN, nwg, G, c;
    __device__ void init(int M, int N, int G_, int c_) { nM = M / BM; nN = N / BM; nwg = nM * nN; G = G_; c = c_; }
    __device__ bool next(int i, Unit& u) const {
        const long L = (long)i * G + c; if (L >= nwg) return false;
        int wgid = (int)L; { const int q = nwg / NXCD, r = nwg % NXCD, xcd = wgid % NXCD, off = wgid / NXCD; wgid = (xcd < r ? xcd * (q + 1) : r * (q + 1) + (xcd - r) * q) + off; }
        const int nig = WGM * nN, gid = wgid / nig, fm = gid * WGM, gsz = (nM - fm) < WGM ? (nM - fm) : WGM;
        u.pm = fm + ((wgid % nig) % gsz); u.pn = (wgid % nig) / gsz; return true;
    }
};
template <int ACT, int RS> struct EpiB {
    static constexpr bool PERM = true;
    bf16_t* O; int ldc; const float* rs;
    __device__ __forceinline__ void load_rs(const Unit& u, int wr, int fr, float (&rsv)[8]) const {
        if (RS == 1) {
#pragma unroll
            for (int q = 0; q < 8; ++q) rsv[q] = __builtin_amdgcn_rsqf(rs[u.pm * BM + wr * 64 + fr + (q >> 2) * HALF + (q & 3) * 16] * (1.f / 2048.f) + 1e-6f); }
    }
    __device__ __forceinline__ void operator()(const f32x4 (&acc)[2][2][4][2], const Unit& u, int wr, int wc, int fr, int fq, const float (&rsv)[8]) const {
        const int row0 = u.pm * BM + wr * 64 + fr, col0 = u.pn * BM + wc * 32 + 8 * fq;
        f32x4 cs[2][2];
        if (RS == 2) {
#pragma unroll
            for (int bj = 0; bj < 2; ++bj) { cs[bj][0] = *(const f32x4*)(rs + col0 + bj * HALF); cs[bj][1] = *(const f32x4*)(rs + col0 + bj * HALF + 4);
#pragma unroll
                for (int e = 0; e < 4; ++e) { cs[bj][0][e] = __builtin_amdgcn_rsqf(cs[bj][0][e] * (1.f / 2048.f) + 1e-6f); cs[bj][1][e] = __builtin_amdgcn_rsqf(cs[bj][1][e] * (1.f / 2048.f) + 1e-6f); } } }
#pragma unroll
        for (int ai = 0; ai < 2; ++ai)
#pragma unroll
            for (int m = 0; m < 4; ++m) { const int row = row0 + ai * HALF + m * 16; bf16_t* rowp = O + (size_t)row * ldc + col0;
                float rsc = 1.f; if (RS == 1) rsc = rsv[ai * 4 + m];
#pragma unroll
                for (int bj = 0; bj < 2; ++bj) { f32x4 v0 = acc[ai][bj][m][0], v1 = acc[ai][bj][m][1];
                    if (RS == 1) { v0 *= rsc; v1 *= rsc; }
                    if (RS == 2) { v0 *= cs[bj][0]; v1 *= cs[bj][1]; }
                    if (ACT == 1) {
#pragma unroll
                        for (int j = 0; j < 4; ++j) { float a = fmaxf(v0[j], 0.f), b = fmaxf(v1[j], 0.f); v0[j] = a * a; v1[j] = b * b; } }
                    u32x4 w; w.x = pk2(v0[0], v0[1]); w.y = pk2(v0[2], v0[3]); w.z = pk2(v1[0], v1[1]); w.w = pk2(v1[2], v1[3]);
                    *(u32x4*)(rowp + bj * HALF) = w; } }
    }
};

struct PanelOrder {
    int c;
    __device__ bool next(int i, Unit& u) const { if (i >= 2) return false; const int x = c & 7, k = c >> 3; u.pm = i * 32 + x * 4 + (k >> 3); u.pn = k & 7; return true; }
};
template <bool FINAL> struct EpiRes {
    static constexpr bool PERM = true;
    bf16_t* hb; float* out; const float* g1; float* ssY; float* ssH; unsigned* cnt;
    __device__ __forceinline__ void load_rs(const Unit&, int, int, float (&)[8]) const {}
    __device__ __forceinline__ void operator()(const f32x4 (&acc)[2][2][4][2], const Unit& u, int wr, int wc, int fr, int fq, const float (&)[8]) const {
        const int row0 = u.pm * BM + wr * 64 + fr, col0 = u.pn * BM + wc * 32 + 8 * fq;
#pragma unroll
        for (int q = 0; q < 8; ++q) { const int ai = q >> 2, m = q & 3; float sq = 0.f;
#pragma unroll
            for (int bj = 0; bj < 2; ++bj)
#pragma unroll
                for (int n = 0; n < 2; ++n)
#pragma unroll
                    for (int e = 0; e < 4; ++e) sq += acc[ai][bj][m][n][e] * acc[ai][bj][m][n][e];
            sq += __shfl_xor(sq, 16); sq += __shfl_xor(sq, 32);
            if (fq == 0) (void)__hip_atomic_fetch_add(ssY + row0 + ai * HALF + m * 16, sq, __ATOMIC_RELAXED, __HIP_MEMORY_SCOPE_AGENT); }
        asm volatile("s_waitcnt vmcnt(0)" ::: "memory");
        __builtin_amdgcn_s_barrier();
        if (threadIdx.x == 0) {
            (void)__hip_atomic_fetch_add(cnt + u.pm, 1u, __ATOMIC_RELAXED, __HIP_MEMORY_SCOPE_AGENT);
            unsigned sp = 0;
            while (__hip_atomic_load(cnt + u.pm, __ATOMIC_RELAXED, __HIP_MEMORY_SCOPE_AGENT) < 8u) { __builtin_amdgcn_s_sleep(1); if (++sp > (1u << 22)) break; }
        }
        asm volatile("" ::: "memory");
        __builtin_amdgcn_s_barrier();
        asm volatile("" ::: "memory");
        f32x4 gv[2][2];
#pragma unroll
        for (int bj = 0; bj < 2; ++bj) { gv[bj][0] = *(const f32x4*)(g1 + col0 + bj * HALF); gv[bj][1] = *(const f32x4*)(g1 + col0 + bj * HALF + 4); }
#pragma unroll
        for (int q = 0; q < 8; ++q) { const int ai = q >> 2, m = q & 3, row = row0 + ai * HALF + m * 16;
            const float rs1 = __builtin_amdgcn_rsqf(__hip_atomic_load(ssY + row, __ATOMIC_RELAXED, __HIP_MEMORY_SCOPE_AGENT) * (1.f / 2048.f) + 1e-6f);
            bf16_t* rowp = hb + (size_t)row * 2048 + col0; float s2 = 0.f;
#pragma unroll
            for (int bj = 0; bj < 2; ++bj) { const u32x4 hw = *(const u32x4*)(rowp + bj * HALF);
                f32x4 h0, h1;
                h0[0] = __uint_as_float(hw[0] << 16); h0[1] = __uint_as_float(hw[0] & 0xffff0000u); h0[2] = __uint_as_float(hw[1] << 16); h0[3] = __uint_as_float(hw[1] & 0xffff0000u);
                h1[0] = __uint_as_float(hw[2] << 16); h1[1] = __uint_as_float(hw[2] & 0xffff0000u); h1[2] = __uint_as_float(hw[3] << 16); h1[3] = __uint_as_float(hw[3] & 0xffff0000u);
                h0 += acc[ai][bj][m][0] * rs1 * gv[bj][0]; h1 += acc[ai][bj][m][1] * rs1 * gv[bj][1];
                if (FINAL) { float* op = out + (size_t)row * 2048 + col0 + bj * HALF; *(f32x4*)op = h0; *(f32x4*)(op + 4) = h1; }
                else {
#pragma unroll
                    for (int e = 0; e < 4; ++e) s2 += h0[e] * h0[e] + h1[e] * h1[e];
                    u32x4 w; w.x = pk2(h0[0], h0[1]); w.y = pk2(h0[2], h0[3]); w.z = pk2(h1[0], h1[1]); w.w = pk2(h1[2], h1[3]);
                    *(u32x4*)(rowp + bj * HALF) = w; } }
            if (!FINAL) { s2 += __shfl_xor(s2, 16); s2 += __shfl_xor(s2, 32);
                if (fq == 0) (void)__hip_atomic_fetch_add(ssH + row, s2, __ATOMIC_RELAXED, __HIP_MEMORY_SCOPE_AGENT); } }
    }
};

template <class Epi, class Sched>
__device__ __forceinline__ void gemm_phase(LAS unsigned char* lds, const Gemm g, const Sched& S, const Epi& E) {
    const int tid = threadIdx.x, wid = __builtin_amdgcn_readfirstlane(tid >> 6), lane = tid & 63, wr = wid >> 2, wc = wid & 3, fr = lane & 15, fq = lane >> 4;
    const int K = g.K, nt = K / BK;
    unsigned voffA[2], voffB[2];
#pragma unroll
    for (int i = 0; i < 2; ++i) { int R, C; stage_rc(tid * 16 + i * 8192, R, C); const int Rb = Epi::PERM ? ((R & ~31) + perm32(R & 31)) : R;
        voffA[i] = (unsigned)(R * K + C) * 2u; voffB[i] = (unsigned)(Rb * K + C) * 2u; }
    const size_t kstep = (size_t)(BK * 2);
    const size_t hstep = (size_t)HALF * K * 2;
    const size_t tstep = 2 * hstep;
    const unsigned ldsw = (unsigned)wid * 1024u;
    const int aoff = lds_byte(wr * 64 + fr, fq * 8), boff = lds_byte(wc * 32 + fr, fq * 8);
#define PG8_SA(b, h) (((b) * 2 + (h)) * HTB)
#define PG8_SB(b, h) ((4 + (b) * 2 + (h)) * HTB)
#define PG8_STAGE(bufoff, gbase, voff) do { _Pragma("unroll") for (int _i = 0; _i < 2; ++_i) \
        __builtin_amdgcn_global_load_lds((const unsigned*)((const char*)(gbase) + (voff)[_i]), (LAS unsigned*)(lds + (bufoff) + ldsw + _i * 8192), 16, 0, 0); } while (0)
#define PG8_LDA(dst, b, h) do { _Pragma("unroll") for (int m = 0; m < 4; ++m) _Pragma("unroll") for (int k = 0; k < 2; ++k) dst[m][k] = *(const LAS bf16x8*)(lds + PG8_SA(b, h) + aoff + m * 2048 + k * 1024); } while (0)
#define PG8_LDB(dst, b, h) do { _Pragma("unroll") for (int n = 0; n < 2; ++n) _Pragma("unroll") for (int k = 0; k < 2; ++k) dst[n][k] = *(const LAS bf16x8*)(lds + PG8_SB(b, h) + boff + n * 2048 + k * 1024); } while (0)
#define PG8_MMA(ai, bj, At, Bt) do { __builtin_amdgcn_s_setprio(1); _Pragma("unroll") for (int m = 0; m < 4; ++m) _Pragma("unroll") for (int n = 0; n < 2; ++n) _Pragma("unroll") for (int k = 0; k < 2; ++k) \
        acc[ai][bj][m][n] = __builtin_amdgcn_mfma_f32_16x16x32_bf16(Bt[n][k], At[m][k], acc[ai][bj][m][n], 0, 0, 0); __builtin_amdgcn_s_setprio(0); } while (0)
#define PG8_WAIT_V(n) asm volatile("s_waitcnt vmcnt(" #n ")" ::: "memory")
#define PG8_WAIT_L(n) asm volatile("s_waitcnt lgkmcnt(" #n ")" ::: "memory")
#define PG8_BAR __builtin_amdgcn_s_barrier()
#define PG8_SCHED __builtin_amdgcn_sched_barrier(0)
    Unit cur, nxt; int ui = 0;
    if (!S.next(0, cur)) return;
    f32x4 acc[2][2][4][2];
#pragma unroll
    for (int a = 0; a < 2; ++a)
#pragma unroll
        for (int b = 0; b < 2; ++b)
#pragma unroll
            for (int m = 0; m < 4; ++m)
#pragma unroll
                for (int n = 0; n < 2; ++n) acc[a][b][m][n] = (f32x4){0.f, 0.f, 0.f, 0.f};
    bf16x8 At[4][2], B0[2][2], B1[2][2];
    const char* cA = (const char*)g.A + (size_t)cur.pm * tstep; const char* cB = (const char*)g.Bt + (size_t)cur.pn * tstep;
    float rsv[8] = {1.f, 1.f, 1.f, 1.f, 1.f, 1.f, 1.f, 1.f};
    E.load_rs(cur, wr, fr, rsv);
    PG8_STAGE(PG8_SB(0, 0), cB, voffB); PG8_STAGE(PG8_SB(0, 1), cB + hstep, voffB); PG8_STAGE(PG8_SA(0, 0), cA, voffA); PG8_STAGE(PG8_SA(0, 1), cA + hstep, voffA);
    if (wr == 1) PG8_BAR;
    PG8_WAIT_V(2); PG8_BAR;
    PG8_STAGE(PG8_SB(1, 0), cB + kstep, voffB); PG8_STAGE(PG8_SA(1, 0), cA + kstep, voffA); PG8_STAGE(PG8_SB(1, 1), cB + hstep + kstep, voffB);
    PG8_WAIT_V(6); PG8_BAR;
    for (;;) {
        const bool has_next = S.next(ui + 1, nxt);
        const char* nA = has_next ? (const char*)g.A + (size_t)nxt.pm * tstep : cA; const char* nB = has_next ? (const char*)g.Bt + (size_t)nxt.pn * tstep : cB;
        for (int t = 0; t < nt; t += 2) {
            const bool last = (t == nt - 2);
            const char* a1 = cA + (size_t)(t + 1) * kstep;
            const char* a2 = last ? nA : cA + (size_t)(t + 2) * kstep; const char* b2 = last ? nB : cB + (size_t)(t + 2) * kstep;
            const char* a3 = a2 + kstep; const char* b3 = b2 + kstep;
            PG8_LDB(B0, 0, 0); PG8_LDB(B1, 0, 1); PG8_SCHED; PG8_LDA(At, 0, 0); PG8_STAGE(PG8_SA(1, 1), a1 + hstep, voffA);
            PG8_WAIT_V(8); PG8_WAIT_L(0); PG8_BAR; PG8_MMA(0, 0, At, B0); PG8_MMA(0, 1, At, B1); PG8_BAR; PG8_SCHED;
            PG8_LDA(At, 0, 1); PG8_STAGE(PG8_SB(0, 0), b2, voffB); PG8_STAGE(PG8_SB(0, 1), b2 + hstep, voffB); PG8_STAGE(PG8_SA(0, 0), a2, voffA);
            PG8_WAIT_V(8); PG8_WAIT_L(0); PG8_BAR; PG8_MMA(1, 0, At, B0); PG8_MMA(1, 1, At, B1); PG8_BAR; PG8_SCHED;
            PG8_LDB(B0, 1, 0); PG8_LDB(B1, 1, 1); PG8_SCHED; PG8_LDA(At, 1, 0); PG8_STAGE(PG8_SA(0, 1), a2 + hstep, voffA);
            PG8_WAIT_V(8); PG8_WAIT_L(0); PG8_BAR; PG8_MMA(0, 0, At, B0); PG8_MMA(0, 1, At, B1); PG8_BAR; PG8_SCHED;
            PG8_LDA(At, 1, 1); PG8_STAGE(PG8_SB(1, 0), b3, voffB); PG8_STAGE(PG8_SB(1, 1), b3 + hstep, voffB); PG8_STAGE(PG8_SA(1, 0), a3, voffA);
            PG8_WAIT_V(8); PG8_WAIT_L(0); PG8_BAR; PG8_MMA(1, 0, At, B0); PG8_MMA(1, 1, At, B1); PG8_BAR; PG8_SCHED;
        }
        if (wr == 0) PG8_BAR;
        E(acc, cur, wr, wc, fr, fq, rsv);
        if (!has_next) break;
        E.load_rs(nxt, wr, fr, rsv);
#pragma unroll
        for (int a = 0; a < 2; ++a)
#pragma unroll
            for (int b = 0; b < 2; ++b)
#pragma unroll
                for (int m = 0; m < 4; ++m)
#pragma unroll
                    for (int n = 0; n < 2; ++n) acc[a][b][m][n] = (f32x4){0.f, 0.f, 0.f, 0.f};
        cur = nxt; cA = nA; cB = nB; ++ui;
        if (wr == 1) PG8_BAR;
    }
    PG8_WAIT_V(0);
    PG8_BAR;
#undef PG8_SA
#undef PG8_SB
#undef PG8_STAGE
#undef PG8_LDA
#undef PG8_LDB
#undef PG8_MMA
#undef PG8_WAIT_V
#undef PG8_WAIT_L
#undef PG8_BAR
#undef PG8_SCHED
}
}

struct Params {
    const float* x; const float* norm_g; const float* even_w_in; const float* conv_w; const float* rel_bias; const float* even_w_out;
    const float* odd_w_in; const float* hgrn_lb; const float* hgrn_ng; const float* wa2; const float* ba; const float* gla_ng; const float* odd_w_out;
    const float* w1; const float* w2; float* out; unsigned char* ws; int ph_lo, ph_hi;
};

__device__ __forceinline__ void cvt_seg(const float* __restrict__ W, int K, int NS, int c0, int nc, bf16_t* __restrict__ WT, int r0, const float* __restrict__ gf, float* scr, int gw, int NGW, int lane) {
    const int nblk = (nc + 31) >> 5, nitems = (K >> 6) * nblk;
    const int krow = lane >> 3, c4 = (lane & 7) * 4;
    for (int it = gw; it < nitems; it += NGW) {
        const int kb = it / nblk, nb = it - kb * nblk, k0 = kb * 64, n0 = nb * 32;
        const bool ok = (n0 + c4) < nc;
        const float* src = W + (size_t)(k0 + krow) * NS + c0 + n0 + c4;
        f32x4 v[8];
#pragma unroll
        for (int i = 0; i < 8; ++i) v[i] = ok ? __builtin_nontemporal_load((const f32x4*)(src + (size_t)(8 * i) * NS)) : (f32x4){0.f, 0.f, 0.f, 0.f};
        if (gf) {
#pragma unroll
            for (int i = 0; i < 8; ++i) v[i] *= gf[k0 + 8 * i + krow]; }
#pragma unroll
        for (int i = 0; i < 8; ++i) { float* d = scr + (8 * i + krow) * 33 + c4; d[0] = v[i][0]; d[1] = v[i][1]; d[2] = v[i][2]; d[3] = v[i][3]; }
        LDS_WAIT();
        const int c = lane & 7;
#pragma unroll
        for (int j = 0; j < 4; ++j) { const int n = (lane >> 3) + 8 * j; const float* s = scr + (8 * c) * 33 + n;
            u32x4 o; o.x = pk2(s[0], s[33]); o.y = pk2(s[66], s[99]); o.z = pk2(s[132], s[165]); o.w = pk2(s[198], s[231]);
            if (n0 + n < nc) *(u32x4*)(WT + (size_t)(r0 + n0 + n) * K + k0 + 8 * c) = o; }
        LDS_WAIT();
    }
}

template <int MODE>
__device__ __forceinline__ void rowwise(const float* __restrict__ xin, const bf16_t* __restrict__ ysrc, const float* __restrict__ g1,
                                        bf16_t* hb, float* __restrict__ rsout, float* __restrict__ out, int gw, int NGW, int lane) {
    for (int row0 = gw; row0 < NTOK; row0 += 2 * NGW) {
        f32x4 h[2][4][2]; u32x4 yw[2][4], hw[2][4];
#pragma unroll
        for (int rr = 0; rr < 2; ++rr) { const size_t rb = (size_t)(row0 + rr * NGW) * DM;
#pragma unroll
            for (int j = 0; j < 4; ++j) { const int col = 512 * j + 8 * lane;
                if (MODE == 0) { h[rr][j][0] = __builtin_nontemporal_load((const f32x4*)(xin + rb + col)); h[rr][j][1] = __builtin_nontemporal_load((const f32x4*)(xin + rb + col + 4)); }
                else { hw[rr][j] = *(const u32x4*)(hb + rb + col); yw[rr][j] = *(const u32x4*)(ysrc + rb + col); } } }
#pragma unroll
        for (int rr = 0; rr < 2; ++rr) {
            const int row = row0 + rr * NGW; const size_t rb = (size_t)row * DM;
            if (MODE != 0) {
                float y[4][8]; float ss = 0.f;
#pragma unroll
                for (int j = 0; j < 4; ++j) {
#pragma unroll
                    for (int e = 0; e < 4; ++e) { y[j][2 * e] = __uint_as_float(yw[rr][j][e] << 16); y[j][2 * e + 1] = __uint_as_float(yw[rr][j][e] & 0xffff0000u);
                        h[rr][j][e >> 1][(2 * e) & 3] = __uint_as_float(hw[rr][j][e] << 16); h[rr][j][e >> 1][(2 * e + 1) & 3] = __uint_as_float(hw[rr][j][e] & 0xffff0000u); }
#pragma unroll
                    for (int e = 0; e < 8; ++e) ss += y[j][e] * y[j][e]; }
                const float rs = rsqrtf(wave_sum(ss) * (1.f / DM) + EPS);
#pragma unroll
                for (int j = 0; j < 4; ++j) { const int col = 512 * j + 8 * lane; const f32x4 ga = *(const f32x4*)(g1 + col), gb = *(const f32x4*)(g1 + col + 4);
#pragma unroll
                    for (int e = 0; e < 4; ++e) { h[rr][j][0][e] += y[j][e] * rs * ga[e]; h[rr][j][1][e] += y[j][4 + e] * rs * gb[e]; }
                    if (MODE == 2) { *(f32x4*)(out + rb + col) = h[rr][j][0]; *(f32x4*)(out + rb + col + 4) = h[rr][j][1]; } }
            }
            if (MODE != 2) {
                float ss = 0.f;
#pragma unroll
                for (int j = 0; j < 4; ++j)
#pragma unroll
                    for (int e = 0; e < 4; ++e) ss += h[rr][j][0][e] * h[rr][j][0][e] + h[rr][j][1][e] * h[rr][j][1][e];
                const float sst = wave_sum(ss);
                if (lane == 0) rsout[row] = sst;
#pragma unroll
                for (int j = 0; j < 4; ++j) { const int col = 512 * j + 8 * lane;
                    u32x4 o; o.x = pk2(h[rr][j][0][0], h[rr][j][0][1]); o.y = pk2(h[rr][j][0][2], h[rr][j][0][3]);
                    o.z = pk2(h[rr][j][1][0], h[rr][j][1][1]); o.w = pk2(h[rr][j][1][2], h[rr][j][1][3]);
                    *(u32x4*)(hb + rb + col) = o; }
            }
        }
    }
}

__device__ __forceinline__ void conv_phase(const bf16_t* __restrict__ P, const float* __restrict__ cw, bf16_t* __restrict__ ycat) {
    const int nthr = gridDim.x * 512;
#pragma unroll 2
    for (int it = blockIdx.x * 512 + threadIdx.x; it < NTOK * 128; it += nthr) {
        const int t = it >> 7, c0 = (it & 127) * 8, tp = t & (SEQ - 1);
        const bf16_t* row = P + (size_t)t * LDE + c0;
        const u32x4 bg = *(const u32x4*)(row), c2 = *(const u32x4*)(row + 1024), h2 = *(const u32x4*)(row + 2048);
        u32x4 c1 = (u32x4){0, 0, 0, 0}, h1 = c1, cz = c1, hz = c1;
        if (tp >= 1) { c1 = *(const u32x4*)(row - LDE + 1024); h1 = *(const u32x4*)(row - LDE + 2048); }
        if (tp >= 2) { cz = *(const u32x4*)(row - 2 * LDE + 1024); hz = *(const u32x4*)(row - 2 * LDE + 2048); }
        float o[8];
#pragma unroll
        for (int e = 0; e < 8; ++e) {
            const int sh = (e & 1) ? 0 : 16; const int w = e >> 1;
            auto get = [&](const u32x4& v) { return __uint_as_float((v[w] << sh) & 0xffff0000u); };
            const float u2 = get(c2) * get(h2), u1 = get(c1) * get(h1), u0 = get(cz) * get(hz);
            const float y = cw[c0 + e] * u0 + cw[1024 + c0 + e] * u1 + cw[2048 + c0 + e] * u2;
            o[e] = get(bg) * y;
        }
        u32x4 w; w.x = pk2(o[0], o[1]); w.y = pk2(o[2], o[3]); w.z = pk2(o[4], o[5]); w.w = pk2(o[6], o[7]);
        *(u32x4*)(ycat + (size_t)t * DM + c0) = w;
    }
}

__device__ __forceinline__ void attn_phase(unsigned char* smem, const bf16_t* __restrict__ P, const bf16_t* __restrict__ VT, const float* __restrict__ relb, bf16_t* __restrict__ ycat) {
    const int tid = threadIdx.x, lane = tid & 63, wave = tid >> 6, half = wave >> 2, w4 = wave & 3, ltid = tid & 255, r = lane & 15, q8 = lane >> 4;
    unsigned char* base = smem + half * 47616;
    bf16_t* kS = (bf16_t*)base;
    bf16_t* vS = (bf16_t*)(base + 17408);
    bf16_t* pS = (bf16_t*)(base + 35840);
    float* bS = (float*)(base + 45056);
    const float scale = 0.08838834764831845f * 1.4426950408889634f;
    for (int pair = blockIdx.x; pair < 1024; pair += gridDim.x) {
        const int hp = pair & 3, n = (pair >> 2) & 63, b = pair >> 8, head = hp * 2 + half;
        const int tok0 = b * SEQ + n * 64;
        __syncthreads();
        for (int i = ltid; i < 640; i += 256) bS[i] = relb[head * 320 + (i < 319 ? i : 319)] * 1.4426950408889634f;
        bf16x8 qf[4];
        { const bf16_t* qp = P + (size_t)(tok0 + 16 * w4 + r) * LDE + 3072 + head * 128 + 8 * q8;
#pragma unroll
          for (int kk = 0; kk < 4; ++kk) qf[kk] = *(const bf16x8*)(qp + 32 * kk); }
        float m[4], l[4]; f32x4 o[8];
#pragma unroll
        for (int j = 0; j < 4; ++j) { m[j] = -1e30f; l[j] = 0.f; }
#pragma unroll
        for (int i = 0; i < 8; ++i) o[i] = (f32x4){0.f, 0.f, 0.f, 0.f};
        const int js0 = (n < 8 ? 8 - n : 0);
        u32x4 kreg[4], vreg[4];
        { const int ktok0 = tok0 + (js0 - 8) * 64;
#pragma unroll
          for (int i = 0; i < 4; ++i) { const int ch = ltid + 256 * i;
              kreg[i] = *(const u32x4*)(P + (size_t)(ktok0 + (ch >> 4)) * LDE + 4096 + head * 128 + (ch & 15) * 8);
              vreg[i] = *(const u32x4*)(VT + (size_t)(head * 128 + (ch >> 3)) * NTOK + ktok0 + (ch & 7) * 8); } }
        for (int js = js0; js <= 8; ++js) {
            __syncthreads();
#pragma unroll
            for (int i = 0; i < 4; ++i) { const int ch = ltid + 256 * i;
                *(u32x4*)(kS + (ch >> 4) * 136 + (ch & 15) * 8) = kreg[i];
                *(u32x4*)(vS + (ch >> 3) * 72 + (ch & 7) * 8) = vreg[i]; }
            __syncthreads();
            if (js < 8) { const int ktok0 = tok0 + (js + 1 - 8) * 64;
#pragma unroll
                for (int i = 0; i < 4; ++i) { const int ch = ltid + 256 * i;
                    kreg[i] = *(const u32x4*)(P + (size_t)(ktok0 + (ch >> 4)) * LDE + 4096 + head * 128 + (ch & 15) * 8);
                    vreg[i] = *(const u32x4*)(VT + (size_t)(head * 128 + (ch >> 3)) * NTOK + ktok0 + (ch & 7) * 8); } }
            f32x4 s[4];
#pragma unroll
            for (int nt = 0; nt < 4; ++nt) { s[nt] = (f32x4){0.f, 0.f, 0.f, 0.f};
#pragma unroll
                for (int kk = 0; kk < 4; ++kk) { const bf16x8 kf = *(const bf16x8*)(kS + (16 * nt + r) * 136 + 32 * kk + 8 * q8);
                    s[nt] = __builtin_amdgcn_mfma_f32_16x16x32_bf16(qf[kk], kf, s[nt], 0, 0, 0); } }
            float alpha[4];
            const float* bT = bS + (16 * w4 + 4 * q8 - r + 63 + (8 - js) * 64);
#pragma unroll
            for (int j = 0; j < 4; ++j) {
                float mx = -1e30f;
#pragma unroll
                for (int nt = 0; nt < 4; ++nt) { const float v = s[nt][j] * scale + bT[j - 16 * nt]; s[nt][j] = v; mx = fmaxf(mx, v); }
                mx = row16_max(mx);
                const float mn = fmaxf(m[j], mx); alpha[j] = __builtin_amdgcn_exp2f(m[j] - mn); m[j] = mn;
                float ps = 0.f;
#pragma unroll
                for (int nt = 0; nt < 4; ++nt) { const float pp = __builtin_amdgcn_exp2f(s[nt][j] - mn); ps += pp; pS[(16 * w4 + 4 * q8 + j) * 72 + 16 * nt + r] = f2bf(pp); }
                l[j] = l[j] * alpha[j] + ps;
            }
#pragma unroll
            for (int i = 0; i < 8; ++i)
#pragma unroll
                for (int j = 0; j < 4; ++j) o[i][j] *= alpha[j];
            LDS_WAIT();
#pragma unroll
            for (int kk = 0; kk < 2; ++kk) { const bf16x8 pf = *(const bf16x8*)(pS + (16 * w4 + r) * 72 + 32 * kk + 8 * q8);
#pragma unroll
                for (int i = 0; i < 8; ++i) { const bf16x8 vf = *(const bf16x8*)(vS + (16 * i + r) * 72 + 32 * kk + 8 * q8);
                    o[i] = __builtin_amdgcn_mfma_f32_16x16x32_bf16(pf, vf, o[i], 0, 0, 0); } }
        }
#pragma unroll
        for (int j = 0; j < 4; ++j) { float lt = l[j];
#pragma unroll
            for (int ofs = 1; ofs < 16; ofs <<= 1) lt += __shfl_xor(lt, ofs);
            const float inv = frcp(lt);
            bf16_t* op = ycat + (size_t)(tok0 + 16 * w4 + 4 * q8 + j) * DM + 1024 + head * 128 + r;
#pragma unroll
            for (int i = 0; i < 8; ++i) op[16 * i] = f2bf(o[i][j] * inv); }
    }
}

template <int KIND, bool WANT_Q>
__device__ __forceinline__ void decay_qk(const Params& p, const bf16_t* __restrict__ P, int tok0, int hd, int d, int tq, float (&bl)[16], float (&kv)[16], float (&qv)[16], const bf16_t (&ra)[16], const bf16_t (&rq)[16], const u32x4& gaR) {
    const int col = hd * 128 + d;
    const bf16_t* rp = P + (size_t)(tok0 + 16 * tq) * LDO;
    if (KIND == 0) {
        const float lb = frcp(1.f + __expf(p.hgrn_lb[col] - p.hgrn_lb[1024 + col]));
        float run = 0.f;
#pragma unroll
        for (int jj = 0; jj < 16; ++jj) {
            const float fr = bf2f(ra[jj]);
            const float f = lb + (1.f - lb) * sigmoidf_(fr);
            run += __logf(f); bl[jj] = run; kv[jj] = 1.f - f;
            if (WANT_Q) { const float qr = bf2f(rq[jj]); qv[jj] = qr * sigmoidf_(qr); }
        }
    } else {
        float w[16];
#pragma unroll
        for (int rr = 0; rr < 16; ++rr) w[rr] = p.wa2[rr * 512 + col];
        const float bias = p.ba[col];
        float run = 0.f;
#pragma unroll
        for (int jj = 0; jj < 16; ++jj) {
            u32x4 g0, g1;
#pragma unroll
            for (int e = 0; e < 4; ++e) { g0[e] = (unsigned)__builtin_amdgcn_readlane((int)gaR[e], 2 * jj); g1[e] = (unsigned)__builtin_amdgcn_readlane((int)gaR[e], 2 * jj + 1); }
            float xx = bias;
#pragma unroll
            for (int e = 0; e < 4; ++e) {
                xx += __uint_as_float(g0[e] << 16) * w[2 * e] + __uint_as_float(g0[e] & 0xffff0000u) * w[2 * e + 1];
                xx += __uint_as_float(g1[e] << 16) * w[8 + 2 * e] + __uint_as_float(g1[e] & 0xffff0000u) * w[8 + 2 * e + 1];
            }
            const float ls = fminf(xx, 0.f) - __logf(1.f + __expf(-fabsf(xx)));
            run += ls * (1.f / 16.f); bl[jj] = run;
            kv[jj] = bf2f(ra[jj]);
            if (WANT_Q) qv[jj] = bf2f(rq[jj]) * 0.08838834764831845f;
        }
    }
}

template <int KIND, bool WANT_Q>
__device__ __forceinline__ void load_raw(const bf16_t* __restrict__ P, const bf16_t* __restrict__ VT, int idx, bf16_t (&ra)[16], bf16_t (&rq)[16], u32x4 (&vr)[KIND ? 4 : 2], u32x4& gaR) {
    constexpr int DV = KIND ? 256 : 128;
    const int tid = threadIdx.x, d = tid & 127, tq = tid >> 7;
    const int c = idx & 63, bh = idx >> 6, hd = KIND ? (bh & 3) : (bh & 7), b = KIND ? (bh >> 2) : (bh >> 3);
    const int tok0 = b * SEQ + c * 64, col = hd * 128 + d;
    const bf16_t* rp = P + (size_t)(tok0 + 16 * tq) * LDO;
#pragma unroll
    for (int jj = 0; jj < 16; ++jj) { ra[jj] = rp[(size_t)jj * LDO + (KIND ? 3584 : 1024) + col]; if (WANT_Q) rq[jj] = rp[(size_t)jj * LDO + (KIND ? 3072 : 0) + col]; }
    if (KIND == 1) gaR = *(const u32x4*)(rp + (size_t)((tid & 31) >> 1) * LDO + 5120 + (tid & 1) * 8);
    const bf16_t* vsrc = VT + (size_t)((KIND ? 1024 + hd * 256 : hd * 128)) * NTOK + tok0;
#pragma unroll
    for (int i = 0; i < DV / 64; ++i) { const int ch = tid + 512 * i, row = ch >> 3, c8 = ch & 7; vr[i] = *(const u32x4*)(vsrc + (size_t)row * NTOK + c8 * 8); }
}

template <int KIND>
__device__ __forceinline__ void passA_item(const Params& p, unsigned char* smem_base, const bf16_t* __restrict__ P, const bf16_t* __restrict__ VT, bf16_t* __restrict__ ST, float* __restrict__ DEC, int idx, int par, int nidx, bf16_t (&ra)[16], bf16_t (&rq)[16], u32x4 (&vr)[KIND ? 4 : 2], u32x4& gaR) {
    unsigned char* smem = smem_base + par * 57344;
    constexpr int DV = KIND ? 256 : 128;
    const int tid = threadIdx.x, lane = tid & 63, wave = tid >> 6, r = lane & 15, q8 = lane >> 4, d = tid & 127, tq = tid >> 7;
    const int c = idx & 63, bh = idx >> 6, hd = KIND ? (bh & 3) : (bh & 7), b = KIND ? (bh >> 2) : (bh >> 3);
    const int tok0 = b * SEQ + c * 64;
    bf16_t* kT = (bf16_t*)smem;
    bf16_t* vS = (bf16_t*)(smem + 18432);
    float* tot = (float*)(smem + 18432 + 36864);
    float bl[16], kv[16], qv[16];
    decay_qk<KIND, false>(p, P, tok0, hd, d, tq, bl, kv, qv, ra, rq, gaR);
    tot[tq * 128 + d] = bl[15];
#pragma unroll
    for (int i = 0; i < DV / 64; ++i) { const int ch = tid + 512 * i, row = ch >> 3, c8 = ch & 7; *(u32x4*)(vS + row * 72 + c8 * 8) = vr[i]; }
    __syncthreads();
    if (nidx >= 0) load_raw<KIND, false>(P, VT, nidx, ra, rq, vr, gaR);
    const float t0 = tot[d], t1 = tot[128 + d], t2 = tot[256 + d], t3 = tot[384 + d];
    const float r4 = t0 + t1 + t2 + t3;
    const float rpre = (tq > 0 ? t0 : 0.f) + (tq > 1 ? t1 : 0.f) + (tq > 2 ? t2 : 0.f);
    {
        float kt[16];
#pragma unroll
        for (int jj = 0; jj < 16; ++jj) kt[jj] = kv[jj] * __expf(r4 - rpre - bl[jj]);
        u32x4 w0, w1;
        w0.x = pk2(kt[0], kt[1]); w0.y = pk2(kt[2], kt[3]); w0.z = pk2(kt[4], kt[5]); w0.w = pk2(kt[6], kt[7]);
        w1.x = pk2(kt[8], kt[9]); w1.y = pk2(kt[10], kt[11]); w1.z = pk2(kt[12], kt[13]); w1.w = pk2(kt[14], kt[15]);
        *(u32x4*)(kT + d * 72 + 16 * tq) = w0; *(u32x4*)(kT + d * 72 + 16 * tq + 8) = w1;
    }
    const int gitem = (KIND ? 2048 : 0) + idx;
    if (tq == 0) DEC[(size_t)gitem * 128 + d] = __expf(r4);
    __syncthreads();
    const int d0 = 16 * wave;
    bf16x8 af[2];
#pragma unroll
    for (int kk = 0; kk < 2; ++kk) af[kk] = *(const bf16x8*)(kT + (d0 + r) * 72 + 32 * kk + 8 * q8);
    bf16_t* stb = ST + (KIND ? (size_t)33554432 : 0) + (size_t)idx * (DV * 128);
#pragma unroll
    for (int nt = 0; nt < DV / 16; ++nt) {
        f32x4 acc = (f32x4){0.f, 0.f, 0.f, 0.f};
#pragma unroll
        for (int kk = 0; kk < 2; ++kk) { const bf16x8 bfr = *(const bf16x8*)(vS + (16 * nt + r) * 72 + 32 * kk + 8 * q8);
            acc = __builtin_amdgcn_mfma_f32_16x16x32_bf16(af[kk], bfr, acc, 0, 0, 0); }
        u32x2 w; w.x = pk2(acc[0], acc[1]); w.y = pk2(acc[2], acc[3]);
        *(u32x2*)(stb + (size_t)(16 * nt + r) * 128 + d0 + 4 * q8) = w;
    }
}

__device__ __forceinline__ void scan_phase(bf16_t* __restrict__ ST, const float* __restrict__ DEC) {
    const int nthr = gridDim.x * 512;
    for (int gid = blockIdx.x * 512 + threadIdx.x; gid < 131072; gid += nthr) {
        const int kind = gid >> 16, v = gid & 65535;
        const int vper = kind ? 4096 : 2048, bh = v / vper, vi = v - bh * vper, d0 = (vi * 8) & 127;
        const size_t csz = kind ? 32768 : 16384;
        bf16_t* sp = ST + (kind ? (size_t)33554432 : 0) + (size_t)bh * 64 * csz + (size_t)vi * 8;
        const float* dp = DEC + (size_t)((kind ? 2048 : 0) + bh * 64) * 128 + d0;
        float S[8];
#pragma unroll
        for (int e = 0; e < 8; ++e) S[e] = 0.f;
#pragma unroll 8
        for (int c = 0; c < 64; ++c) {
            const u32x4 u = __builtin_nontemporal_load((const u32x4*)(sp + (size_t)c * csz));
            const f32x4 da = *(const f32x4*)(dp + c * 128), db = *(const f32x4*)(dp + c * 128 + 4);
            u32x4 w; w.x = pk2(S[0], S[1]); w.y = pk2(S[2], S[3]); w.z = pk2(S[4], S[5]); w.w = pk2(S[6], S[7]);
            *(u32x4*)(sp + (size_t)c * csz) = w;
#pragma unroll
            for (int e = 0; e < 4; ++e) {
                S[2 * e] = S[2 * e] * (e < 2 ? da[2 * e] : db[2 * e - 4]) + __uint_as_float(u[e] << 16);
                S[2 * e + 1] = S[2 * e + 1] * (e < 2 ? da[2 * e + 1] : db[2 * e - 3]) + __uint_as_float(u[e] & 0xffff0000u);
            }
        }
    }
}

template <int KIND>
__device__ __forceinline__ void passC_item(const Params& p, unsigned char* smem, const bf16_t* __restrict__ P, const bf16_t* __restrict__ VT, const bf16_t* __restrict__ ST, bf16_t* __restrict__ ycat, int idx, int nidx, bf16_t (&ra)[16], bf16_t (&rq)[16], u32x4 (&vr)[KIND ? 4 : 2], u32x4& gaR) {
    constexpr int DV = KIND ? 256 : 128;
    const int tid = threadIdx.x, lane = tid & 63, wave = tid >> 6, r = lane & 15, q8 = lane >> 4, d = tid & 127, tq = tid >> 7;
    const int c = idx & 63, bh = idx >> 6, hd = KIND ? (bh & 3) : (bh & 7), b = KIND ? (bh >> 2) : (bh >> 3);
    const int tok0 = b * SEQ + c * 64;
    bf16_t* qs = (bf16_t*)smem;
    bf16_t* qh = (bf16_t*)(smem + 17408);
    bf16_t* ks = (bf16_t*)(smem + 34816);
    bf16_t* vS = (bf16_t*)(smem + 78336);
    bf16_t* pS = (bf16_t*)(smem + 115200);
    float* tot = (float*)(smem + 124416);
    float* ssq = (float*)(smem + 126464);
    float bl[16], kv[16], qv[16];
    decay_qk<KIND, true>(p, P, tok0, hd, d, tq, bl, kv, qv, ra, rq, gaR);
    tot[tq * 128 + d] = bl[15];
#pragma unroll
    for (int i = 0; i < DV / 64; ++i) { const int ch = tid + 512 * i, row = ch >> 3, c8 = ch & 7; *(u32x4*)(vS + row * 72 + c8 * 8) = vr[i]; }
    for (int i = tid; i < 64 * 72 / 8; i += 512) *(u32x4*)(pS + i * 8) = (u32x4){0, 0, 0, 0};
    __syncthreads();
    if (nidx >= 0) load_raw<KIND, true>(P, VT, nidx, ra, rq, vr, gaR);
    constexpr int NT = DV / 32;
    constexpr int NPRE = 4;
    const int oi = wave & 3, oeh = wave >> 2;
    const bf16_t* stb = ST + (KIND ? (size_t)33554432 : 0) + (size_t)idx * (DV * 128);
    const int gcol = KIND ? 4096 + hd * 256 : 2048 + hd * 128;
    bf16x8 bst[NPRE][4];
#pragma unroll
    for (int nt = 0; nt < NPRE; ++nt)
#pragma unroll
        for (int kk = 0; kk < 4; ++kk) bst[nt][kk] = *(const bf16x8*)(stb + (size_t)(oeh * (DV / 2) + 16 * nt + r) * 128 + 32 * kk + 8 * q8);
    bf16_t graw[4][NT];
#pragma unroll
    for (int j = 0; j < 4; ++j)
#pragma unroll
        for (int nt = 0; nt < NT; ++nt) graw[j][nt] = P[(size_t)(tok0 + 16 * oi + 4 * q8 + j) * LDO + gcol + oeh * (DV / 2) + 16 * nt + r];
    {
        const float t0 = tot[d], t1 = tot[128 + d], t2 = tot[256 + d];
        const float rpre = (tq > 0 ? t0 : 0.f) + (tq > 1 ? t1 : 0.f) + (tq > 2 ? t2 : 0.f);
        const float Ttq = bl[15], rn = rpre + Ttq;
        const float einv = __expf(fminf(-Ttq, 80.f));
        const float f1 = (tq == 1) ? einv : __expf(fminf(t0 - rn, 0.f));
        const float f2 = (tq == 2) ? einv : __expf(fminf(t0 + t1 - rn, 0.f));
        const float f3 = (tq == 3) ? einv : __expf(fminf(t0 + t1 + t2 - rn, 0.f));
        const float erp = __expf(rpre);
#pragma unroll
        for (int jj = 0; jj < 16; ++jj) {
            const int t = 16 * tq + jj;
            const float ql = qv[jj] * __expf(bl[jj]);
            qs[t * 136 + d] = f2bf(ql);
            qh[t * 136 + d] = f2bf(ql * erp);
            const float kb = kv[jj] * __expf(Ttq - bl[jj]);
            if (tq == 0) ks[(0 + t) * 136 + d] = f2bf(kb * einv);
            if (tq <= 1) ks[(16 + t) * 136 + d] = f2bf(kb * f1);
            if (tq <= 2) ks[(48 + t) * 136 + d] = f2bf(kb * f2);
            ks[(96 + t) * 136 + d] = f2bf(kb * f3);
        }
    }
    __syncthreads();
    {
        const int i = wave >> 1, off = 8 * i * (i + 1);
        bf16x8 af[4];
#pragma unroll
        for (int kk = 0; kk < 4; ++kk) af[kk] = *(const bf16x8*)(qs + (16 * i + r) * 136 + 32 * kk + 8 * q8);
        for (int jt = (wave & 1); jt <= i; jt += 2) {
            f32x4 acc = (f32x4){0.f, 0.f, 0.f, 0.f};
#pragma unroll
            for (int kk = 0; kk < 4; ++kk) { const bf16x8 bfr = *(const bf16x8*)(ks + (off + 16 * jt + r) * 136 + 32 * kk + 8 * q8);
                acc = __builtin_amdgcn_mfma_f32_16x16x32_bf16(af[kk], bfr, acc, 0, 0, 0); }
#pragma unroll
            for (int j = 0; j < 4; ++j) { float v = acc[j]; if (jt == i && r > 4 * q8 + j) v = 0.f;
                pS[(16 * i + 4 * q8 + j) * 72 + 16 * jt + r] = f2bf(v); }
        }
    }
    __syncthreads();
    {
        const int i = oi, eh = oeh;
        bf16x8 ap[2], aq[4];
#pragma unroll
        for (int kk = 0; kk < 2; ++kk) ap[kk] = *(const bf16x8*)(pS + (16 * i + r) * 72 + 32 * kk + 8 * q8);
#pragma unroll
        for (int kk = 0; kk < 4; ++kk) aq[kk] = *(const bf16x8*)(qh + (16 * i + r) * 136 + 32 * kk + 8 * q8);
        f32x4 o[NT];
        float ss[4] = {0.f, 0.f, 0.f, 0.f};
#pragma unroll
        for (int nt = 0; nt < NT; ++nt) {
            const int e0 = eh * (DV / 2) + 16 * nt;
            f32x4 acc = (f32x4){0.f, 0.f, 0.f, 0.f};
#pragma unroll
            for (int kk = 0; kk < 2; ++kk) { const bf16x8 bfr = *(const bf16x8*)(vS + (e0 + r) * 72 + 32 * kk + 8 * q8);
                acc = __builtin_amdgcn_mfma_f32_16x16x32_bf16(ap[kk], bfr, acc, 0, 0, 0); }
#pragma unroll
            for (int kk = 0; kk < 4; ++kk) { bf16x8 bfr;
                if (nt < NPRE) bfr = bst[nt < NPRE ? nt : 0][kk]; else bfr = *(const bf16x8*)(stb + (size_t)(e0 + r) * 128 + 32 * kk + 8 * q8);
                acc = __builtin_amdgcn_mfma_f32_16x16x32_bf16(aq[kk], bfr, acc, 0, 0, 0); }
            o[nt] = acc;
#pragma unroll
            for (int j = 0; j < 4; ++j) ss[j] += acc[j] * acc[j];
        }
#pragma unroll
        for (int j = 0; j < 4; ++j) {
#pragma unroll
            for (int ofs = 1; ofs < 16; ofs <<= 1) ss[j] += __shfl_xor(ss[j], ofs);
            if (r == 0) ssq[eh * 64 + 16 * i + 4 * q8 + j] = ss[j];
        }
        __syncthreads();
        const float* ng = (KIND ? p.gla_ng + hd * 256 : p.hgrn_ng + hd * 128);
        const int ycol = KIND ? 1024 + hd * 256 : hd * 128;
#pragma unroll
        for (int j = 0; j < 4; ++j) {
            const int t = 16 * i + 4 * q8 + j;
            const float rstd = __builtin_amdgcn_rsqf((ssq[t] + ssq[64 + t]) * (1.f / DV) + EPS);
            bf16_t* yp = ycat + (size_t)(tok0 + t) * DM + ycol;
#pragma unroll
            for (int nt = 0; nt < NT; ++nt) { const int e = eh * (DV / 2) + 16 * nt + r;
                const float g = bf2f(graw[j][nt]);
                yp[e] = f2bf(o[nt][j] * rstd * ng[e] * (g * sigmoidf_(g))); }
        }
    }
}

#define XB_TMO      128
#define XB_XCNT(j)  (256  + 64 * (j))
#define XB_XSUB(j)  (1280 + 64 * (j))
#define XB_XGEN(j)  (2304 + 64 * (j))
#define XB_TOP      3328
#define XB_TOPGEN   3392
#define XCD_BAR_WORDS 3456
#define XB_SPIN_CAP (1u << 18)
__device__ __forceinline__ unsigned xb_ld(unsigned* p)              { return __hip_atomic_load(p, __ATOMIC_RELAXED, __HIP_MEMORY_SCOPE_AGENT); }
__device__ __forceinline__ unsigned xb_add(unsigned* p, unsigned v) { return __hip_atomic_fetch_add(p, v, __ATOMIC_RELAXED, __HIP_MEMORY_SCOPE_AGENT); }
__device__ __forceinline__ unsigned xb_xcc_id() { return (unsigned)__builtin_amdgcn_s_getreg((3 << 11) | 20) & 0xFu; }
#define XB_SPIN(cond, bar) do { unsigned _sp = 0; while (cond) { __builtin_amdgcn_s_sleep(1); \
    if ((++_sp & 255u) == 0u) { if (xb_ld(&(bar)[XB_TMO])) break; if (_sp > XB_SPIN_CAP) { atomicAdd(&(bar)[XB_TMO], 1u); break; } } } } while (0)
struct XcdBarrier { unsigned* bar; unsigned x; volatile LAS unsigned* st; };
__device__ __forceinline__ XcdBarrier xcd_barrier_post(unsigned* bar, volatile LAS unsigned* st) {
    XcdBarrier b; b.bar = bar; b.x = xb_xcc_id(); b.st = st;
    if (threadIdx.x == 0) (void)xb_add(&bar[XB_XCNT(b.x)], 1u);
    return b;
}
__device__ __forceinline__ void xcd_barrier_complete(unsigned* bar, unsigned x, unsigned& nloc, unsigned& nx) {
    const unsigned G = gridDim.x * gridDim.y * gridDim.z;
    unsigned sum, cnt, mine, sp = 0u;
    for (;;) {
        sum = 0u; cnt = 0u; mine = 0u;
#pragma unroll
        for (unsigned j = 0; j < 16; ++j) { const unsigned c = xb_ld(&bar[XB_XCNT(j)]); sum += c; cnt += (c > 0u) ? 1u : 0u; mine = (j == x) ? c : mine; }
        if (sum == G) break;
        __builtin_amdgcn_s_sleep(1);
        if ((++sp & 255u) == 0u) { if (xb_ld(&bar[XB_TMO])) break; if (sp > XB_SPIN_CAP) { atomicAdd(&bar[XB_TMO], 1u); break; } }
    }
    nloc = mine > 0u ? mine : 1u; nx = cnt > 0u ? cnt : 1u;
}
__device__ __forceinline__ void xcd_barrier(const XcdBarrier& b) {
    asm volatile("s_waitcnt vmcnt(0)" ::: "memory");
    __syncthreads();
    if (threadIdx.x == 0) {
        unsigned* bar = b.bar;
        __builtin_amdgcn_s_waitcnt(0);
        unsigned nloc = b.st[0], nx = b.st[1];
        if (nloc == 0u) { xcd_barrier_complete(bar, b.x, nloc, nx); b.st[0] = nloc; b.st[1] = nx; }
        const unsigned old = xb_add(&bar[XB_XSUB(b.x)], 1u);
        const unsigned gen = old / nloc;
        if (old + 1u == (gen + 1u) * nloc) {
            __builtin_amdgcn_fence(__ATOMIC_RELEASE, "agent");
            asm volatile("s_waitcnt vmcnt(0)" ::: "memory");
            const unsigned og = xb_add(&bar[XB_TOP], 1u);
            const unsigned tg = og / nx;
            if (og + 1u == (tg + 1u) * nx) xb_add(&bar[XB_TOPGEN], 1u);
            else XB_SPIN(xb_ld(&bar[XB_TOPGEN]) == tg, bar);
            __builtin_amdgcn_fence(__ATOMIC_ACQUIRE, "agent");
            xb_add(&bar[XB_XGEN(b.x)], 1u);
            asm volatile("s_waitcnt vmcnt(0)" ::: "memory");
        } else {
            XB_SPIN(xb_ld(&bar[XB_XGEN(b.x)]) == gen, bar);
            __builtin_amdgcn_fence(__ATOMIC_ACQUIRE, "agent");
            asm volatile("s_waitcnt vmcnt(0)" ::: "memory");
        }
    }
    __syncthreads();
}

__global__ void __launch_bounds__(512, 2) fwd_kernel(Params p) {
    extern __shared__ __attribute__((aligned(16))) unsigned char smem[];
    cg::grid_group grid = cg::this_grid();
    const int tid = threadIdx.x, lane = tid & 63, wave = tid >> 6;
    const int G = gridDim.x, gw = blockIdx.x * 8 + wave, NGW = G * 8;
    unsigned char* ws = p.ws;
    bf16_t* Wout = (bf16_t*)(ws + WS_WOUT); bf16_t* W1t = (bf16_t*)(ws + WS_W1); bf16_t* W2t = (bf16_t*)(ws + WS_W2); bf16_t* Win = (bf16_t*)(ws + WS_WIN);
    bf16_t* U = (bf16_t*)(ws + WS_U); bf16_t* BIG = (bf16_t*)(ws + WS_BIG); bf16_t* YZ = (bf16_t*)(ws + WS_YZ);
    bf16_t* VTE = (bf16_t*)(ws + WS_VT_E); bf16_t* VTO = (bf16_t*)(ws + WS_VT_O); bf16_t* ST = (bf16_t*)(ws + WS_ST); float* DEC = (float*)(ws + WS_DEC);
    float* SS = (float*)(ws + WS_SS); unsigned* PCNT = (unsigned*)(ws + WS_PCNT); bf16_t* YC = (bf16_t*)p.out;
    float* SSH0 = SS; float* SSH1 = SS + NTOK; float* SSH2 = SS + 2 * NTOK; float* SSH3 = SS + 3 * NTOK;
    float* scr = (float*)(smem + wave * 8448);
    LAS unsigned char* lds = (LAS unsigned char*)smem;
    const int lo = p.ph_lo, hi = p.ph_hi;
#define IN(k) (lo <= (k) && (k) < hi)
#define SEAM(k) do { if (IN(k) && IN((k) + 1)) xcd_barrier(xbar); } while (0)
    if (lo < 0) grid.sync();
    volatile LAS unsigned* xst = (volatile LAS unsigned*)(lds + 131072 + 1024);
    if (tid < 4) xst[tid] = 0u;
    __syncthreads();
    XcdBarrier xbar; xbar.bar = (unsigned*)(ws + WS_BAR); xbar.x = 0; xbar.st = xst;
    if (hi - lo > 1) xbar = xcd_barrier_post((unsigned*)(ws + WS_BAR), xst);

    if (IN(0)) {
        cvt_seg(p.even_w_in, DM, 6144, 0, 5120, Win, 0, p.norm_g, scr, gw, NGW, lane);
        cvt_seg(p.even_w_in, DM, 6144, 5120, 1024, Win, 5120, p.norm_g, scr, gw, NGW, lane);
        cvt_seg(p.even_w_out, DM, DM, 0, DM, Wout, 0, nullptr, scr, gw, NGW, lane);
        cvt_seg(p.w1, DM, DFF, 0, DFF, W1t, 0, p.norm_g + 2 * DM, scr, gw, NGW, lane);
        cvt_seg(p.w2, DFF, DM, 0, DM, W2t, 0, nullptr, scr, gw, NGW, lane);
        rowwise<0>(p.x, nullptr, nullptr, U, SSH0, nullptr, gw, NGW, lane);
    }
    SEAM(0);
    if (IN(1)) {
        { pg8::Gemm g{U, Win, NTOK, LDE, DM}; pg8::StaticOrder S; S.init(NTOK, LDE, G, blockIdx.x); pg8::EpiB<0, 1> E{BIG, LDE, SSH0}; pg8::gemm_phase(lds, g, S, E); }
        { pg8::Gemm g{Win + (size_t)5120 * DM, U, 1024, NTOK, DM}; pg8::StaticOrder S; S.init(1024, NTOK, G, blockIdx.x); pg8::EpiB<0, 2> E{VTE, NTOK, SSH0}; pg8::gemm_phase(lds, g, S, E); }
    }
    SEAM(1);
    if (IN(2)) { conv_phase(BIG, p.conv_w, YC); attn_phase(smem, BIG, VTE, p.rel_bias, YC); }
    SEAM(2);
    if (IN(3)) { pg8::Gemm g{YC, Wout, NTOK, DM, DM}; pg8::PanelOrder S{(int)blockIdx.x}; pg8::EpiRes<false> E{U, nullptr, p.norm_g + 1 * DM, SS + 4 * NTOK, SSH1, PCNT}; pg8::gemm_phase(lds, g, S, E); }
    SEAM(3);
    if (IN(5)) { pg8::Gemm g{U, W1t, NTOK, DFF, DM}; pg8::StaticOrder S; S.init(NTOK, DFF, G, blockIdx.x); pg8::EpiB<1, 1> E{BIG, DFF, SSH1}; pg8::gemm_phase(lds, g, S, E); }
    SEAM(5);
    if (IN(6)) { pg8::Gemm g{BIG, W2t, NTOK, DM, DFF}; pg8::PanelOrder S{(int)blockIdx.x}; pg8::EpiRes<false> E{U, nullptr, p.norm_g + 3 * DM, SS + 5 * NTOK, SSH2, PCNT + 64}; pg8::gemm_phase(lds, g, S, E); }
    SEAM(6);
    if (IN(7)) {
        const float* wi = p.odd_w_in;
        cvt_seg(wi, DM, 7184, 0, 2048, Win, 0, p.norm_g + 4 * DM, scr, gw, NGW, lane);
        cvt_seg(wi, DM, 7184, 3072, 2048, Win, 2048, p.norm_g + 4 * DM, scr, gw, NGW, lane);
        cvt_seg(wi, DM, 7184, 6144, 1040, Win, 4096, p.norm_g + 4 * DM, scr, gw, NGW, lane);
        cvt_seg(wi, DM, 7184, 2048, 1024, Win, 5376, p.norm_g + 4 * DM, scr, gw, NGW, lane);
        cvt_seg(wi, DM, 7184, 5120, 1024, Win, 6400, p.norm_g + 4 * DM, scr, gw, NGW, lane);
        cvt_seg(p.odd_w_out, DM, DM, 0, DM, Wout, 0, nullptr, scr, gw, NGW, lane);
        cvt_seg(p.w1 + (size_t)DM * DFF, DM, DFF, 0, DFF, W1t, 0, p.norm_g + 6 * DM, scr, gw, NGW, lane);
        cvt_seg(p.w2 + (size_t)DM * DFF, DFF, DM, 0, DM, W2t, 0, nullptr, scr, gw, NGW, lane);
    }
    SEAM(7);
    if (IN(8)) {
        { pg8::Gemm g{U, Win, NTOK, 5120, DM}; pg8::StaticOrder S; S.init(NTOK, 5120, G, blockIdx.x); pg8::EpiB<0, 1> E{BIG, LDO, SSH2}; pg8::gemm_phase(lds, g, S, E); }
        { pg8::Gemm g{Win + (size_t)5376 * DM, U, 2048, NTOK, DM}; pg8::StaticOrder S; S.init(2048, NTOK, G, blockIdx.x); pg8::EpiB<0, 2> E{VTO, NTOK, SSH2}; pg8::gemm_phase(lds, g, S, E); }
        if (wave < 4) {
            const int r = lane & 15, q8 = lane >> 4, t0 = (blockIdx.x * 4 + wave) * 16;
            if (t0 < NTOK) {
                const bf16_t* ap = U + (size_t)(t0 + r) * DM + 8 * q8;
                const bf16_t* bp = Win + (size_t)(5120 + r) * DM + 8 * q8;
                f32x4 acc = (f32x4){0.f, 0.f, 0.f, 0.f};
#pragma unroll 8
                for (int kk = 0; kk < DM / 32; ++kk) { const bf16x8 a = *(const bf16x8*)(ap + 32 * kk), b = *(const bf16x8*)(bp + 32 * kk);
                    acc = __builtin_amdgcn_mfma_f32_16x16x32_bf16(a, b, acc, 0, 0, 0); }
#pragma unroll
                for (int j = 0; j < 4; ++j) BIG[(size_t)(t0 + 4 * q8 + j) * LDO + 5120 + r] = f2bf(acc[j] * __builtin_amdgcn_rsqf(SSH2[t0 + 4 * q8 + j] * (1.f / DM) + EPS));
            }
        }
    }
    SEAM(8);
    if (IN(9)) {
        int par = 0;
        { bf16_t ra[16], rq[16]; u32x4 vr[2]; u32x4 gaR = (u32x4){0, 0, 0, 0}; load_raw<0, false>(BIG, VTO, blockIdx.x, ra, rq, vr, gaR);
          for (int it = blockIdx.x; it < 2048; it += G) { passA_item<0>(p, smem, BIG, VTO, ST, DEC, it, par, (it + G < 2048) ? it + G : -1, ra, rq, vr, gaR); par ^= 1; } }
        { bf16_t ra[16], rq[16]; u32x4 vr[4]; u32x4 gaR = (u32x4){0, 0, 0, 0}; load_raw<1, false>(BIG, VTO, blockIdx.x, ra, rq, vr, gaR);
          for (int it = blockIdx.x; it < 1024; it += G) { passA_item<1>(p, smem, BIG, VTO, ST, DEC, it, par, (it + G < 1024) ? it + G : -1, ra, rq, vr, gaR); par ^= 1; } }
    }
    SEAM(9);
    if (IN(10)) scan_phase(ST, DEC);
    SEAM(10);
    if (IN(11)) {
        { bf16_t ra[16], rq[16]; u32x4 vr[2]; u32x4 gaR = (u32x4){0, 0, 0, 0}; load_raw<0, true>(BIG, VTO, blockIdx.x, ra, rq, vr, gaR);
          for (int it = blockIdx.x; it < 2048; it += G) passC_item<0>(p, smem, BIG, VTO, ST, YC, it, (it + G < 2048) ? it + G : -1, ra, rq, vr, gaR); }
        { bf16_t ra[16], rq[16]; u32x4 vr[4]; u32x4 gaR = (u32x4){0, 0, 0, 0}; load_raw<1, true>(BIG, VTO, blockIdx.x, ra, rq, vr, gaR);
          for (int it = blockIdx.x; it < 1024; it += G) passC_item<1>(p, smem, BIG, VTO, ST, YC, it, (it + G < 1024) ? it + G : -1, ra, rq, vr, gaR); }
    }
    SEAM(11);
    if (IN(12)) { pg8::Gemm g{YC, Wout, NTOK, DM, DM}; pg8::PanelOrder S{(int)blockIdx.x}; pg8::EpiRes<false> E{U, nullptr, p.norm_g + 5 * DM, SS + 6 * NTOK, SSH3, PCNT + 128}; pg8::gemm_phase(lds, g, S, E); }
    SEAM(12);
    if (IN(14)) { pg8::Gemm g{U, W1t, NTOK, DFF, DM}; pg8::StaticOrder S; S.init(NTOK, DFF, G, blockIdx.x); pg8::EpiB<1, 1> E{BIG, DFF, SSH3}; pg8::gemm_phase(lds, g, S, E); }
    SEAM(14);
    if (IN(15)) { pg8::Gemm g{BIG, W2t, NTOK, DM, DFF}; pg8::PanelOrder S{(int)blockIdx.x}; pg8::EpiRes<true> E{U, p.out, p.norm_g + 7 * DM, SS + 7 * NTOK, nullptr, PCNT + 192}; pg8::gemm_phase(lds, g, S, E); }
#undef IN
#undef SEAM
}

constexpr int NPHASE = 17;

extern "C" void kernel_launch(void* const* d_in, const int* in_sizes, int n_in, void* d_out, int out_size, void* d_ws, size_t ws_size, hipStream_t stream) {
    static int grid = 0;
    if (grid == 0) {
        if (ws_size < WS_END) fprintf(stderr, "kernel_launch: workspace too small: %zu < %zu\n", ws_size, (size_t)WS_END);
        int dev = 0, cus = 0, per_cu = 0;
        hipGetDevice(&dev);
        hipDeviceGetAttribute(&cus, hipDeviceAttributeMultiprocessorCount, dev);
        if (hipFuncSetAttribute((const void*)fwd_kernel, hipFuncAttributeMaxDynamicSharedMemorySize, LDS_BYTES) != hipSuccess) fprintf(stderr, "kernel_launch: hipFuncSetAttribute failed\n");
        if (hipOccupancyMaxActiveBlocksPerMultiprocessor(&per_cu, (const void*)fwd_kernel, 512, LDS_BYTES) != hipSuccess || per_cu < 1) { per_cu = 1; (void)hipGetLastError(); }
        grid = cus * (per_cu > 1 ? 1 : per_cu);
        if (grid <= 0) grid = 256;
    }
    Params p{};
    p.x = (const float*)d_in[0]; p.norm_g = (const float*)d_in[1]; p.even_w_in = (const float*)d_in[2]; p.conv_w = (const float*)d_in[3];
    p.rel_bias = (const float*)d_in[4]; p.even_w_out = (const float*)d_in[5]; p.odd_w_in = (const float*)d_in[6]; p.hgrn_lb = (const float*)d_in[7];
    p.hgrn_ng = (const float*)d_in[8]; p.wa2 = (const float*)d_in[9]; p.ba = (const float*)d_in[10]; p.gla_ng = (const float*)d_in[11];
    p.odd_w_out = (const float*)d_in[12]; p.w1 = (const float*)d_in[13]; p.w2 = (const float*)d_in[14];
    p.out = (float*)d_out; p.ws = (unsigned char*)d_ws;
#if ONE_LAUNCH
    (void)hipMemsetAsync((unsigned char*)d_ws + WS_BAR, 0, WS_ZERO_BYTES, stream);
    p.ph_lo = 0; p.ph_hi = NPHASE;
    void* args[] = {&p};
    hipError_t e = hipLaunchCooperativeKernel((const void*)fwd_kernel, dim3(grid), dim3(512), args, LDS_BYTES, stream);
    if (e != hipSuccess) fprintf(stderr, "cooperative launch failed: %s (grid %d)\n", hipGetErrorString(e), grid);
#else
    for (int k = 0; k < NPHASE; ++k) {
        p.ph_lo = k; p.ph_hi = k + 1;
        hipLaunchKernelGGL(fwd_kernel, dim3(grid), dim3(512), LDS_BYTES, stream, p);
    }
#endif
}
```

```cpp
#include <hip/hip_runtime.h>
#include <hip/hip_cooperative_groups.h>
#include <cstdio>
namespace cg = cooperative_groups;

#ifndef ONE_LAUNCH
#define ONE_LAUNCH 1
#endif

typedef unsigned short bf16_t;
typedef short bf16x8 __attribute__((ext_vector_type(8)));
typedef float f32x4 __attribute__((ext_vector_type(4)));
typedef unsigned u32x4 __attribute__((ext_vector_type(4)));
typedef unsigned u32x2 __attribute__((ext_vector_type(2)));
#define LAS __attribute__((address_space(3)))

constexpr int DM = 2048, NTOK = 16384, SEQ = 4096, DFF = 8192;
constexpr int LDE = 5120;
constexpr int LDO = 5376;
constexpr float EPS = 1e-6f;

constexpr size_t WS_WOUT = 0;
constexpr size_t WS_W1 = 8388608;
constexpr size_t WS_W2 = WS_W1 + 33554432;
constexpr size_t WS_U = WS_W2 + 33554432;
constexpr size_t WS_BIG = WS_U + 67108864;
constexpr size_t WS_WIN = WS_BIG + 268435456;
constexpr size_t WS_YZ = WS_WIN + 30408704;
constexpr size_t WS_VT_E = WS_BIG + (size_t)NTOK * LDE * 2;
constexpr size_t WS_VT_O = WS_BIG + (size_t)NTOK * LDO * 2;
constexpr size_t WS_ST = WS_VT_O + 67108864;
constexpr size_t WS_DEC = WS_ST + 134217728;
constexpr size_t WS_BAR = WS_DEC + 3072 * 128 * 4;
constexpr size_t WS_SS = WS_BAR + 16384;
constexpr size_t WS_PCNT = WS_SS + 8 * 65536;
constexpr size_t WS_END = WS_PCNT + 4096;
constexpr size_t WS_ZERO_BYTES = WS_END - WS_BAR;

constexpr int LDS_BYTES = 131072 + 4096;

__device__ __forceinline__ float bf2f(bf16_t v) { return __uint_as_float(((unsigned)v) << 16); }
typedef float f32x2 __attribute__((ext_vector_type(2)));
typedef __bf16 bf16x2v __attribute__((ext_vector_type(2)));
__device__ __forceinline__ unsigned pk2(float lo, float hi) { f32x2 v = {lo, hi}; bf16x2v b = __builtin_convertvector(v, bf16x2v); return __builtin_bit_cast(unsigned, b); }
__device__ __forceinline__ bf16_t f2bf(float f) { return __builtin_bit_cast(bf16_t, (__bf16)f); }
__device__ __forceinline__ float wave_sum(float v) {
#pragma unroll
    for (int o = 1; o < 64; o <<= 1) v += __shfl_xor(v, o);
    return v;
}
__device__ __forceinline__ float frcp(float x) { return __builtin_amdgcn_rcpf(x); }
__device__ __forceinline__ float sigmoidf_(float x) { return frcp(1.f + __expf(-x)); }
#define LDS_WAIT() asm volatile("s_waitcnt lgkmcnt(0)" ::: "memory")
__device__ __forceinline__ float dpp_f(float v, int ctrl_sel) {
    const int x = __float_as_int(v); int y;
    if (ctrl_sel == 0) y = __builtin_amdgcn_update_dpp(x, x, 0xB1, 0xF, 0xF, false);
    else if (ctrl_sel == 1) y = __builtin_amdgcn_update_dpp(x, x, 0x4E, 0xF, 0xF, false);
    else if (ctrl_sel == 2) y = __builtin_amdgcn_update_dpp(x, x, 0x141, 0xF, 0xF, false);
    else y = __builtin_amdgcn_update_dpp(x, x, 0x140, 0xF, 0xF, false);
    return __int_as_float(y);
}
__device__ __forceinline__ float row16_max(float v) { v = fmaxf(v, dpp_f(v, 0)); v = fmaxf(v, dpp_f(v, 1)); v = fmaxf(v, dpp_f(v, 2)); v = fmaxf(v, dpp_f(v, 3)); return v; }
__device__ __forceinline__ float row16_sum(float v) { v += dpp_f(v, 0); v += dpp_f(v, 1); v += dpp_f(v, 2); v += dpp_f(v, 3); return v; }

namespace pg8 {
constexpr int BM = 256, BK = 64, HALF = 128, HTB = HALF * BK * 2, STAGE_BYTES = 8 * HTB, NXCD = 8, WGM = 8;
__host__ __device__ __forceinline__ int lds_byte(int r, int c) { const int st = (r >> 4) * 2 + (c >> 5), rr = r & 15, cc = c & 31, ob = rr * 64 + cc * 2; return st * 1024 + (ob ^ (((ob >> 9) & 1) << 5)); }
__host__ __device__ __forceinline__ void stage_rc(int b, int& R, int& C) { const int st = b / 1024, sb = b % 1024, swz = sb ^ (((sb >> 9) & 1) << 5); R = (st >> 1) * 16 + swz / 64; C = (st & 1) * 32 + (swz % 64) / 2; }
__host__ __device__ __forceinline__ int perm32(int rho) { const int n = rho >> 4, i = rho & 15; return 8 * (i >> 2) + 4 * n + (i & 3); }
struct Unit { int pm, pn; };
struct Gemm { const bf16_t* A; const bf16_t* Bt; int M, N, K; };
struct StaticOrder {
    int nM, nN, nwg, G, c;
    __device__ void init(int M, int N, int G_, int c_) { nM = M / BM; nN = N / BM; nwg = nM * nN; G = G_; c = c_; }
    __device__ bool next(int i, Unit& u) const {
        const long L = (long)i * G + c; if (L >= nwg) return false;
        int wgid = (int)L; { const int q = nwg / NXCD, r = nwg % NXCD, xcd = wgid % NXCD, off = wgid / NXCD; wgid = (xcd < r ? xcd * (q + 1) : r * (q + 1) + (xcd - r) * q) + off; }
        const int nig = WGM * nN, gid = wgid / nig, fm = gid * WGM, gsz = (nM - fm) < WGM ? (nM - fm) : WGM;
        u.pm = fm + ((wgid % nig) % gsz); u.pn = (wgid % nig) / gsz; return true;
    }
};
template <int ACT, int RS> struct EpiB {
    static constexpr bool PERM = true;
    bf16_t* O; int ldc; const float* rs;
    __device__ __forceinline__ void load_rs(const Unit& u, int wr, int fr, float (&rsv)[8]) const {
        if (RS == 1) {
#pragma unroll
            for (int q = 0; q < 8; ++q) rsv[q] = __builtin_amdgcn_rsqf(rs[u.pm * BM + wr * 64 + fr + (q >> 2) * HALF + (q & 3) * 16] * (1.f / 2048.f) + 1e-6f); }
    }
    __device__ __forceinline__ void operator()(const f32x4 (&acc)[2][2][4][2], const Unit& u, int wr, int wc, int fr, int fq, const float (&rsv)[8]) const {
        const int row0 = u.pm * BM + wr * 64 + fr, col0 = u.pn * BM + wc * 32 + 8 * fq;
        f32x4 cs[2][2];
        if (RS == 2) {
#pragma unroll
            for (int bj = 0; bj < 2; ++bj) { cs[bj][0] = *(const f32x4*)(rs + col0 + bj * HALF); cs[bj][1] = *(const f32x4*)(rs + col0 + bj * HALF + 4);
#pragma unroll
                for (int e = 0; e < 4; ++e) { cs[bj][0][e] = __builtin_amdgcn_rsqf(cs[bj][0][e] * (1.f / 2048.f) + 1e-6f); cs[bj][1][e] = __builtin_amdgcn_rsqf(cs[bj][1][e] * (1.f / 2048.f) + 1e-6f); } } }
#pragma unroll
        for (int ai = 0; ai < 2; ++ai)
#pragma unroll
            for (int m = 0; m < 4; ++m) { const int row = row0 + ai * HALF + m * 16; bf16_t* rowp = O + (size_t)row * ldc + col0;
                float rsc = 1.f; if (RS == 1) rsc = rsv[ai * 4 + m];
#pragma unroll
                for (int bj = 0; bj < 2; ++bj) { f32x4 v0 = acc[ai][bj][m][0], v1 = acc[ai][bj][m][1];
                    if (RS == 1) { v0 *= rsc; v1 *= rsc; }
                    if (RS == 2) { v0 *= cs[bj][0]; v1 *= cs[bj][1]; }
                    if (ACT == 1) {
#pragma unroll
                        for (int j = 0; j < 4; ++j) { float a = fmaxf(v0[j], 0.f), b = fmaxf(v1[j], 0.f); v0[j] = a * a; v1[j] = b * b; } }
                    u32x4 w; w.x = pk2(v0[0], v0[1]); w.y = pk2(v0[2], v0[3]); w.z = pk2(v1[0], v1[1]); w.w = pk2(v1[2], v1[3]);
                    *(u32x4*)(rowp + bj * HALF) = w; } }
    }
};

struct PanelOrder {
    int c;
    __device__ bool next(int i, Unit& u) const { if (i >= 2) return false; const int x = c & 7, k = c >> 3; u.pm = i * 32 + x * 4 + (k >> 3); u.pn = k & 7; return true; }
};
template <bool FINAL> struct EpiRes {
    static constexpr bool PERM = true;
    bf16_t* hb; float* out; const float* g1; float* ssY; float* ssH; unsigned* cnt;
    __device__ __forceinline__ void load_rs(const Unit&, int, int, float (&)[8]) const {}
    __device__ __forceinline__ void operator()(const f32x4 (&acc)[2][2][4][2], const Unit& u, int wr, int wc, int fr, int fq, const float (&)[8]) const {
        const int row0 = u.pm * BM + wr * 64 + fr, col0 = u.pn * BM + wc * 32 + 8 * fq;
#pragma unroll
        for (int q = 0; q < 8; ++q) { const int ai = q >> 2, m = q & 3; float sq = 0.f;
#pragma unroll
            for (int bj = 0; bj < 2; ++bj)
#pragma unroll
                for (int n = 0; n < 2; ++n)
#pragma unroll
                    for (int e = 0; e < 4; ++e) sq += acc[ai][bj][m][n][e] * acc[ai][bj][m][n][e];
            sq += __shfl_xor(sq, 16); sq += __shfl_xor(sq, 32);
            if (fq == 0) (void)__hip_atomic_fetch_add(ssY + row0 + ai * HALF + m * 16, sq, __ATOMIC_RELAXED, __HIP_MEMORY_SCOPE_AGENT); }
        asm volatile("s_waitcnt vmcnt(0)" ::: "memory");
        __builtin_amdgcn_s_barrier();
        if (threadIdx.x == 0) {
            (void)__hip_atomic_fetch_add(cnt + u.pm, 1u, __ATOMIC_RELAXED, __HIP_MEMORY_SCOPE_AGENT);
            unsigned sp = 0;
            while (__hip_atomic_load(cnt + u.pm, __ATOMIC_RELAXED, __HIP_MEMORY_SCOPE_AGENT) < 8u) { __builtin_amdgcn_s_sleep(1); if (++sp > (1u << 22)) break; }
        }
        asm volatile("" ::: "memory");
        __builtin_amdgcn_s_barrier();
        asm volatile("" ::: "memory");
        f32x4 gv[2][2];
#pragma unroll
        for (int bj = 0; bj < 2; ++bj) { gv[bj][0] = *(const f32x4*)(g1 + col0 + bj * HALF); gv[bj][1] = *(const f32x4*)(g1 + col0 + bj * HALF + 4); }
#pragma unroll
        for (int q = 0; q < 8; ++q) { const int ai = q >> 2, m = q & 3, row = row0 + ai * HALF + m * 16;
            const float rs1 = __builtin_amdgcn_rsqf(__hip_atomic_load(ssY + row, __ATOMIC_RELAXED, __HIP_MEMORY_SCOPE_AGENT) * (1.f / 2048.f) + 1e-6f);
            bf16_t* rowp = hb + (size_t)row * 2048 + col0; float s2 = 0.f;
#pragma unroll
            for (int bj = 0; bj < 2; ++bj) { const u32x4 hw = *(const u32x4*)(rowp + bj * HALF);
                f32x4 h0, h1;
                h0[0] = __uint_as_float(hw[0] << 16); h0[1] = __uint_as_float(hw[0] & 0xffff0000u); h0[2] = __uint_as_float(hw[1] << 16); h0[3] = __uint_as_float(hw[1] & 0xffff0000u);
                h1[0] = __uint_as_float(hw[2] << 16); h1[1] = __uint_as_float(hw[2] & 0xffff0000u); h1[2] = __uint_as_float(hw[3] << 16); h1[3] = __uint_as_float(hw[3] & 0xffff0000u);
                h0 += acc[ai][bj][m][0] * rs1 * gv[bj][0]; h1 += acc[ai][bj][m][1] * rs1 * gv[bj][1];
                if (FINAL) { float* op = out + (size_t)row * 2048 + col0 + bj * HALF; *(f32x4*)op = h0; *(f32x4*)(op + 4) = h1; }
                else {
#pragma unroll
                    for (int e = 0; e < 4; ++e) s2 += h0[e] * h0[e] + h1[e] * h1[e];
                    u32x4 w; w.x = pk2(h0[0], h0[1]); w.y = pk2(h0[2], h0[3]); w.z = pk2(h1[0], h1[1]); w.w = pk2(h1[2], h1[3]);
                    *(u32x4*)(rowp + bj * HALF) = w; } }
            if (!FINAL) { s2 += __shfl_xor(s2, 16); s2 += __shfl_xor(s2, 32);
                if (fq == 0) (void)__hip_atomic_fetch_add(ssH + row, s2, __ATOMIC_RELAXED, __HIP_MEMORY_SCOPE_AGENT); } }
    }
};

template <class Epi, class Sched>
__device__ __forceinline__ void gemm_phase(LAS unsigned char* lds, const Gemm g, const Sched& S, const Epi& E) {
    const int tid = threadIdx.x, wid = __builtin_amdgcn_readfirstlane(tid >> 6), lane = tid & 63, wr = wid >> 2, wc = wid & 3, fr = lane & 15, fq = lane >> 4;
    const int K = g.K, nt = K / BK;
    unsigned voffA[2], voffB[2];
#pragma unroll
    for (int i = 0; i < 2; ++i) { int R, C; stage_rc(tid * 16 + i * 8192, R, C); const int Rb = Epi::PERM ? ((R & ~31) + perm32(R & 31)) : R;
        voffA[i] = (unsigned)(R * K + C) * 2u; voffB[i] = (unsigned)(Rb * K + C) * 2u; }
    const size_t kstep = (size_t)(BK * 2);
    const size_t hstep = (size_t)HALF * K * 2;
    const size_t tstep = 2 * hstep;
    const unsigned ldsw = (unsigned)wid * 1024u;
    const int aoff = lds_byte(wr * 64 + fr, fq * 8), boff = lds_byte(wc * 32 + fr, fq * 8);
#define PG8_SA(b, h) (((b) * 2 + (h)) * HTB)
#define PG8_SB(b, h) ((4 + (b) * 2 + (h)) * HTB)
#define PG8_STAGE(bufoff, gbase, voff) do { _Pragma("unroll") for (int _i = 0; _i < 2; ++_i) \
        __builtin_amdgcn_global_load_lds((const unsigned*)((const char*)(gbase) + (voff)[_i]), (LAS unsigned*)(lds + (bufoff) + ldsw + _i * 8192), 16, 0, 0); } while (0)
#define PG8_LDA(dst, b, h) do { _Pragma("unroll") for (int m = 0; m < 4; ++m) _Pragma("unroll") for (int k = 0; k < 2; ++k) dst[m][k] = *(const LAS bf16x8*)(lds + PG8_SA(b, h) + aoff + m * 2048 + k * 1024); } while (0)
#define PG8_LDB(dst, b, h) do { _Pragma("unroll") for (int n = 0; n < 2; ++n) _Pragma("unroll") for (int k = 0; k < 2; ++k) dst[n][k] = *(const LAS bf16x8*)(lds + PG8_SB(b, h) + boff + n * 2048 + k * 1024); } while (0)
#define PG8_MMA(ai, bj, At, Bt) do { __builtin_amdgcn_s_setprio(1); _Pragma("unroll") for (int m = 0; m < 4; ++m) _Pragma("unroll") for (int n = 0; n < 2; ++n) _Pragma("unroll") for (int k = 0; k < 2; ++k) \
        acc[ai][bj][m][n] = __builtin_amdgcn_mfma_f32_16x16x32_bf16(Bt[n][k], At[m][k], acc[ai][bj][m][n], 0, 0, 0); __builtin_amdgcn_s_setprio(0); } while (0)
#define PG8_WAIT_V(n) asm volatile("s_waitcnt vmcnt(" #n ")" ::: "memory")
#define PG8_WAIT_L(n) asm volatile("s_waitcnt lgkmcnt(" #n ")" ::: "memory")
#define PG8_BAR __builtin_amdgcn_s_barrier()
#define PG8_SCHED __builtin_amdgcn_sched_barrier(0)
    Unit cur, nxt; int ui = 0;
    if (!S.next(0, cur)) return;
    f32x4 acc[2][2][4][2];
#pragma unroll
    for (int a = 0; a < 2; ++a)
#pragma unroll
        for (int b = 0; b < 2; ++b)
#pragma unroll
            for (int m = 0; m < 4; ++m)
#pragma unroll
                for (int n = 0; n < 2; ++n) acc[a][b][m][n] = (f32x4){0.f, 0.f, 0.f, 0.f};
    bf16x8 At[4][2], B0[2][2], B1[2][2];
    const char* cA = (const char*)g.A + (size_t)cur.pm * tstep; const char* cB = (const char*)g.Bt + (size_t)cur.pn * tstep;
    float rsv[8] = {1.f, 1.f, 1.f, 1.f, 1.f, 1.f, 1.f, 1.f};
    E.load_rs(cur, wr, fr, rsv);
    PG8_STAGE(PG8_SB(0, 0), cB, voffB); PG8_STAGE(PG8_SB(0, 1), cB + hstep, voffB); PG8_STAGE(PG8_SA(0, 0), cA, voffA); PG8_STAGE(PG8_SA(0, 1), cA + hstep, voffA);
    if (wr == 1) PG8_BAR;
    PG8_WAIT_V(2); PG8_BAR;
    PG8_STAGE(PG8_SB(1, 0), cB + kstep, voffB); PG8_STAGE(PG8_SA(1, 0), cA + kstep, voffA); PG8_STAGE(PG8_SB(1, 1), cB + hstep + kstep, voffB);
    PG8_WAIT_V(6); PG8_BAR;
    for (;;) {
        const bool has_next = S.next(ui + 1, nxt);
        const char* nA = has_next ? (const char*)g.A + (size_t)nxt.pm * tstep : cA; const char* nB = has_next ? (const char*)g.Bt + (size_t)nxt.pn * tstep : cB;
        for (int t = 0; t < nt; t += 2) {
            const bool last = (t == nt - 2);
            const char* a1 = cA + (size_t)(t + 1) * kstep;
            const char* a2 = last ? nA : cA + (size_t)(t + 2) * kstep; const char* b2 = last ? nB : cB + (size_t)(t + 2) * kstep;
            const char* a3 = a2 + kstep; const char* b3 = b2 + kstep;
            PG8_LDB(B0, 0, 0); PG8_LDB(B1, 0, 1); PG8_SCHED; PG8_LDA(At, 0, 0); PG8_STAGE(PG8_SA(1, 1), a1 + hstep, voffA);
            PG8_WAIT_V(8); PG8_WAIT_L(0); PG8_BAR; PG8_MMA(0, 0, At, B0); PG8_MMA(0, 1, At, B1); PG8_BAR; PG8_SCHED;
            PG8_LDA(At, 0, 1); PG8_STAGE(PG8_SB(0, 0), b2, voffB); PG8_STAGE(PG8_SB(0, 1), b2 + hstep, voffB); PG8_STAGE(PG8_SA(0, 0), a2, voffA);
            PG8_WAIT_V(8); PG8_WAIT_L(0); PG8_BAR; PG8_MMA(1, 0, At, B0); PG8_MMA(1, 1, At, B1); PG8_BAR; PG8_SCHED;
            PG8_LDB(B0, 1, 0); PG8_LDB(B1, 1, 1); PG8_SCHED; PG8_LDA(At, 1, 0); PG8_STAGE(PG8_SA(0, 1), a2 + hstep, voffA);
            PG8_WAIT_V(8); PG8_WAIT_L(0); PG8_BAR; PG8_MMA(0, 0, At, B0); PG8_MMA(0, 1, At, B1); PG8_BAR; PG8_SCHED;
            PG8_LDA(At, 1, 1); PG8_STAGE(PG8_SB(1, 0), b3, voffB); PG8_STAGE(PG8_SB(1, 1), b3 + hstep, voffB); PG8_STAGE(PG8_SA(1, 0), a3, voffA);
            PG8_WAIT_V(8); PG8_WAIT_L(0); PG8_BAR; PG8_MMA(1, 0, At, B0); PG8_MMA(1, 1, At, B1); PG8_BAR; PG8_SCHED;
        }
        if (wr == 0) PG8_BAR;
        E(acc, cur, wr, wc, fr, fq, rsv);
        if (!has_next) break;
        E.load_rs(nxt, wr, fr, rsv);
#pragma unroll
        for (int a = 0; a < 2; ++a)
#pragma unroll
            for (int b = 0; b < 2; ++b)
#pragma unroll
                for (int m = 0; m < 4; ++m)
#pragma unroll
                    for (int n = 0; n < 2; ++n) acc[a][b][m][n] = (f32x4){0.f, 0.f, 0.f, 0.f};
        cur = nxt; cA = nA; cB = nB; ++ui;
        if (wr == 1) PG8_BAR;
    }
    PG8_WAIT_V(0);
    PG8_BAR;
#undef PG8_SA
#undef PG8_SB
#undef PG8_STAGE
#undef PG8_LDA
#undef PG8_LDB
#undef PG8_MMA
#undef PG8_WAIT_V
#undef PG8_WAIT_L
#undef PG8_BAR
#undef PG8_SCHED
}
}

struct Params {
    const float* x; const float* norm_g; const float* even_w_in; const float* conv_w; const float* rel_bias; const float* even_w_out;
    const float* odd_w_in; const float* hgrn_lb; const float* hgrn_ng; const float* wa2; const float* ba; const float* gla_ng; const float* odd_w_out;
    const float* w1; const float* w2; float* out; unsigned char* ws; int ph_lo, ph_hi;
};

__device__ __forceinline__ void cvt_seg(const float* __restrict__ W, int K, int NS, int c0, int nc, bf16_t* __restrict__ WT, int r0, const float* __restrict__ gf, float* scr, int gw, int NGW, int lane) {
    const int nblk = (nc + 31) >> 5, nitems = (K >> 6) * nblk;
    const int krow = lane >> 3, c4 = (lane & 7) * 4;
    for (int it = gw; it < nitems; it += NGW) {
        const int kb = it / nblk, nb = it - kb * nblk, k0 = kb * 64, n0 = nb * 32;
        const bool ok = (n0 + c4) < nc;
        const float* src = W + (size_t)(k0 + krow) * NS + c0 + n0 + c4;
        f32x4 v[8];
#pragma unroll
        for (int i = 0; i < 8; ++i) v[i] = ok ? __builtin_nontemporal_load((const f32x4*)(src + (size_t)(8 * i) * NS)) : (f32x4){0.f, 0.f, 0.f, 0.f};
        if (gf) {
#pragma unroll
            for (int i = 0; i < 8; ++i) v[i] *= gf[k0 + 8 * i + krow]; }
#pragma unroll
        for (int i = 0; i < 8; ++i) { float* d = scr + (8 * i + krow) * 33 + c4; d[0] = v[i][0]; d[1] = v[i][1]; d[2] = v[i][2]; d[3] = v[i][3]; }
        LDS_WAIT();
        const int c = lane & 7;
#pragma unroll
        for (int j = 0; j < 4; ++j) { const int n = (lane >> 3) + 8 * j; const float* s = scr + (8 * c) * 33 + n;
            u32x4 o; o.x = pk2(s[0], s[33]); o.y = pk2(s[66], s[99]); o.z = pk2(s[132], s[165]); o.w = pk2(s[198], s[231]);
            if (n0 + n < nc) *(u32x4*)(WT + (size_t)(r0 + n0 + n) * K + k0 + 8 * c) = o; }
        LDS_WAIT();
    }
}

template <int MODE>
__device__ __forceinline__ void rowwise(const float* __restrict__ xin, const bf16_t* __restrict__ ysrc, const float* __restrict__ g1,
                                        bf16_t* hb, float* __restrict__ rsout, float* __restrict__ out, int gw, int NGW, int lane) {
    for (int row0 = gw; row0 < NTOK; row0 += 2 * NGW) {
        f32x4 h[2][4][2]; u32x4 yw[2][4], hw[2][4];
#pragma unroll
        for (int rr = 0; rr < 2; ++rr) { const size_t rb = (size_t)(row0 + rr * NGW) * DM;
#pragma unroll
            for (int j = 0; j < 4; ++j) { const int col = 512 * j + 8 * lane;
                if (MODE == 0) { h[rr][j][0] = __builtin_nontemporal_load((const f32x4*)(xin + rb + col)); h[rr][j][1] = __builtin_nontemporal_load((const f32x4*)(xin + rb + col + 4)); }
                else { hw[rr][j] = *(const u32x4*)(hb + rb + col); yw[rr][j] = *(const u32x4*)(ysrc + rb + col); } } }
#pragma unroll
        for (int rr = 0; rr < 2; ++rr) {
            const int row = row0 + rr * NGW; const size_t rb = (size_t)row * DM;
            if (MODE != 0) {
                float y[4][8]; float ss = 0.f;
#pragma unroll
                for (int j = 0; j < 4; ++j) {
#pragma unroll
                    for (int e = 0; e < 4; ++e) { y[j][2 * e] = __uint_as_float(yw[rr][j][e] << 16); y[j][2 * e + 1] = __uint_as_float(yw[rr][j][e] & 0xffff0000u);
                        h[rr][j][e >> 1][(2 * e) & 3] = __uint_as_float(hw[rr][j][e] << 16); h[rr][j][e >> 1][(2 * e + 1) & 3] = __uint_as_float(hw[rr][j][e] & 0xffff0000u); }
#pragma unroll
                    for (int e = 0; e < 8; ++e) ss += y[j][e] * y[j][e]; }
                const float rs = rsqrtf(wave_sum(ss) * (1.f / DM) + EPS);
#pragma unroll
                for (int j = 0; j < 4; ++j) { const int col = 512 * j + 8 * lane; const f32x4 ga = *(const f32x4*)(g1 + col), gb = *(const f32x4*)(g1 + col + 4);
#pragma unroll
                    for (int e = 0; e < 4; ++e) { h[rr][j][0][e] += y[j][e] * rs * ga[e]; h[rr][j][1][e] += y[j][4 + e] * rs * gb[e]; }
                    if (MODE == 2) { *(f32x4*)(out + rb + col) = h[rr][j][0]; *(f32x4*)(out + rb + col + 4) = h[rr][j][1]; } }
            }
            if (MODE != 2) {
                float ss = 0.f;
#pragma unroll
                for (int j = 0; j < 4; ++j)
#pragma unroll
                    for (int e = 0; e < 4; ++e) ss += h[rr][j][0][e] * h[rr][j][0][e] + h[rr][j][1][e] * h[rr][j][1][e];
                const float sst = wave_sum(ss);
                if (lane == 0) rsout[row] = sst;
#pragma unroll
                for (int j = 0; j < 4; ++j) { const int col = 512 * j + 8 * lane;
                    u32x4 o; o.x = pk2(h[rr][j][0][0], h[rr][j][0][1]); o.y = pk2(h[rr][j][0][2], h[rr][j][0][3]);
                    o.z = pk2(h[rr][j][1][0], h[rr][j][1][1]); o.w = pk2(h[rr][j][1][2], h[rr][j][1][3]);
                    *(u32x4*)(hb + rb + col) = o; }
            }
        }
    }
}

__device__ __forceinline__ void conv_phase(const bf16_t* __restrict__ P, const float* __restrict__ cw, bf16_t* __restrict__ ycat) {
    const int nthr = gridDim.x * 512;
#pragma unroll 2
    for (int it = blockIdx.x * 512 + threadIdx.x; it < NTOK * 128; it += nthr) {
        const int t = it >> 7, c0 = (it & 127) * 8, tp = t & (SEQ - 1);
        const bf16_t* row = P + (size_t)t * LDE + c0;
        const u32x4 bg = *(const u32x4*)(row), c2 = *(const u32x4*)(row + 1024), h2 = *(const u32x4*)(row + 2048);
        u32x4 c1 = (u32x4){0, 0, 0, 0}, h1 = c1, cz = c1, hz = c1;
        if (tp >= 1) { c1 = *(const u32x4*)(row - LDE + 1024); h1 = *(const u32x4*)(row - LDE + 2048); }
        if (tp >= 2) { cz = *(const u32x4*)(row - 2 * LDE + 1024); hz = *(const u32x4*)(row - 2 * LDE + 2048); }
        float o[8];
#pragma unroll
        for (int e = 0; e < 8; ++e) {
            const int sh = (e & 1) ? 0 : 16; const int w = e >> 1;
            auto get = [&](const u32x4& v) { return __uint_as_float((v[w] << sh) & 0xffff0000u); };
            const float u2 = get(c2) * get(h2), u1 = get(c1) * get(h1), u0 = get(cz) * get(hz);
            const float y = cw[c0 + e] * u0 + cw[1024 + c0 + e] * u1 + cw[2048 + c0 + e] * u2;
            o[e] = get(bg) * y;
        }
        u32x4 w; w.x = pk2(o[0], o[1]); w.y = pk2(o[2], o[3]); w.z = pk2(o[4], o[5]); w.w = pk2(o[6], o[7]);
        *(u32x4*)(ycat + (size_t)t * DM + c0) = w;
    }
}

__device__ __forceinline__ void attn_phase(unsigned char* smem, const bf16_t* __restrict__ P, const bf16_t* __restrict__ VT, const float* __restrict__ relb, bf16_t* __restrict__ ycat) {
    const int tid = threadIdx.x, lane = tid & 63, wave = tid >> 6, half = wave >> 2, w4 = wave & 3, ltid = tid & 255, r = lane & 15, q8 = lane >> 4;
    unsigned char* base = smem + half * 47616;
    bf16_t* kS = (bf16_t*)base;
    bf16_t* vS = (bf16_t*)(base + 17408);
    bf16_t* pS = (bf16_t*)(base + 35840);
    float* bS = (float*)(base + 45056);
    const float scale = 0.08838834764831845f * 1.4426950408889634f;
    for (int pair = blockIdx.x; pair < 1024; pair += gridDim.x) {
        const int hp = pair & 3, n = (pair >> 2) & 63, b = pair >> 8, head = hp * 2 + half;
        const int tok0 = b * SEQ + n * 64;
        __syncthreads();
        for (int i = ltid; i < 640; i += 256) bS[i] = relb[head * 320 + (i < 319 ? i : 319)] * 1.4426950408889634f;
        bf16x8 qf[4];
        { const bf16_t* qp = P + (size_t)(tok0 + 16 * w4 + r) * LDE + 3072 + head * 128 + 8 * q8;
#pragma unroll
          for (int kk = 0; kk < 4; ++kk) qf[kk] = *(const bf16x8*)(qp + 32 * kk); }
        float m[4], l[4]; f32x4 o[8];
#pragma unroll
        for (int j = 0; j < 4; ++j) { m[j] = -1e30f; l[j] = 0.f; }
#pragma unroll
        for (int i = 0; i < 8; ++i) o[i] = (f32x4){0.f, 0.f, 0.f, 0.f};
        const int js0 = (n < 8 ? 8 - n : 0);
        u32x4 kreg[4], vreg[4];
        { const int ktok0 = tok0 + (js0 - 8) * 64;
#pragma unroll
          for (int i = 0; i < 4; ++i) { const int ch = ltid + 256 * i;
              kreg[i] = *(const u32x4*)(P + (size_t)(ktok0 + (ch >> 4)) * LDE + 4096 + head * 128 + (ch & 15) * 8);
              vreg[i] = *(const u32x4*)(VT + (size_t)(head * 128 + (ch >> 3)) * NTOK + ktok0 + (ch & 7) * 8); } }
        for (int js = js0; js <= 8; ++js) {
            __syncthreads();
#pragma unroll
            for (int i = 0; i < 4; ++i) { const int ch = ltid + 256 * i;
                *(u32x4*)(kS + (ch >> 4) * 136 + (ch & 15) * 8) = kreg[i];
                *(u32x4*)(vS + (ch >> 3) * 72 + (ch & 7) * 8) = vreg[i]; }
            __syncthreads();
            if (js < 8) { const int ktok0 = tok0 + (js + 1 - 8) * 64;
#pragma unroll
                for (int i = 0; i < 4; ++i) { const int ch = ltid + 256 * i;
                    kreg[i] = *(const u32x4*)(P + (size_t)(ktok0 + (ch >> 4)) * LDE + 4096 + head * 128 + (ch & 15) * 8);
                    vreg[i] = *(const u32x4*)(VT + (size_t)(head * 128 + (ch >> 3)) * NTOK + ktok0 + (ch & 7) * 8); } }
            f32x4 s[4];
#pragma unroll
            for (int nt = 0; nt < 4; ++nt) { s[nt] = (f32x4){0.f, 0.f, 0.f, 0.f};
#pragma unroll
                for (int kk = 0; kk < 4; ++kk) { const bf16x8 kf = *(const bf16x8*)(kS + (16 * nt + r) * 136 + 32 * kk + 8 * q8);
                    s[nt] = __builtin_amdgcn_mfma_f32_16x16x32_bf16(qf[kk], kf, s[nt], 0, 0, 0); } }
            float alpha[4];
            const float* bT = bS + (16 * w4 + 4 * q8 - r + 63 + (8 - js) * 64);
#pragma unroll
            for (int j = 0; j < 4; ++j) {
                float mx = -1e30f;
#pragma unroll
                for (int nt = 0; nt < 4; ++nt) { const float v = s[nt][j] * scale + bT[j - 16 * nt]; s[nt][j] = v; mx = fmaxf(mx, v); }
                mx = row16_max(mx);
                const float mn = fmaxf(m[j], mx); alpha[j] = __builtin_amdgcn_exp2f(m[j] - mn); m[j] = mn;
                float ps = 0.f;
#pragma unroll
                for (int nt = 0; nt < 4; ++nt) { const float pp = __builtin_amdgcn_exp2f(s[nt][j] - mn); ps += pp; pS[(16 * w4 + 4 * q8 + j) * 72 + 16 * nt + r] = f2bf(pp); }
                l[j] = l[j] * alpha[j] + ps;
            }
#pragma unroll
            for (int i = 0; i < 8; ++i)
#pragma unroll
                for (int j = 0; j < 4; ++j) o[i][j] *= alpha[j];
            LDS_WAIT();
#pragma unroll
            for (int kk = 0; kk < 2; ++kk) { const bf16x8 pf = *(const bf16x8*)(pS + (16 * w4 + r) * 72 + 32 * kk + 8 * q8);
#pragma unroll
                for (int i = 0; i < 8; ++i) { const bf16x8 vf = *(const bf16x8*)(vS + (16 * i + r) * 72 + 32 * kk + 8 * q8);
                    o[i] = __builtin_amdgcn_mfma_f32_16x16x32_bf16(pf, vf, o[i], 0, 0, 0); } }
        }
#pragma unroll
        for (int j = 0; j < 4; ++j) { float lt = l[j];
#pragma unroll
            for (int ofs = 1; ofs < 16; ofs <<= 1) lt += __shfl_xor(lt, ofs);
            const float inv = frcp(lt);
            bf16_t* op = ycat + (size_t)(tok0 + 16 * w4 + 4 * q8 + j) * DM + 1024 + head * 128 + r;
#pragma unroll
            for (int i = 0; i < 8; ++i) op[16 * i] = f2bf(o[i][j] * inv); }
    }
}

template <int KIND, bool WANT_Q>
__device__ __forceinline__ void decay_qk(const Params& p, const bf16_t* __restrict__ P, int tok0, int hd, int d, int tq, float (&bl)[16], float (&kv)[16], float (&qv)[16], const bf16_t (&ra)[16], const bf16_t (&rq)[16], const u32x4& gaR) {
    const int col = hd * 128 + d;
    const bf16_t* rp = P + (size_t)(tok0 + 16 * tq) * LDO;
    if (KIND == 0) {
        const float lb = frcp(1.f + __expf(p.hgrn_lb[col] - p.hgrn_lb[1024 + col]));
        float run = 0.f;
#pragma unroll
        for (int jj = 0; jj < 16; ++jj) {
            const float fr = bf2f(ra[jj]);
            const float f = lb + (1.f - lb) * sigmoidf_(fr);
            run += __logf(f); bl[jj] = run; kv[jj] = 1.f - f;
            if (WANT_Q) { const float qr = bf2f(rq[jj]); qv[jj] = qr * sigmoidf_(qr); }
        }
    } else {
        float w[16];
#pragma unroll
        for (int rr = 0; rr < 16; ++rr) w[rr] = p.wa2[rr * 512 + col];
        const float bias = p.ba[col];
        float run = 0.f;
#pragma unroll
        for (int jj = 0; jj < 16; ++jj) {
            u32x4 g0, g1;
#pragma unroll
            for (int e = 0; e < 4; ++e) { g0[e] = (unsigned)__builtin_amdgcn_readlane((int)gaR[e], 2 * jj); g1[e] = (unsigned)__builtin_amdgcn_readlane((int)gaR[e], 2 * jj + 1); }
            float xx = bias;
#pragma unroll
            for (int e = 0; e < 4; ++e) {
                xx += __uint_as_float(g0[e] << 16) * w[2 * e] + __uint_as_float(g0[e] & 0xffff0000u) * w[2 * e + 1];
                xx += __uint_as_float(g1[e] << 16) * w[8 + 2 * e] + __uint_as_float(g1[e] & 0xffff0000u) * w[8 + 2 * e + 1];
            }
            const float ls = fminf(xx, 0.f) - __logf(1.f + __expf(-fabsf(xx)));
            run += ls * (1.f / 16.f); bl[jj] = run;
            kv[jj] = bf2f(ra[jj]);
            if (WANT_Q) qv[jj] = bf2f(rq[jj]) * 0.08838834764831845f;
        }
    }
}

template <int KIND, bool WANT_Q>
__device__ __forceinline__ void load_raw(const bf16_t* __restrict__ P, const bf16_t* __restrict__ VT, int idx, bf16_t (&ra)[16], bf16_t (&rq)[16], u32x4 (&vr)[KIND ? 4 : 2], u32x4& gaR) {
    constexpr int DV = KIND ? 256 : 128;
    const int tid = threadIdx.x, d = tid & 127, tq = tid >> 7;
    const int c = idx & 63, bh = idx >> 6, hd = KIND ? (bh & 3) : (bh & 7), b = KIND ? (bh >> 2) : (bh >> 3);
    const int tok0 = b * SEQ + c * 64, col = hd * 128 + d;
    const bf16_t* rp = P + (size_t)(tok0 + 16 * tq) * LDO;
#pragma unroll
    for (int jj = 0; jj < 16; ++jj) {
        ra[jj] = WANT_Q ? __builtin_nontemporal_load(rp + (size_t)jj * LDO + (KIND ? 3584 : 1024) + col) : rp[(size_t)jj * LDO + (KIND ? 3584 : 1024) + col];
        if (WANT_Q) rq[jj] = __builtin_nontemporal_load(rp + (size_t)jj * LDO + (KIND ? 3072 : 0) + col); }
    if (KIND == 1) gaR = *(const u32x4*)(rp + (size_t)((tid & 31) >> 1) * LDO + 5120 + (tid & 1) * 8);
    const bf16_t* vsrc = VT + (size_t)((KIND ? 1024 + hd * 256 : hd * 128)) * NTOK + tok0;
#pragma unroll
    for (int i = 0; i < DV / 64; ++i) { const int ch = tid + 512 * i, row = ch >> 3, c8 = ch & 7;
        vr[i] = WANT_Q ? __builtin_nontemporal_load((const u32x4*)(vsrc + (size_t)row * NTOK + c8 * 8)) : *(const u32x4*)(vsrc + (size_t)row * NTOK + c8 * 8); }
}

template <int KIND>
__device__ __forceinline__ void passA_item(const Params& p, unsigned char* smem_base, const bf16_t* __restrict__ P, const bf16_t* __restrict__ VT, bf16_t* __restrict__ ST, float* __restrict__ DEC, int idx, int par, int nidx, bf16_t (&ra)[16], bf16_t (&rq)[16], u32x4 (&vr)[KIND ? 4 : 2], u32x4& gaR) {
    unsigned char* smem = smem_base + par * 57344;
    constexpr int DV = KIND ? 256 : 128;
    const int tid = threadIdx.x, lane = tid & 63, wave = tid >> 6, r = lane & 15, q8 = lane >> 4, d = tid & 127, tq = tid >> 7;
    const int c = idx & 63, bh = idx >> 6, hd = KIND ? (bh & 3) : (bh & 7), b = KIND ? (bh >> 2) : (bh >> 3);
    const int tok0 = b * SEQ + c * 64;
    bf16_t* kT = (bf16_t*)smem;
    bf16_t* vS = (bf16_t*)(smem + 18432);
    float* tot = (float*)(smem + 18432 + 36864);
    float bl[16], kv[16], qv[16];
    decay_qk<KIND, false>(p, P, tok0, hd, d, tq, bl, kv, qv, ra, rq, gaR);
    tot[tq * 128 + d] = bl[15];
#pragma unroll
    for (int i = 0; i < DV / 64; ++i) { const int ch = tid + 512 * i, row = ch >> 3, c8 = ch & 7; *(u32x4*)(vS + row * 72 + c8 * 8) = vr[i]; }
    __syncthreads();
    if (nidx >= 0) load_raw<KIND, false>(P, VT, nidx, ra, rq, vr, gaR);
    const float t0 = tot[d], t1 = tot[128 + d], t2 = tot[256 + d], t3 = tot[384 + d];
    const float r4 = t0 + t1 + t2 + t3;
    const float rpre = (tq > 0 ? t0 : 0.f) + (tq > 1 ? t1 : 0.f) + (tq > 2 ? t2 : 0.f);
    {
        float kt[16];
#pragma unroll
        for (int jj = 0; jj < 16; ++jj) kt[jj] = kv[jj] * __expf(r4 - rpre - bl[jj]);
        u32x4 w0, w1;
        w0.x = pk2(kt[0], kt[1]); w0.y = pk2(kt[2], kt[3]); w0.z = pk2(kt[4], kt[5]); w0.w = pk2(kt[6], kt[7]);
        w1.x = pk2(kt[8], kt[9]); w1.y = pk2(kt[10], kt[11]); w1.z = pk2(kt[12], kt[13]); w1.w = pk2(kt[14], kt[15]);
        *(u32x4*)(kT + d * 72 + 16 * tq) = w0; *(u32x4*)(kT + d * 72 + 16 * tq + 8) = w1;
    }
    const int gitem = (KIND ? 2048 : 0) + idx;
    if (tq == 0) DEC[(size_t)gitem * 128 + d] = __expf(r4);
    __syncthreads();
    const int d0 = 16 * wave;
    bf16x8 af[2];
#pragma unroll
    for (int kk = 0; kk < 2; ++kk) af[kk] = *(const bf16x8*)(kT + (d0 + r) * 72 + 32 * kk + 8 * q8);
    bf16_t* stb = ST + (KIND ? (size_t)33554432 : 0) + (size_t)idx * (DV * 128);
#pragma unroll
    for (int nt = 0; nt < DV / 16; ++nt) {
        f32x4 acc = (f32x4){0.f, 0.f, 0.f, 0.f};
#pragma unroll
        for (int kk = 0; kk < 2; ++kk) { const bf16x8 bfr = *(const bf16x8*)(vS + (16 * nt + r) * 72 + 32 * kk + 8 * q8);
            acc = __builtin_amdgcn_mfma_f32_16x16x32_bf16(af[kk], bfr, acc, 0, 0, 0); }
        u32x2 w; w.x = pk2(acc[0], acc[1]); w.y = pk2(acc[2], acc[3]);
        *(u32x2*)(stb + (size_t)(16 * nt + r) * 128 + d0 + 4 * q8) = w;
    }
}

__device__ __forceinline__ void scan_phase(bf16_t* __restrict__ ST, const float* __restrict__ DEC) {
    const int nthr = gridDim.x * 512;
    for (int gid = blockIdx.x * 512 + threadIdx.x; gid < 131072; gid += nthr) {
        const int kind = gid >> 16, v = gid & 65535;
        const int vper = kind ? 4096 : 2048, bh = v / vper, vi = v - bh * vper, d0 = (vi * 8) & 127;
        const size_t csz = kind ? 32768 : 16384;
        bf16_t* sp = ST + (kind ? (size_t)33554432 : 0) + (size_t)bh * 64 * csz + (size_t)vi * 8;
        const float* dp = DEC + (size_t)((kind ? 2048 : 0) + bh * 64) * 128 + d0;
        float S[8];
#pragma unroll
        for (int e = 0; e < 8; ++e) S[e] = 0.f;
#pragma unroll 8
        for (int c = 0; c < 64; ++c) {
            const u32x4 u = __builtin_nontemporal_load((const u32x4*)(sp + (size_t)c * csz));
            const f32x4 da = *(const f32x4*)(dp + c * 128), db = *(const f32x4*)(dp + c * 128 + 4);
            u32x4 w; w.x = pk2(S[0], S[1]); w.y = pk2(S[2], S[3]); w.z = pk2(S[4], S[5]); w.w = pk2(S[6], S[7]);
            *(u32x4*)(sp + (size_t)c * csz) = w;
#pragma unroll
            for (int e = 0; e < 4; ++e) {
                S[2 * e] = S[2 * e] * (e < 2 ? da[2 * e] : db[2 * e - 4]) + __uint_as_float(u[e] << 16);
                S[2 * e + 1] = S[2 * e + 1] * (e < 2 ? da[2 * e + 1] : db[2 * e - 3]) + __uint_as_float(u[e] & 0xffff0000u);
            }
        }
    }
}

template <int KIND>
__device__ __forceinline__ void passC_item(const Params& p, unsigned char* smem, const bf16_t* __restrict__ P, const bf16_t* __restrict__ VT, const bf16_t* __restrict__ ST, bf16_t* __restrict__ ycat, int idx, int nidx, bf16_t (&ra)[16], bf16_t (&rq)[16], u32x4 (&vr)[KIND ? 4 : 2], u32x4& gaR) {
    constexpr int DV = KIND ? 256 : 128;
    const int tid = threadIdx.x, lane = tid & 63, wave = tid >> 6, r = lane & 15, q8 = lane >> 4, d = tid & 127, tq = tid >> 7;
    const int c = idx & 63, bh = idx >> 6, hd = KIND ? (bh & 3) : (bh & 7), b = KIND ? (bh >> 2) : (bh >> 3);
    const int tok0 = b * SEQ + c * 64;
    bf16_t* qs = (bf16_t*)smem;
    bf16_t* qh = (bf16_t*)(smem + 17408);
    bf16_t* ks = (bf16_t*)(smem + 34816);
    bf16_t* vS = (bf16_t*)(smem + 78336);
    bf16_t* pS = (bf16_t*)(smem + 115200);
    float* tot = (float*)(smem + 124416);
    float* ssq = (float*)(smem + 126464);
    float bl[16], kv[16], qv[16];
    decay_qk<KIND, true>(p, P, tok0, hd, d, tq, bl, kv, qv, ra, rq, gaR);
    tot[tq * 128 + d] = bl[15];
#pragma unroll
    for (int i = 0; i < DV / 64; ++i) { const int ch = tid + 512 * i, row = ch >> 3, c8 = ch & 7; *(u32x4*)(vS + row * 72 + c8 * 8) = vr[i]; }
    for (int i = tid; i < 64 * 72 / 8; i += 512) *(u32x4*)(pS + i * 8) = (u32x4){0, 0, 0, 0};
    __syncthreads();
    if (nidx >= 0) load_raw<KIND, true>(P, VT, nidx, ra, rq, vr, gaR);
    constexpr int NT = DV / 32;
    constexpr int NPRE = 4;
    const int oi = wave & 3, oeh = wave >> 2;
    const bf16_t* stb = ST + (KIND ? (size_t)33554432 : 0) + (size_t)idx * (DV * 128);
    const int gcol = KIND ? 4096 + hd * 256 : 2048 + hd * 128;
    bf16x8 bst[NPRE][4];
#pragma unroll
    for (int nt = 0; nt < NPRE; ++nt)
#pragma unroll
        for (int kk = 0; kk < 4; ++kk) bst[nt][kk] = *(const bf16x8*)(stb + (size_t)(oeh * (DV / 2) + 16 * nt + r) * 128 + 32 * kk + 8 * q8);
    bf16_t graw[4][NT];
#pragma unroll
    for (int j = 0; j < 4; ++j)
#pragma unroll
        for (int nt = 0; nt < NT; ++nt) graw[j][nt] = P[(size_t)(tok0 + 16 * oi + 4 * q8 + j) * LDO + gcol + oeh * (DV / 2) + 16 * nt + r];
    {
        const float t0 = tot[d], t1 = tot[128 + d], t2 = tot[256 + d];
        const float rpre = (tq > 0 ? t0 : 0.f) + (tq > 1 ? t1 : 0.f) + (tq > 2 ? t2 : 0.f);
        const float Ttq = bl[15], rn = rpre + Ttq;
        const float einv = __expf(fminf(-Ttq, 80.f));
        const float f1 = (tq == 1) ? einv : __expf(fminf(t0 - rn, 0.f));
        const float f2 = (tq == 2) ? einv : __expf(fminf(t0 + t1 - rn, 0.f));
        const float f3 = (tq == 3) ? einv : __expf(fminf(t0 + t1 + t2 - rn, 0.f));
        const float erp = __expf(rpre);
#pragma unroll
        for (int jj = 0; jj < 16; ++jj) {
            const int t = 16 * tq + jj;
            const float ql = qv[jj] * __expf(bl[jj]);
            qs[t * 136 + d] = f2bf(ql);
            qh[t * 136 + d] = f2bf(ql * erp);
            const float kb = kv[jj] * __expf(Ttq - bl[jj]);
            if (tq == 0) ks[(0 + t) * 136 + d] = f2bf(kb * einv);
            if (tq <= 1) ks[(16 + t) * 136 + d] = f2bf(kb * f1);
            if (tq <= 2) ks[(48 + t) * 136 + d] = f2bf(kb * f2);
            ks[(96 + t) * 136 + d] = f2bf(kb * f3);
        }
    }
    __syncthreads();
    {
        const int i = wave >> 1, off = 8 * i * (i + 1);
        bf16x8 af[4];
#pragma unroll
        for (int kk = 0; kk < 4; ++kk) af[kk] = *(const bf16x8*)(qs + (16 * i + r) * 136 + 32 * kk + 8 * q8);
        for (int jt = (wave & 1); jt <= i; jt += 2) {
            f32x4 acc = (f32x4){0.f, 0.f, 0.f, 0.f};
#pragma unroll
            for (int kk = 0; kk < 4; ++kk) { const bf16x8 bfr = *(const bf16x8*)(ks + (off + 16 * jt + r) * 136 + 32 * kk + 8 * q8);
                acc = __builtin_amdgcn_mfma_f32_16x16x32_bf16(af[kk], bfr, acc, 0, 0, 0); }
#pragma unroll
            for (int j = 0; j < 4; ++j) { float v = acc[j]; if (jt == i && r > 4 * q8 + j) v = 0.f;
                pS[(16 * i + 4 * q8 + j) * 72 + 16 * jt + r] = f2bf(v); }
        }
    }
    __syncthreads();
    {
        const int i = oi, eh = oeh;
        bf16x8 ap[2], aq[4];
#pragma unroll
        for (int kk = 0; kk < 2; ++kk) ap[kk] = *(const bf16x8*)(pS + (16 * i + r) * 72 + 32 * kk + 8 * q8);
#pragma unroll
        for (int kk = 0; kk < 4; ++kk) aq[kk] = *(const bf16x8*)(qh + (16 * i + r) * 136 + 32 * kk + 8 * q8);
        f32x4 o[NT];
        float ss[4] = {0.f, 0.f, 0.f, 0.f};
#pragma unroll
        for (int nt = 0; nt < NT; ++nt) {
            const int e0 = eh * (DV / 2) + 16 * nt;
            f32x4 acc = (f32x4){0.f, 0.f, 0.f, 0.f};
#pragma unroll
            for (int kk = 0; kk < 2; ++kk) { const bf16x8 bfr = *(const bf16x8*)(vS + (e0 + r) * 72 + 32 * kk + 8 * q8);
                acc = __builtin_amdgcn_mfma_f32_16x16x32_bf16(ap[kk], bfr, acc, 0, 0, 0); }
#pragma unroll
            for (int kk = 0; kk < 4; ++kk) { bf16x8 bfr;
                if (nt < NPRE) bfr = bst[nt < NPRE ? nt : 0][kk]; else bfr = *(const bf16x8*)(stb + (size_t)(e0 + r) * 128 + 32 * kk + 8 * q8);
                acc = __builtin_amdgcn_mfma_f32_16x16x32_bf16(aq[kk], bfr, acc, 0, 0, 0); }
            o[nt] = acc;
#pragma unroll
            for (int j = 0; j < 4; ++j) ss[j] += acc[j] * acc[j];
        }
#pragma unroll
        for (int j = 0; j < 4; ++j) {
#pragma unroll
            for (int ofs = 1; ofs < 16; ofs <<= 1) ss[j] += __shfl_xor(ss[j], ofs);
            if (r == 0) ssq[eh * 64 + 16 * i + 4 * q8 + j] = ss[j];
        }
        __syncthreads();
        const float* ng = (KIND ? p.gla_ng + hd * 256 : p.hgrn_ng + hd * 128);
        const int ycol = KIND ? 1024 + hd * 256 : hd * 128;
#pragma unroll
        for (int j = 0; j < 4; ++j) {
            const int t = 16 * i + 4 * q8 + j;
            const float rstd = __builtin_amdgcn_rsqf((ssq[t] + ssq[64 + t]) * (1.f / DV) + EPS);
            bf16_t* yp = ycat + (size_t)(tok0 + t) * DM + ycol;
#pragma unroll
            for (int nt = 0; nt < NT; ++nt) { const int e = eh * (DV / 2) + 16 * nt + r;
                const float g = bf2f(graw[j][nt]);
                yp[e] = f2bf(o[nt][j] * rstd * ng[e] * (g * sigmoidf_(g))); }
        }
    }
}

#define XB_TMO      128
#define XB_XCNT(j)  (256  + 64 * (j))
#define XB_XSUB(j)  (1280 + 64 * (j))
#define XB_XGEN(j)  (2304 + 64 * (j))
#define XB_TOP      3328
#define XB_TOPGEN   3392
#define XCD_BAR_WORDS 3456
#define XB_SPIN_CAP (1u << 18)
__device__ __forceinline__ unsigned xb_ld(unsigned* p)              { return __hip_atomic_load(p, __ATOMIC_RELAXED, __HIP_MEMORY_SCOPE_AGENT); }
__device__ __forceinline__ unsigned xb_add(unsigned* p, unsigned v) { return __hip_atomic_fetch_add(p, v, __ATOMIC_RELAXED, __HIP_MEMORY_SCOPE_AGENT); }
__device__ __forceinline__ unsigned xb_xcc_id() { return (unsigned)__builtin_amdgcn_s_getreg((3 << 11) | 20) & 0xFu; }
#define XB_SPIN(cond, bar) do { unsigned _sp = 0; while (cond) { __builtin_amdgcn_s_sleep(1); \
    if ((++_sp & 255u) == 0u) { if (xb_ld(&(bar)[XB_TMO])) break; if (_sp > XB_SPIN_CAP) { atomicAdd(&(bar)[XB_TMO], 1u); break; } } } } while (0)
struct XcdBarrier { unsigned* bar; unsigned x; volatile LAS unsigned* st; };
__device__ __forceinline__ XcdBarrier xcd_barrier_post(unsigned* bar, volatile LAS unsigned* st) {
    XcdBarrier b; b.bar = bar; b.x = xb_xcc_id(); b.st = st;
    if (threadIdx.x == 0) (void)xb_add(&bar[XB_XCNT(b.x)], 1u);
    return b;
}
__device__ __forceinline__ void xcd_barrier_complete(unsigned* bar, unsigned x, unsigned& nloc, unsigned& nx) {
    const unsigned G = gridDim.x * gridDim.y * gridDim.z;
    unsigned sum, cnt, mine, sp = 0u;
    for (;;) {
        sum = 0u; cnt = 0u; mine = 0u;
#pragma unroll
        for (unsigned j = 0; j < 16; ++j) { const unsigned c = xb_ld(&bar[XB_XCNT(j)]); sum += c; cnt += (c > 0u) ? 1u : 0u; mine = (j == x) ? c : mine; }
        if (sum == G) break;
        __builtin_amdgcn_s_sleep(1);
        if ((++sp & 255u) == 0u) { if (xb_ld(&bar[XB_TMO])) break; if (sp > XB_SPIN_CAP) { atomicAdd(&bar[XB_TMO], 1u); break; } }
    }
    nloc = mine > 0u ? mine : 1u; nx = cnt > 0u ? cnt : 1u;
}
__device__ __forceinline__ void xcd_barrier(const XcdBarrier& b) {
    asm volatile("s_waitcnt vmcnt(0)" ::: "memory");
    __syncthreads();
    if (threadIdx.x == 0) {
        unsigned* bar = b.bar;
        __builtin_amdgcn_s_waitcnt(0);
        unsigned nloc = b.st[0], nx = b.st[1];
        if (nloc == 0u) { xcd_barrier_complete(bar, b.x, nloc, nx); b.st[0] = nloc; b.st[1] = nx; }
        const unsigned old = xb_add(&bar[XB_XSUB(b.x)], 1u);
        const unsigned gen = old / nloc;
        if (old + 1u == (gen + 1u) * nloc) {
            __builtin_amdgcn_fence(__ATOMIC_RELEASE, "agent");
            asm volatile("s_waitcnt vmcnt(0)" ::: "memory");
            const unsigned og = xb_add(&bar[XB_TOP], 1u);
            const unsigned tg = og / nx;
            if (og + 1u == (tg + 1u) * nx) xb_add(&bar[XB_TOPGEN], 1u);
            else XB_SPIN(xb_ld(&bar[XB_TOPGEN]) == tg, bar);
            __builtin_amdgcn_fence(__ATOMIC_ACQUIRE, "agent");
            xb_add(&bar[XB_XGEN(b.x)], 1u);
            asm volatile("s_waitcnt vmcnt(0)" ::: "memory");
        } else {
            XB_SPIN(xb_ld(&bar[XB_XGEN(b.x)]) == gen, bar);
            __builtin_amdgcn_fence(__ATOMIC_ACQUIRE, "agent");
            asm volatile("s_waitcnt vmcnt(0)" ::: "memory");
        }
    }
    __syncthreads();
}

__global__ void __launch_bounds__(512, 2) fwd_kernel(Params p) {
    extern __shared__ __attribute__((aligned(16))) unsigned char smem[];
    cg::grid_group grid = cg::this_grid();
    const int tid = threadIdx.x, lane = tid & 63, wave = tid >> 6;
    const int G = gridDim.x, gw = blockIdx.x * 8 + wave, NGW = G * 8;
    unsigned char* ws = p.ws;
    bf16_t* Wout = (bf16_t*)(ws + WS_WOUT); bf16_t* W1t = (bf16_t*)(ws + WS_W1); bf16_t* W2t = (bf16_t*)(ws + WS_W2); bf16_t* Win = (bf16_t*)(ws + WS_WIN);
    bf16_t* U = (bf16_t*)(ws + WS_U); bf16_t* BIG = (bf16_t*)(ws + WS_BIG); bf16_t* YZ = (bf16_t*)(ws + WS_YZ);
    bf16_t* VTE = (bf16_t*)(ws + WS_VT_E); bf16_t* VTO = (bf16_t*)(ws + WS_VT_O); bf16_t* ST = (bf16_t*)(ws + WS_ST); float* DEC = (float*)(ws + WS_DEC);
    float* SS = (float*)(ws + WS_SS); unsigned* PCNT = (unsigned*)(ws + WS_PCNT); bf16_t* YC = (bf16_t*)p.out;
    float* SSH0 = SS; float* SSH1 = SS + NTOK; float* SSH2 = SS + 2 * NTOK; float* SSH3 = SS + 3 * NTOK;
    float* scr = (float*)(smem + wave * 8448);
    LAS unsigned char* lds = (LAS unsigned char*)smem;
    const int lo = p.ph_lo, hi = p.ph_hi;
#define IN(k) (lo <= (k) && (k) < hi)
#define SEAM(k) do { if (IN(k) && IN((k) + 1)) xcd_barrier(xbar); } while (0)
    if (lo < 0) grid.sync();
    volatile LAS unsigned* xst = (volatile LAS unsigned*)(lds + 131072 + 1024);
    if (tid < 4) xst[tid] = 0u;
    __syncthreads();
    XcdBarrier xbar; xbar.bar = (unsigned*)(ws + WS_BAR); xbar.x = 0; xbar.st = xst;
    if (hi - lo > 1) xbar = xcd_barrier_post((unsigned*)(ws + WS_BAR), xst);

    if (IN(0)) {
        cvt_seg(p.even_w_in, DM, 6144, 0, 5120, Win, 0, p.norm_g, scr, gw, NGW, lane);
        cvt_seg(p.even_w_in, DM, 6144, 5120, 1024, Win, 5120, p.norm_g, scr, gw, NGW, lane);
        cvt_seg(p.even_w_out, DM, DM, 0, DM, Wout, 0, nullptr, scr, gw, NGW, lane);
        cvt_seg(p.w1, DM, DFF, 0, DFF, W1t, 0, p.norm_g + 2 * DM, scr, gw, NGW, lane);
        cvt_seg(p.w2, DFF, DM, 0, DM, W2t, 0, nullptr, scr, gw, NGW, lane);
        rowwise<0>(p.x, nullptr, nullptr, U, SSH0, nullptr, gw, NGW, lane);
    }
    SEAM(0);
    if (IN(1)) {
        { pg8::Gemm g{U, Win, NTOK, LDE, DM}; pg8::StaticOrder S; S.init(NTOK, LDE, G, blockIdx.x); pg8::EpiB<0, 1> E{BIG, LDE, SSH0}; pg8::gemm_phase(lds, g, S, E); }
        { pg8::Gemm g{Win + (size_t)5120 * DM, U, 1024, NTOK, DM}; pg8::StaticOrder S; S.init(1024, NTOK, G, blockIdx.x); pg8::EpiB<0, 2> E{VTE, NTOK, SSH0}; pg8::gemm_phase(lds, g, S, E); }
    }
    SEAM(1);
    if (IN(2)) { conv_phase(BIG, p.conv_w, YC); attn_phase(smem, BIG, VTE, p.rel_bias, YC); }
    SEAM(2);
    if (IN(3)) { pg8::Gemm g{YC, Wout, NTOK, DM, DM}; pg8::PanelOrder S{(int)blockIdx.x}; pg8::EpiRes<false> E{U, nullptr, p.norm_g + 1 * DM, SS + 4 * NTOK, SSH1, PCNT}; pg8::gemm_phase(lds, g, S, E); }
    SEAM(3);
    if (IN(5)) { pg8::Gemm g{U, W1t, NTOK, DFF, DM}; pg8::StaticOrder S; S.init(NTOK, DFF, G, blockIdx.x); pg8::EpiB<1, 1> E{BIG, DFF, SSH1}; pg8::gemm_phase(lds, g, S, E); }
    SEAM(5);
    if (IN(6)) { pg8::Gemm g{BIG, W2t, NTOK, DM, DFF}; pg8::PanelOrder S{(int)blockIdx.x}; pg8::EpiRes<false> E{U, nullptr, p.norm_g + 3 * DM, SS + 5 * NTOK, SSH2, PCNT + 64}; pg8::gemm_phase(lds, g, S, E); }
    SEAM(6);
    if (IN(7)) {
        const float* wi = p.odd_w_in;
        cvt_seg(wi, DM, 7184, 0, 2048, Win, 0, p.norm_g + 4 * DM, scr, gw, NGW, lane);
        cvt_seg(wi, DM, 7184, 3072, 2048, Win, 2048, p.norm_g + 4 * DM, scr, gw, NGW, lane);
        cvt_seg(wi, DM, 7184, 6144, 1040, Win, 4096, p.norm_g + 4 * DM, scr, gw, NGW, lane);
        cvt_seg(wi, DM, 7184, 2048, 1024, Win, 5376, p.norm_g + 4 * DM, scr, gw, NGW, lane);
        cvt_seg(wi, DM, 7184, 5120, 1024, Win, 6400, p.norm_g + 4 * DM, scr, gw, NGW, lane);
        cvt_seg(p.odd_w_out, DM, DM, 0, DM, Wout, 0, nullptr, scr, gw, NGW, lane);
        cvt_seg(p.w1 + (size_t)DM * DFF, DM, DFF, 0, DFF, W1t, 0, p.norm_g + 6 * DM, scr, gw, NGW, lane);
        cvt_seg(p.w2 + (size_t)DM * DFF, DFF, DM, 0, DM, W2t, 0, nullptr, scr, gw, NGW, lane);
    }
    SEAM(7);
    if (IN(8)) {
        { pg8::Gemm g{U, Win, NTOK, 5120, DM}; pg8::StaticOrder S; S.init(NTOK, 5120, G, blockIdx.x); pg8::EpiB<0, 1> E{BIG, LDO, SSH2}; pg8::gemm_phase(lds, g, S, E); }
        { pg8::Gemm g{Win + (size_t)5376 * DM, U, 2048, NTOK, DM}; pg8::StaticOrder S; S.init(2048, NTOK, G, blockIdx.x); pg8::EpiB<0, 2> E{VTO, NTOK, SSH2}; pg8::gemm_phase(lds, g, S, E); }
        if (wave < 4) {
            const int r = lane & 15, q8 = lane >> 4, t0 = (blockIdx.x * 4 + wave) * 16;
            if (t0 < NTOK) {
                const bf16_t* ap = U + (size_t)(t0 + r) * DM + 8 * q8;
                const bf16_t* bp = Win + (size_t)(5120 + r) * DM + 8 * q8;
                f32x4 acc = (f32x4){0.f, 0.f, 0.f, 0.f};
#pragma unroll 8
                for (int kk = 0; kk < DM / 32; ++kk) { const bf16x8 a = *(const bf16x8*)(ap + 32 * kk), b = *(const bf16x8*)(bp + 32 * kk);
                    acc = __builtin_amdgcn_mfma_f32_16x16x32_bf16(a, b, acc, 0, 0, 0); }
#pragma unroll
                for (int j = 0; j < 4; ++j) BIG[(size_t)(t0 + 4 * q8 + j) * LDO + 5120 + r] = f2bf(acc[j] * __builtin_amdgcn_rsqf(SSH2[t0 + 4 * q8 + j] * (1.f / DM) + EPS));
            }
        }
    }
    SEAM(8);
    if (IN(9)) {
        int par = 0;
        { bf16_t ra[16], rq[16]; u32x4 vr[2]; u32x4 gaR = (u32x4){0, 0, 0, 0}; load_raw<0, false>(BIG, VTO, blockIdx.x, ra, rq, vr, gaR);
          for (int it = blockIdx.x; it < 2048; it += G) { passA_item<0>(p, smem, BIG, VTO, ST, DEC, it, par, (it + G < 2048) ? it + G : -1, ra, rq, vr, gaR); par ^= 1; } }
        { bf16_t ra[16], rq[16]; u32x4 vr[4]; u32x4 gaR = (u32x4){0, 0, 0, 0}; load_raw<1, false>(BIG, VTO, blockIdx.x, ra, rq, vr, gaR);
          for (int it = blockIdx.x; it < 1024; it += G) { passA_item<1>(p, smem, BIG, VTO, ST, DEC, it, par, (it + G < 1024) ? it + G : -1, ra, rq, vr, gaR); par ^= 1; } }
    }
    SEAM(9);
    if (IN(10)) scan_phase(ST, DEC);
    SEAM(10);
    if (IN(11)) {
        { bf16_t ra[16], rq[16]; u32x4 vr[2]; u32x4 gaR = (u32x4){0, 0, 0, 0}; load_raw<0, true>(BIG, VTO, blockIdx.x, ra, rq, vr, gaR);
          for (int it = blockIdx.x; it < 2048; it += G) passC_item<0>(p, smem, BIG, VTO, ST, YC, it, (it + G < 2048) ? it + G : -1, ra, rq, vr, gaR); }
        { bf16_t ra[16], rq[16]; u32x4 vr[4]; u32x4 gaR = (u32x4){0, 0, 0, 0}; load_raw<1, true>(BIG, VTO, blockIdx.x, ra, rq, vr, gaR);
          for (int it = blockIdx.x; it < 1024; it += G) passC_item<1>(p, smem, BIG, VTO, ST, YC, it, (it + G < 1024) ? it + G : -1, ra, rq, vr, gaR); }
    }
    SEAM(11);
    if (IN(12)) { pg8::Gemm g{YC, Wout, NTOK, DM, DM}; pg8::PanelOrder S{(int)blockIdx.x}; pg8::EpiRes<false> E{U, nullptr, p.norm_g + 5 * DM, SS + 6 * NTOK, SSH3, PCNT + 128}; pg8::gemm_phase(lds, g, S, E); }
    SEAM(12);
    if (IN(14)) { pg8::Gemm g{U, W1t, NTOK, DFF, DM}; pg8::StaticOrder S; S.init(NTOK, DFF, G, blockIdx.x); pg8::EpiB<1, 1> E{BIG, DFF, SSH3}; pg8::gemm_phase(lds, g, S, E); }
    SEAM(14);
    if (IN(15)) { pg8::Gemm g{BIG, W2t, NTOK, DM, DFF}; pg8::PanelOrder S{(int)blockIdx.x}; pg8::EpiRes<true> E{U, p.out, p.norm_g + 7 * DM, SS + 7 * NTOK, nullptr, PCNT + 192}; pg8::gemm_phase(lds, g, S, E); }
#undef IN
#undef SEAM
}

constexpr int NPHASE = 17;

extern "C" void kernel_launch(void* const* d_in, const int* in_sizes, int n_in, void* d_out, int out_size, void* d_ws, size_t ws_size, hipStream_t stream) {
    static int grid = 0;
    if (grid == 0) {
        if (ws_size < WS_END) fprintf(stderr, "kernel_launch: workspace too small: %zu < %zu\n", ws_size, (size_t)WS_END);
        int dev = 0, cus = 0, per_cu = 0;
        hipGetDevice(&dev);
        hipDeviceGetAttribute(&cus, hipDeviceAttributeMultiprocessorCount, dev);
        if (hipFuncSetAttribute((const void*)fwd_kernel, hipFuncAttributeMaxDynamicSharedMemorySize, LDS_BYTES) != hipSuccess) fprintf(stderr, "kernel_launch: hipFuncSetAttribute failed\n");
        if (hipOccupancyMaxActiveBlocksPerMultiprocessor(&per_cu, (const void*)fwd_kernel, 512, LDS_BYTES) != hipSuccess || per_cu < 1) { per_cu = 1; (void)hipGetLastError(); }
        grid = cus * (per_cu > 1 ? 1 : per_cu);
        if (grid <= 0) grid = 256;
    }
    Params p{};
    p.x = (const float*)d_in[0]; p.norm_g = (const float*)d_in[1]; p.even_w_in = (const float*)d_in[2]; p.conv_w = (const float*)d_in[3];
    p.rel_bias = (const float*)d_in[4]; p.even_w_out = (const float*)d_in[5]; p.odd_w_in = (const float*)d_in[6]; p.hgrn_lb = (const float*)d_in[7];
    p.hgrn_ng = (const float*)d_in[8]; p.wa2 = (const float*)d_in[9]; p.ba = (const float*)d_in[10]; p.gla_ng = (const float*)d_in[11];
    p.odd_w_out = (const float*)d_in[12]; p.w1 = (const float*)d_in[13]; p.w2 = (const float*)d_in[14];
    p.out = (float*)d_out; p.ws = (unsigned char*)d_ws;
#if ONE_LAUNCH
    (void)hipMemsetAsync((unsigned char*)d_ws + WS_BAR, 0, WS_ZERO_BYTES, stream);
    p.ph_lo = 0; p.ph_hi = NPHASE;
    void* args[] = {&p};
    hipError_t e = hipLaunchCooperativeKernel((const void*)fwd_kernel, dim3(grid), dim3(512), args, LDS_BYTES, stream);
    if (e != hipSuccess) fprintf(stderr, "cooperative launch failed: %s (grid %d)\n", hipGetErrorString(e), grid);
#else
    for (int k = 0; k < NPHASE; ++k) {
        p.ph_lo = k; p.ph_hi = k + 1;
        hipLaunchKernelGGL(fwd_kernel, dim3(grid), dim3(512), LDS_BYTES, stream, p);
    }
#endif
}
```
